# Optimizing an MI355X kernel written in HIP

```python
import math
import jax
import jax.numpy as jnp
from jax import lax
import numpy as np

D_MODEL = 1024
BATCH = 2
SEQ = 8192
DEPTH = 2

D_MIX = D_MODEL
ATT_HEADS = 8
ATT_HEAD_DIM = 64
ATT_WIDTH = ATT_HEADS * ATT_HEAD_DIM
MOBA_BLOCK = 256
MOBA_TOPK = 3
Q_CHUNK = 128
ROPE_THETA = 500000.0
ROPE_DIM = ATT_HEAD_DIM // 4
ML_HEADS = 4
ML_WIDTH = D_MIX - ATT_WIDTH
ML_V_DIM = ML_WIDTH // ML_HEADS
ML_QK_DIM = ML_V_DIM // 2
ML_QK_WIDTH = ML_HEADS * ML_QK_DIM
ML_CHUNK = 128
CONV_WIDTH = 4
N_IN = 3 * ATT_WIDTH + 2 * ML_QK_WIDTH + 2 * ML_WIDTH + 2 * ML_HEADS
D_FF = 2816
N_EXPERTS = 8
TOP_K = 2
D_EXPERT = 3584
N_DENSE = (DEPTH + 1) // 2
N_MOE = DEPTH // 2
LN_EPS = 1e-5
RMS_EPS = 1e-6

kernel_name = "hymba_moba_mlstm_deepnorm_moe"


def layer_norm(x, g, b):
    xf = x.astype(jnp.float32)
    mu = xf.mean(-1, keepdims=True)
    var = jnp.square(xf - mu).mean(-1, keepdims=True)
    return ((xf - mu) * lax.rsqrt(var + LN_EPS) * g.astype(jnp.float32) + b.astype(jnp.float32)).astype(x.dtype)


def head_rmsnorm(h, g, out_dtype):
    B, S, H, Dh = h.shape
    hf = h.astype(jnp.float32)
    hf = hf * lax.rsqrt(jnp.mean(jnp.square(hf), -1, keepdims=True) + RMS_EPS)
    return (hf.reshape(B, S, H * Dh) * g.astype(jnp.float32)).astype(out_dtype)


def partial_rope(x, positions):
    half = ROPE_DIM // 2
    inv_freq = ROPE_THETA ** (-jnp.arange(half, dtype=jnp.float32) / half)
    ang = positions.astype(jnp.float32)[:, None, :, None] * inv_freq
    cos, sin = jnp.cos(ang), jnp.sin(ang)
    xf = x.astype(jnp.float32)
    x1, x2, rest = xf[..., :half], xf[..., half:ROPE_DIM], xf[..., ROPE_DIM:]
    out = jnp.concatenate([x1 * cos - x2 * sin, x2 * cos + x1 * sin, rest], -1)
    return out.astype(x.dtype)


def moba_attention(q, k, v):
    B, H, S, Dh = q.shape
    nb = -(-S // MOBA_BLOCK)
    pad = nb * MOBA_BLOCK - S
    kp = jnp.pad(k, ((0, 0), (0, 0), (0, pad), (0, 0)))
    vp = jnp.pad(v, ((0, 0), (0, 0), (0, pad), (0, 0)))
    kb = kp.reshape(B, H, nb, MOBA_BLOCK, Dh)
    vb = vp.reshape(B, H, nb, MOBA_BLOCK, Dh)
    k_mean = kb.astype(jnp.float32).mean(3)
    topk = min(MOBA_TOPK, nb)
    scale = Dh ** -0.5
    bi = jnp.arange(B)[:, None, None, None]
    hi = jnp.arange(H)[None, :, None, None]
    block_ids = jnp.arange(nb)

    def one_chunk(c):
        q0 = c * Q_CHUNK
        blk = q0 // MOBA_BLOCK
        qf = lax.dynamic_slice_in_dim(q, q0, Q_CHUNK, axis=2).astype(jnp.float32)
        gate = jnp.einsum('bhqd,bhnd->bhqn', qf, k_mean)
        gate = jnp.where(block_ids < blk, gate, -jnp.inf)
        _, sel = lax.top_k(gate, topk)
        sel_ok = sel < blk
        k_sel = kb[bi, hi, sel].astype(jnp.float32)
        v_sel = vb[bi, hi, sel].astype(jnp.float32)
        s_sel = jnp.einsum('bhqd,bhqknd->bhqkn', qf, k_sel) * scale
        s_sel = jnp.where(sel_ok[..., None], s_sel, -jnp.inf)
        k_own = lax.dynamic_index_in_dim(kb, blk, axis=2, keepdims=False).astype(jnp.float32)
        v_own = lax.dynamic_index_in_dim(vb, blk, axis=2, keepdims=False).astype(jnp.float32)
        s_own = jnp.einsum('bhqd,bhnd->bhqn', qf, k_own) * scale
        q_pos = q0 + jnp.arange(Q_CHUNK)
        k_pos = blk * MOBA_BLOCK + jnp.arange(MOBA_BLOCK)
        s_own = jnp.where(k_pos[None, :] <= q_pos[:, None], s_own, -jnp.inf)
        n_sel = topk * MOBA_BLOCK
        p = jax.nn.softmax(jnp.concatenate([s_sel.reshape(B, H, Q_CHUNK, n_sel), s_own], -1), axis=-1)
        p_sel = p[..., :n_sel].reshape(B, H, Q_CHUNK, topk, MOBA_BLOCK)
        p_own = p[..., n_sel:]
        out = (jnp.einsum('bhqkn,bhqknd->bhqd', p_sel, v_sel)
               + jnp.einsum('bhqn,bhnd->bhqd', p_own, v_own))
        return out.astype(q.dtype)

    outs = lax.map(one_chunk, jnp.arange(S // Q_CHUNK))
    return jnp.moveaxis(outs, 0, 2).reshape(B, H, S, Dh)


def causal_depthwise_conv(x, w, b):
    S = x.shape[1]
    xp = jnp.pad(x, ((0, 0), (CONV_WIDTH - 1, 0), (0, 0)))
    y = b + w[0] * xp[:, 0:S]
    for j in range(1, CONV_WIDTH):
        y = y + w[j] * xp[:, j:j + S]
    return y


def mlstm_chunkwise(q, k, v, i_pre, f_pre):
    B, H, S, Dk = q.shape
    Dv = v.shape[-1]
    L = ML_CHUNK
    nc = S // L
    qf = q.astype(jnp.float32) * (Dk ** -0.5)
    kf = k.astype(jnp.float32)
    vf = v.astype(jnp.float32)
    ig = i_pre.astype(jnp.float32)
    logf = jax.nn.log_sigmoid(f_pre.astype(jnp.float32))

    def chunks(t):
        return jnp.moveaxis(t.reshape(B, H, nc, L, *t.shape[3:]), 2, 0)

    causal = jnp.tril(jnp.ones((L, L), dtype=bool))

    def step(carry, xs):
        C, n, m = carry
        qc, kc, vc, ic, fc = xs
        b = jnp.cumsum(fc, axis=-1)
        d_log = jnp.where(causal, b[..., :, None] - b[..., None, :] + ic[..., None, :], -jnp.inf)
        inter = b + m[..., None]
        m_t = jnp.maximum(inter, d_log.max(-1))
        w_intra = jnp.exp(d_log - m_t[..., None])
        w_inter = jnp.exp(inter - m_t)
        s = jnp.einsum('bhtd,bhsd->bhts', qc, kc) * w_intra
        num = (jnp.einsum('bhts,bhsv->bhtv', s, vc)
               + w_inter[..., None] * jnp.einsum('bhvd,bhtd->bhtv', C, qc))
        den = s.sum(-1) + w_inter * jnp.einsum('bhd,bhtd->bht', n, qc)
        h = num / jnp.maximum(jnp.abs(den), jnp.exp(-m_t))[..., None]
        b_last = b[..., -1]
        decay = b_last[..., None] - b + ic
        m_new = jnp.maximum(b_last + m, decay.max(-1))
        w_state = jnp.exp(decay - m_new[..., None])
        carry_scale = jnp.exp(b_last + m - m_new)
        C_new = carry_scale[..., None, None] * C + jnp.einsum('bhs,bhsv,bhsd->bhvd', w_state, vc, kc)
        n_new = carry_scale[..., None] * n + jnp.einsum('bhs,bhsd->bhd', w_state, kc)
        return (C_new, n_new, m_new), h

    init = (jnp.zeros((B, H, Dv, Dk), jnp.float32), jnp.zeros((B, H, Dk), jnp.float32),
            jnp.zeros((B, H), jnp.float32))
    _, hs = lax.scan(step, init, (chunks(qf), chunks(kf), chunks(vf), chunks(ig), chunks(logf)))
    return jnp.moveaxis(hs, 0, 2).reshape(B, H, S, Dv)


def hybrid_mixer(x, positions, w_in, gate_bias, conv_w, conv_b, norm_attn, norm_mlstm, w_out):
    B, S, _ = x.shape
    proj = x @ w_in
    cuts = [int(c) for c in np.cumsum([ATT_WIDTH, ATT_WIDTH, ATT_WIDTH, 2 * ML_QK_WIDTH, ML_WIDTH, ML_WIDTH])]
    aq, ak, av, mqk, mv, mo, mg = jnp.split(proj, cuts, axis=-1)

    def att_heads(t):
        return t.reshape(B, S, ATT_HEADS, ATT_HEAD_DIM).transpose(0, 2, 1, 3)
    qa = partial_rope(att_heads(aq), positions)
    ka = partial_rope(att_heads(ak), positions)
    att = moba_attention(qa, ka, att_heads(av))
    att_out = head_rmsnorm(att.transpose(0, 2, 1, 3), norm_attn, x.dtype)

    mqk = jax.nn.silu(causal_depthwise_conv(mqk, conv_w, conv_b))
    mq, mk = mqk[..., :ML_QK_WIDTH], mqk[..., ML_QK_WIDTH:]
    def ml_heads(t, d):
        return t.reshape(B, S, ML_HEADS, d).transpose(0, 2, 1, 3)
    gates = (mg + gate_bias).transpose(0, 2, 1)
    h_ml = mlstm_chunkwise(ml_heads(mq, ML_QK_DIM), ml_heads(mk, ML_QK_DIM), ml_heads(mv, ML_V_DIM),
                           gates[:, :ML_HEADS], gates[:, ML_HEADS:])
    ml_out = head_rmsnorm(h_ml.transpose(0, 2, 1, 3), norm_mlstm, x.dtype) * jax.nn.sigmoid(mo)

    return jnp.concatenate([att_out, ml_out], axis=-1) @ w_out


def swiglu(x, w_gate, w_up, w_down):
    return (jax.nn.silu(x @ w_gate) * (x @ w_up)) @ w_down


def moe_swiglu(x, router_w, router_b, w_gate, w_up, w_down):
    logits = (x @ router_w).astype(jnp.float32) + router_b.astype(jnp.float32)
    top_val, top_idx = lax.top_k(logits, TOP_K)
    top_w = jax.nn.softmax(top_val, axis=-1)
    combine = jnp.sum(jax.nn.one_hot(top_idx, N_EXPERTS, dtype=jnp.float32) * top_w[..., None], axis=-2)
    combine = combine.astype(x.dtype)
    y = jnp.zeros_like(x)
    for e in range(N_EXPERTS):
        y = y + combine[..., e:e + 1] * swiglu(x, w_gate[e], w_up[e], w_down[e])
    return y


def setup_inputs(seed: int = 0) -> dict:
    key = jax.random.key(seed)
    ks = jax.random.split(key, 24)
    f32 = jnp.float32
    beta = (8.0 * DEPTH) ** -0.25

    def nrm(k, shape, scale):
        return scale * jax.random.normal(k, shape, f32)

    x = nrm(ks[0], (BATCH, SEQ, D_MODEL), 1.0)
    positions = jnp.broadcast_to(jnp.arange(SEQ, dtype=jnp.int32), (BATCH, SEQ))
    w_in = nrm(ks[1], (DEPTH, D_MODEL, N_IN), D_MODEL ** -0.5)
    i_bias = nrm(ks[2], (DEPTH, ML_HEADS), 0.1)
    f_bias = jnp.linspace(3.0, 6.0, ML_HEADS, dtype=f32) + nrm(ks[3], (DEPTH, ML_HEADS), 0.1)
    gate_bias = jnp.concatenate([i_bias, f_bias], axis=-1)
    conv_w = nrm(ks[4], (DEPTH, CONV_WIDTH, 2 * ML_QK_WIDTH), CONV_WIDTH ** -0.5)
    conv_b = nrm(ks[5], (DEPTH, 2 * ML_QK_WIDTH), 0.02)
    norm_attn = 1.0 + nrm(ks[6], (DEPTH, ATT_WIDTH), 0.02)
    norm_mlstm = 1.0 + nrm(ks[7], (DEPTH, ML_WIDTH), 0.02)
    w_out = nrm(ks[8], (DEPTH, D_MIX, D_MODEL), beta * D_MIX ** -0.5)
    ln1_g = 1.0 + nrm(ks[9], (DEPTH, D_MODEL), 0.02)
    ln1_b = nrm(ks[10], (DEPTH, D_MODEL), 0.02)
    dense_w_gate = nrm(ks[11], (N_DENSE, D_MODEL, D_FF), D_MODEL ** -0.5)
    dense_w_up = nrm(ks[12], (N_DENSE, D_MODEL, D_FF), D_MODEL ** -0.5)
    dense_w_down = nrm(ks[13], (N_DENSE, D_FF, D_MODEL), beta * D_FF ** -0.5)
    router_w = nrm(ks[14], (N_MOE, D_MODEL, N_EXPERTS), D_MODEL ** -0.5)
    router_b = nrm(ks[15], (N_MOE, N_EXPERTS), 0.01)
    moe_w_gate = nrm(ks[16], (N_MOE, N_EXPERTS, D_MODEL, D_EXPERT), D_MODEL ** -0.5)
    moe_w_up = nrm(ks[17], (N_MOE, N_EXPERTS, D_MODEL, D_EXPERT), D_MODEL ** -0.5)
    moe_w_down = nrm(ks[18], (N_MOE, N_EXPERTS, D_EXPERT, D_MODEL), beta * D_EXPERT ** -0.5)
    ln2_g = 1.0 + nrm(ks[19], (DEPTH, D_MODEL), 0.02)
    ln2_b = nrm(ks[20], (DEPTH, D_MODEL), 0.02)
    return {"x": x, "positions": positions, "w_in": w_in, "gate_bias": gate_bias,
            "conv_w": conv_w, "conv_b": conv_b, "norm_attn": norm_attn, "norm_mlstm": norm_mlstm,
            "w_out": w_out, "ln1_g": ln1_g, "ln1_b": ln1_b,
            "dense_w_gate": dense_w_gate, "dense_w_up": dense_w_up, "dense_w_down": dense_w_down,
            "router_w": router_w, "router_b": router_b,
            "moe_w_gate": moe_w_gate, "moe_w_up": moe_w_up, "moe_w_down": moe_w_down,
            "ln2_g": ln2_g, "ln2_b": ln2_b}


def reference(x, positions, w_in, gate_bias, conv_w, conv_b, norm_attn, norm_mlstm, w_out,
              ln1_g, ln1_b, dense_w_gate, dense_w_up, dense_w_down, router_w, router_b,
              moe_w_gate, moe_w_up, moe_w_down, ln2_g, ln2_b):
    alpha = (2.0 * DEPTH) ** 0.25
    for l in range(DEPTH):
        mix = hybrid_mixer(x, positions, w_in[l], gate_bias[l], conv_w[l], conv_b[l],
                           norm_attn[l], norm_mlstm[l], w_out[l])
        x = layer_norm(alpha * x + mix, ln1_g[l], ln1_b[l])
        j = l // 2
        if l % 2 == 0:
            ffn = swiglu(x, dense_w_gate[j], dense_w_up[j], dense_w_down[j])
        else:
            ffn = moe_swiglu(x, router_w[j], router_b[j], moe_w_gate[j], moe_w_up[j], moe_w_down[j])
        x = layer_norm(alpha * x + ffn, ln2_g[l], ln2_b[l])
    return x
```

```cpp
#include <hip/hip_runtime.h>
#include <cstdio>
#include <cstdint>
#include <cmath>
namespace pg8 {
#define PG8_LAS __attribute__((address_space(3)))
typedef unsigned short bf16_t;
typedef short bf16x8 __attribute__((ext_vector_type(8)));
typedef float f32x4 __attribute__((ext_vector_type(4)));
typedef unsigned u32x4 __attribute__((ext_vector_type(4)));
constexpr int BM = 256, BK = 64, HALF = 128, HTB = HALF * BK * 2  , STAGE_BYTES = 8 * HTB, NXCD = 8, WGM = 8;

__host__ __device__ __forceinline__ int lds_byte(int r, int c) { const int st = (r >> 4) * 2 + (c >> 5), rr = r & 15, cc = c & 31, ob = rr * 64 + cc * 2; return st * 1024 + (ob ^ (((ob >> 9) & 1) << 5)); }
__host__ __device__ __forceinline__ void stage_rc(int b, int& R, int& C) { const int st = b / 1024, sb = b % 1024, swz = sb ^ (((sb >> 9) & 1) << 5); R = (st >> 1) * 16 + swz / 64; C = (st & 1) * 32 + (swz % 64) / 2; }
__host__ __device__ __forceinline__ int perm32(int rho) { const int n = rho >> 4, i = rho & 15; return 8 * (i >> 2) + 4 * n + (i & 3); }

struct Unit { int pm, pn, pb; };
struct Gemm { const bf16_t* A; const bf16_t* Bt; int M, N, K; };

struct StaticOrder {
    int nM, nN, nwg, G, c;
    __host__ __device__ void init(int M, int N, int G_, int c_) { nM = M / BM; nN = N / BM; nwg = nM * nN; G = G_; c = c_; }
    __host__ __device__ bool next(int i, Unit& u) const {
        const long L = (long)i * G + c; if (L >= nwg) return false;
        int wgid = (int)L; { const int q = nwg / NXCD, r = nwg % NXCD, xcd = wgid % NXCD, off = wgid / NXCD; wgid = (xcd < r ? xcd * (q + 1) : r * (q + 1) + (xcd - r) * q) + off; }
        const int nig = WGM * nN, gid = wgid / nig, fm = gid * WGM, gsz = (nM - fm) < WGM ? (nM - fm) : WGM;
        u.pm = fm + ((wgid % nig) % gsz); u.pn = (wgid % nig) / gsz; u.pb = u.pn; return true;
    }
    __device__ __forceinline__ void a_ready(const Unit&) const {}
    __device__ __forceinline__ void done(const Unit&) const {}
};


__device__ __forceinline__ unsigned cvt_pk_bf16(float lo, float hi) { unsigned r; asm volatile("v_cvt_pk_bf16_f32 %0, %1, %2" : "=v"(r) : "v"(lo), "v"(hi)); return r; }
__device__ __forceinline__ u32x4 pack8(const f32x4 v0, const f32x4 v1) { u32x4 w; w.x = cvt_pk_bf16(v0[0], v0[1]); w.y = cvt_pk_bf16(v0[2], v0[3]); w.z = cvt_pk_bf16(v1[0], v1[1]); w.w = cvt_pk_bf16(v1[2], v1[3]); return w; }
__device__ __forceinline__ f32x4 shx16(const f32x4 v) { f32x4 r; r[0] = __shfl_xor(v[0], 16); r[1] = __shfl_xor(v[1], 16); r[2] = __shfl_xor(v[2], 16); r[3] = __shfl_xor(v[3], 16); return r; }

struct EpiF32 {
    static constexpr bool PERM = false, AFTER_DRAIN = false;
    float* C; int ldc;
    __device__ __forceinline__ void operator()(const f32x4 (&acc)[2][2][4][2], const Unit& u, int wr, int wc, int fr, int fq) const {
        const int row0 = u.pm * BM + wr * 64 + fr, col0 = u.pn * BM + wc * 32 + 4 * fq;
#pragma unroll
        for (int ai = 0; ai < 2; ++ai)
#pragma unroll
            for (int m = 0; m < 4; ++m) { float* rowp = C + (size_t)(row0 + ai * HALF + m * 16) * ldc + col0;
#pragma unroll
                for (int bj = 0; bj < 2; ++bj)
#pragma unroll
                    for (int n = 0; n < 2; ++n) *(f32x4*)(rowp + bj * HALF + n * 16) = acc[ai][bj][m][n]; }
    }
};

struct EpiProj {
    static constexpr bool PERM = true, AFTER_DRAIN = false;
    bf16_t* O; const float* rope; float* ksum; float qscale;
    __device__ __forceinline__ void operator()(const f32x4 (&acc)[2][2][4][2], const Unit& u, int wr, int wc, int fr, int fq) const {
        const int row0 = u.pm * BM + wr * 64 + fr; const int colt = u.pn * BM; const int col0 = colt + wc * 32 + 8 * fq;
        const bool is_qk = u.pn < 4, is_q = u.pn < 2, rot = is_qk && ((wc & 1) == 0);
        float ks[2][8];
#pragma unroll
        for (int bj = 0; bj < 2; ++bj)
#pragma unroll
            for (int i = 0; i < 8; ++i) ks[bj][i] = 0.f;
#pragma unroll
        for (int ai = 0; ai < 2; ++ai)
#pragma unroll
            for (int m = 0; m < 4; ++m) { const int row = row0 + ai * HALF + m * 16; bf16_t* rowp = O + (size_t)row * 3072 + col0;
                f32x4 c0 = {1.f, 1.f, 1.f, 1.f}, c1 = c0, s0 = {0.f, 0.f, 0.f, 0.f}, s1 = s0;
                if (rot && fq < 2) { const f32x4* rp = (const f32x4*)(rope + (size_t)row * 16); c0 = rp[0]; c1 = rp[1]; s0 = rp[2]; s1 = rp[3]; if (fq == 0) { s0 = -s0; s1 = -s1; } }
#pragma unroll
                for (int bj = 0; bj < 2; ++bj) { f32x4 v0 = acc[ai][bj][m][0], v1 = acc[ai][bj][m][1];
                    if (rot) { const f32x4 p0 = shx16(v0), p1 = shx16(v1); v0 = v0 * c0 + p0 * s0; v1 = v1 * c1 + p1 * s1; }
                    if (is_q) { v0 = v0 * qscale; v1 = v1 * qscale; }
                    else if (is_qk) {
#pragma unroll
                        for (int i = 0; i < 4; ++i) { ks[bj][i] += v0[i]; ks[bj][4 + i] += v1[i]; } }
                    *(u32x4*)(rowp + bj * HALF) = pack8(v0, v1); } }
        if (is_qk && !is_q) {
            float* kd = ksum + (size_t)u.pm * 512 + (colt - 512) + wc * 32 + 8 * fq;
#pragma unroll
            for (int bj = 0; bj < 2; ++bj)
#pragma unroll
                for (int i = 0; i < 8; ++i) { float s = ks[bj][i]; s += __shfl_xor(s, 1); s += __shfl_xor(s, 2); s += __shfl_xor(s, 4); s += __shfl_xor(s, 8);
                    if (fr == 0) __hip_atomic_fetch_add(kd + bj * HALF + i, s, __ATOMIC_RELAXED, __HIP_MEMORY_SCOPE_AGENT); }
        }
    }
};

__device__ __forceinline__ float silu_f(float x) { return x * __builtin_amdgcn_rcpf(1.0f + __builtin_amdgcn_exp2f(-1.4426950408889634f * x)); }
struct EpiSwiglu {
    static constexpr bool PERM = true, AFTER_DRAIN = false;
    bf16_t* H; int ldh; int pm_off;
    __device__ __forceinline__ void operator()(const f32x4 (&acc)[2][2][4][2], const Unit& u, int wr, int wc, int fr, int fq) const {
        const int row0 = (u.pm - pm_off) * BM + wr * 64 + fr; const int col0 = u.pn * HALF + wc * 32 + 8 * fq;
#pragma unroll
        for (int ai = 0; ai < 2; ++ai)
#pragma unroll
            for (int m = 0; m < 4; ++m) { bf16_t* rowp = H + (size_t)(row0 + ai * HALF + m * 16) * ldh + col0;
                const f32x4 g0 = acc[ai][0][m][0], g1 = acc[ai][0][m][1], u0 = acc[ai][1][m][0], u1 = acc[ai][1][m][1]; f32x4 h0, h1;
#pragma unroll
                for (int i = 0; i < 4; ++i) { h0[i] = silu_f(g0[i]) * u0[i]; h1[i] = silu_f(g1[i]) * u1[i]; }
                *(u32x4*)rowp = pack8(h0, h1); }
    }
};
struct EpiScatter {
    static constexpr bool PERM = true, AFTER_DRAIN = false;
    bf16_t* Y; const int* rowmap; const float* roww; int pm_off; int mtok;
    __device__ __forceinline__ void operator()(const f32x4 (&acc)[2][2][4][2], const Unit& u, int wr, int wc, int fr, int fq) const {
        const int row0 = (u.pm + pm_off) * BM + wr * 64 + fr; const int col0 = u.pn * BM + wc * 32 + 8 * fq;
#pragma unroll
        for (int ai = 0; ai < 2; ++ai)
#pragma unroll
            for (int m = 0; m < 4; ++m) { const int r = row0 + ai * HALF + m * 16; const int ts = rowmap[r];
                if (ts >= 0) { const float w = roww[r]; bf16_t* rowp = Y + ((size_t)(ts & 1) * mtok + (ts >> 1)) * 1024 + col0;
#pragma unroll
                    for (int bj = 0; bj < 2; ++bj) *(u32x4*)(rowp + bj * HALF) = pack8(acc[ai][bj][m][0] * w, acc[ai][bj][m][1] * w); } }
    }
};
template <bool REL> struct GroupedOrder {
    int t0, nM, nN, nwg, G, c; const PG8_LAS int* texp;
    __device__ __forceinline__ void init(int t0_, int t1_, int nN_, int G_, int c_, const PG8_LAS int* texp_) { t0 = t0_; nM = t1_ - t0_; if (nM < 0) nM = 0; nN = nN_; nwg = nM * nN; G = G_; c = c_; texp = texp_; }
    __device__ __forceinline__ bool next(int i, Unit& u) const {
        const long L = (long)i * G + c; if (L >= nwg) return false;
        int wgid = (int)L; { const int q = nwg / NXCD, r = nwg % NXCD, xcd = wgid % NXCD, off = wgid / NXCD; wgid = (xcd < r ? xcd * (q + 1) : r * (q + 1) + (xcd - r) * q) + off; }
        const int nig = WGM * nN, gid = wgid / nig, fm = gid * WGM, gsz = (nM - fm) < WGM ? (nM - fm) : WGM;
        const int pmr = fm + ((wgid % nig) % gsz); u.pn = (wgid % nig) / gsz; u.pm = REL ? pmr : (t0 + pmr); u.pb = texp[t0 + pmr] * nN + u.pn; return true;
    }
    __device__ __forceinline__ void a_ready(const Unit&) const {}
    __device__ __forceinline__ void done(const Unit&) const {}
};
template <class Epi, class Sched, bool ALIGN_EPI = false, bool SP2 = false>
__device__ __forceinline__ void gemm_phase(PG8_LAS unsigned char* lds, const Gemm g, const Sched& S, const Epi& E) {
    const int tid = threadIdx.x, wid = __builtin_amdgcn_readfirstlane(tid >> 6), lane = tid & 63, wr = wid >> 2, wc = wid & 3, fr = lane & 15, fq = lane >> 4;
    const int K = g.K, nt = K / BK;
    unsigned voffA[2], voffB[2];
#pragma unroll
    for (int i = 0; i < 2; ++i) { int R, C; stage_rc(tid * 16 + i * 8192, R, C); const int Rb = Epi::PERM ? ((R & ~31) + perm32(R & 31)) : R;
        voffA[i] = (unsigned)(R * K + C) * 2u; voffB[i] = (unsigned)(Rb * K + C) * 2u; }
    const size_t kstep = (size_t)(BK * 2);
    const size_t hstep = (size_t)HALF * K * 2;
    const size_t tstep = 2 * hstep;
    const unsigned ldsw = (unsigned)wid * 1024u;
    const int aoff = lds_byte(wr * 64 + fr, fq * 8), boff = lds_byte(wc * 32 + fr, fq * 8);
#define PG8_SA(b, h) (((b) * 2 + (h)) * HTB)
#define PG8_SB(b, h) ((4 + (b) * 2 + (h)) * HTB)
#define PG8_STAGE(bufoff, gbase, voff) do { _Pragma("unroll") for (int _i = 0; _i < 2; ++_i) \
        __builtin_amdgcn_global_load_lds((const unsigned*)((const char*)(gbase) + (voff)[_i]), (PG8_LAS unsigned*)(lds + (bufoff) + ldsw + _i * 8192), 16, 0, 0); } while (0)
#define PG8_LDA(dst, b, h) do { _Pragma("unroll") for (int m = 0; m < 4; ++m) _Pragma("unroll") for (int k = 0; k < 2; ++k) dst[m][k] = *(const PG8_LAS bf16x8*)(lds + PG8_SA(b, h) + aoff + m * 2048 + k * 1024); } while (0)
#define PG8_LDB(dst, b, h) do { _Pragma("unroll") for (int n = 0; n < 2; ++n) _Pragma("unroll") for (int k = 0; k < 2; ++k) dst[n][k] = *(const PG8_LAS bf16x8*)(lds + PG8_SB(b, h) + boff + n * 2048 + k * 1024); } while (0)
#define PG8_MMA(ai, bj, At, Bt) do { __builtin_amdgcn_s_setprio(1); _Pragma("unroll") for (int m = 0; m < 4; ++m) _Pragma("unroll") for (int n = 0; n < 2; ++n) _Pragma("unroll") for (int k = 0; k < 2; ++k) \
        acc[ai][bj][m][n] = __builtin_amdgcn_mfma_f32_16x16x32_bf16(Bt[n][k], At[m][k], acc[ai][bj][m][n], 0, 0, 0); __builtin_amdgcn_s_setprio(0); } while (0)
#define PG8_WAIT_V(n) asm volatile("s_waitcnt vmcnt(" #n ")" ::: "memory")
#define PG8_WAIT_L(n) asm volatile("s_waitcnt lgkmcnt(" #n ")" ::: "memory")
#define PG8_BAR __builtin_amdgcn_s_barrier()
#define PG8_SCHED __builtin_amdgcn_sched_barrier(0)
    Unit cur, nxt; int ui = 0;
    if (!S.next(0, cur)) return;
    f32x4 acc[2][2][4][2];
#pragma unroll
    for (int a = 0; a < 2; ++a)
#pragma unroll
        for (int b = 0; b < 2; ++b)
#pragma unroll
            for (int m = 0; m < 4; ++m)
#pragma unroll
                for (int n = 0; n < 2; ++n) acc[a][b][m][n] = (f32x4){0.f, 0.f, 0.f, 0.f};
    bf16x8 At[4][2], B0[2][2], B1[2][2];
    const char* cA = (const char*)g.A + (size_t)cur.pm * tstep; const char* cB = (const char*)g.Bt + (size_t)cur.pb * tstep;
    S.a_ready(cur);
    if constexpr (SP2) {
        PG8_STAGE(PG8_SB(0, 0), cB, voffB); PG8_STAGE(PG8_SB(0, 1), cB + hstep, voffB); PG8_STAGE(PG8_SA(0, 0), cA, voffA); PG8_STAGE(PG8_SA(0, 1), cA + hstep, voffA);
        if (wr == 1) PG8_BAR;
        PG8_WAIT_V(2); PG8_BAR;
        PG8_STAGE(PG8_SB(1, 0), cB + kstep, voffB); PG8_STAGE(PG8_SA(1, 0), cA + kstep, voffA); PG8_STAGE(PG8_SB(1, 1), cB + hstep + kstep, voffB);
        PG8_WAIT_V(6); PG8_BAR;
    } else {
        PG8_STAGE(PG8_SB(0, 0), cB, voffB); PG8_STAGE(PG8_SA(0, 0), cA, voffA); PG8_STAGE(PG8_SB(0, 1), cB + hstep, voffB); PG8_STAGE(PG8_SA(0, 1), cA + hstep, voffA);
        if (wr == 1) PG8_BAR;
        PG8_WAIT_V(4); PG8_BAR;
        PG8_STAGE(PG8_SB(1, 0), cB + kstep, voffB); PG8_STAGE(PG8_SA(1, 0), cA + kstep, voffA); PG8_STAGE(PG8_SB(1, 1), cB + hstep + kstep, voffB);
        PG8_WAIT_V(6); PG8_BAR;
    }
    for (;;) {
        const bool has_next = S.next(ui + 1, nxt);
        const char* nA = has_next ? (const char*)g.A + (size_t)nxt.pm * tstep : cA; const char* nB = has_next ? (const char*)g.Bt + (size_t)nxt.pb * tstep : cB;
        for (int t = 0; t < nt; t += 2) {
            const bool last = (t == nt - 2);
            const char* a1 = cA + (size_t)(t + 1) * kstep;
            const char* a2 = last ? nA : cA + (size_t)(t + 2) * kstep; const char* b2 = last ? nB : cB + (size_t)(t + 2) * kstep;
            const char* a3 = a2 + kstep; const char* b3 = b2 + kstep;
            if (last && has_next) S.a_ready(nxt);
            if constexpr (SP2) {
            PG8_LDB(B0, 0, 0); PG8_LDB(B1, 0, 1); PG8_SCHED; PG8_LDA(At, 0, 0); PG8_STAGE(PG8_SA(1, 1), a1 + hstep, voffA);
            PG8_WAIT_V(8); PG8_WAIT_L(0); PG8_BAR; PG8_MMA(0, 0, At, B0); PG8_MMA(0, 1, At, B1); PG8_BAR; PG8_SCHED;
            PG8_LDA(At, 0, 1); PG8_STAGE(PG8_SB(0, 0), b2, voffB); PG8_STAGE(PG8_SB(0, 1), b2 + hstep, voffB); PG8_STAGE(PG8_SA(0, 0), a2, voffA);
            PG8_WAIT_V(8); PG8_WAIT_L(0); PG8_BAR; PG8_MMA(1, 0, At, B0); PG8_MMA(1, 1, At, B1); PG8_BAR; PG8_SCHED;
            PG8_LDB(B0, 1, 0); PG8_LDB(B1, 1, 1); PG8_SCHED; PG8_LDA(At, 1, 0); PG8_STAGE(PG8_SA(0, 1), a2 + hstep, voffA);
            PG8_WAIT_V(8); PG8_WAIT_L(0); PG8_BAR; PG8_MMA(0, 0, At, B0); PG8_MMA(0, 1, At, B1); PG8_BAR; PG8_SCHED;
            PG8_LDA(At, 1, 1); PG8_STAGE(PG8_SB(1, 0), b3, voffB); PG8_STAGE(PG8_SB(1, 1), b3 + hstep, voffB); PG8_STAGE(PG8_SA(1, 0), a3, voffA);
            PG8_WAIT_V(8); PG8_WAIT_L(0); PG8_BAR; PG8_MMA(1, 0, At, B0); PG8_MMA(1, 1, At, B1); PG8_BAR; PG8_SCHED;
            } else {
            PG8_LDB(B0, 0, 0); PG8_SCHED; PG8_LDA(At, 0, 0); PG8_STAGE(PG8_SA(1, 1), a1 + hstep, voffA);
            PG8_WAIT_L(8); PG8_BAR; PG8_WAIT_L(0); PG8_MMA(0, 0, At, B0); PG8_BAR; PG8_SCHED;
            PG8_LDB(B1, 0, 1); PG8_STAGE(PG8_SB(0, 0), b2, voffB);
            PG8_BAR; PG8_WAIT_L(0); PG8_MMA(0, 1, At, B1); PG8_BAR;
            PG8_LDA(At, 0, 1); PG8_STAGE(PG8_SA(0, 0), a2, voffA);
            PG8_BAR; PG8_WAIT_L(0); PG8_MMA(1, 0, At, B0); PG8_BAR; PG8_SCHED;
            PG8_STAGE(PG8_SB(0, 1), b2 + hstep, voffB);
            PG8_WAIT_V(6); PG8_BAR; PG8_MMA(1, 1, At, B1); PG8_BAR;
            PG8_LDB(B0, 1, 0); PG8_SCHED; PG8_LDA(At, 1, 0); PG8_STAGE(PG8_SA(0, 1), a2 + hstep, voffA);
            PG8_WAIT_L(8); PG8_BAR; PG8_WAIT_L(0); PG8_MMA(0, 0, At, B0); PG8_BAR; PG8_SCHED;
            PG8_LDB(B1, 1, 1); PG8_STAGE(PG8_SB(1, 0), b3, voffB);
            PG8_BAR; PG8_WAIT_L(0); PG8_MMA(0, 1, At, B1); PG8_BAR;
            PG8_LDA(At, 1, 1); PG8_STAGE(PG8_SA(1, 0), a3, voffA);
            PG8_BAR; PG8_WAIT_L(0); PG8_MMA(1, 0, At, B0); PG8_BAR; PG8_SCHED;
            PG8_STAGE(PG8_SB(1, 1), b3 + hstep, voffB);
            PG8_WAIT_V(6); PG8_BAR; PG8_MMA(1, 1, At, B1); PG8_BAR;
            }
        }
        if constexpr (ALIGN_EPI) { if (wr == 0) PG8_BAR; }
        if constexpr (!Epi::AFTER_DRAIN) { E(acc, cur, wr, wc, fr, fq); S.done(cur); }
        if (!has_next) break;
#pragma unroll
        for (int a = 0; a < 2; ++a)
#pragma unroll
            for (int b = 0; b < 2; ++b)
#pragma unroll
                for (int m = 0; m < 4; ++m)
#pragma unroll
                    for (int n = 0; n < 2; ++n) acc[a][b][m][n] = (f32x4){0.f, 0.f, 0.f, 0.f};
        cur = nxt; cA = nA; cB = nB; ++ui;
        if constexpr (ALIGN_EPI) { if (wr == 1) PG8_BAR; }
    }
    PG8_WAIT_V(0);
    if constexpr (!ALIGN_EPI) { if (wr == 0) PG8_BAR; }
    PG8_BAR;
    if constexpr (Epi::AFTER_DRAIN) { E.fused(acc, cur, wr, wc, fr, fq, lds, wid, lane); S.done(cur); }
#undef PG8_SA
#undef PG8_SB
#undef PG8_STAGE
#undef PG8_LDA
#undef PG8_LDB
#undef PG8_MMA
#undef PG8_WAIT_V
#undef PG8_WAIT_L
#undef PG8_BAR
#undef PG8_SCHED
}
}

constexpr int NWAVES = 8;
constexpr int BATCH = 2, SEQ = 8192, D = 1024, M = BATCH * SEQ;
constexpr int NPROJ = 3072, NIN = 3080;
constexpr int AH = 8, NB = 32;
constexpr int C_AQ = 0, C_AK = 512, C_AV = 1024, C_MQ = 1536, C_MK = 1792, C_MV = 2048, C_MO = 2560;
constexpr int MH = 4, MLC = 128, NCH = SEQ / MLC;
constexpr int DFF = 2816, NE = 8, DEX = 3584;
constexpr int MAXT = 136;
constexpr int CAP = 70;
constexpr float LN_EPS = 1e-5f, RMS_EPS = 1e-6f;
constexpr float ALPHA = 1.41421356237309515f;
constexpr float QSCALE = 0.125f * 1.4426950408889634f;

constexpr size_t MiB = 1u << 20;
constexpr size_t WS_CTL = 0, CTL_ZERO_BYTES = 1 * MiB;
constexpr size_t WS_ROPE = 1 * MiB;
constexpr size_t WS_GATES = 2 * MiB;
constexpr size_t WS_ROWMAP = 2 * MiB + 512 * 1024, WS_ROWW = 2 * MiB + 768 * 1024;
constexpr size_t WS_LIST = 3 * MiB, WS_LISTW = 3 * MiB + 512 * 1024;
constexpr size_t WS_WIN = 4 * MiB, WS_WOUT = 16 * MiB, WS_WGU = 20 * MiB, WS_WD = 31 * MiB;
constexpr size_t WS_MGU = 37 * MiB, WS_MD = 149 * MiB;
constexpr size_t WS_MIX2 = 37 * MiB;
constexpr size_t WS_XB = 205 * MiB, WS_X1B = 237 * MiB, WS_XR = 269 * MiB, WS_PROJ = 333 * MiB, WS_CAT = 429 * MiB;
constexpr size_t WS_MIX = 333 * MiB;
constexpr size_t WS_HD = 333 * MiB;
constexpr size_t WS_Y = 205 * MiB, WS_HM = 269 * MiB, WS_XS = 393 * MiB, WS_END = 461 * MiB;
static_assert(WS_HM + (size_t)CAP * 256 * DEX * 2 <= WS_XS && WS_XS + (size_t)MAXT * 256 * D * 2 <= WS_END, "MoE map");
static_assert(WS_HD + (size_t)M * DFF * 2 <= WS_CAT && WS_WD + (size_t)D * DFF * 2 <= WS_MGU && WS_WGU + (size_t)2 * DFF * D * 2 <= WS_WD, "map");
constexpr int CW_TMO = 0, CW_CODE = 1;
constexpr int CW_BAR = 4096;
constexpr int CW_ECNT = 16384;
constexpr int CW_KSUM = 65536;

constexpr int LDS_BYTES = 147456;
constexpr int MISC_OFF = LDS_BYTES - 1024;
constexpr int TEXP_OFF = MISC_OFF + 256;
constexpr int XW_OFF = 100 * 1024;

#define GAS __attribute__((address_space(1)))
#define LAS __attribute__((address_space(3)))
typedef unsigned short bf16;
typedef unsigned v4u __attribute__((ext_vector_type(4)));
typedef unsigned v2u __attribute__((ext_vector_type(2)));
typedef float f32x4 __attribute__((ext_vector_type(4)));
typedef GAS unsigned gu32;
#define RLX_AGENT __ATOMIC_RELAXED, __HIP_MEMORY_SCOPE_AGENT
#define LDS_WAIT() asm volatile("s_waitcnt lgkmcnt(0)" ::: "memory")
#define VM_WAIT() asm volatile("s_waitcnt vmcnt(0)" ::: "memory")
__device__ __forceinline__ unsigned f2bf(float f) { unsigned u = __builtin_bit_cast(unsigned, f); return (u + 0x7fffu + ((u >> 16) & 1u)) >> 16; }
__device__ __forceinline__ unsigned pk2(float lo, float hi) { return f2bf(lo) | (f2bf(hi) << 16); }
__device__ __forceinline__ float bf2f(unsigned short h) { return __builtin_bit_cast(float, (unsigned)h << 16); }
__device__ __forceinline__ float bflo(unsigned w) { return __builtin_bit_cast(float, w << 16); }
__device__ __forceinline__ float bfhi(unsigned w) { return __builtin_bit_cast(float, w & 0xffff0000u); }
#define XB_TMO      128
#define XB_XCNT(j)  (256  + 64 * (j))
#define XB_XSUB(j)  (1280 + 64 * (j))
#define XB_XGEN(j)  (2304 + 64 * (j))
#define XB_TOP      3328
#define XB_TOPGEN   3392
#define XCD_BAR_WORDS 3456
#define XB_SPIN_CAP (1u << 18)

__device__ __forceinline__ unsigned xb_ld(unsigned* p)              { return __hip_atomic_load(p, __ATOMIC_RELAXED, __HIP_MEMORY_SCOPE_AGENT); }
__device__ __forceinline__ unsigned xb_add(unsigned* p, unsigned v) { return __hip_atomic_fetch_add(p, v, __ATOMIC_RELAXED, __HIP_MEMORY_SCOPE_AGENT); }
__device__ __forceinline__ unsigned xb_xcc_id() { return (unsigned)__builtin_amdgcn_s_getreg((3 << 11) | 20) & 0xFu; }
#define XB_SPIN(cond, bar) do { unsigned _sp = 0; while (cond) { __builtin_amdgcn_s_sleep(1); \
    if ((++_sp & 255u) == 0u) { if (xb_ld(&(bar)[XB_TMO])) break; if (_sp > XB_SPIN_CAP) { atomicAdd(&(bar)[XB_TMO], 1u); break; } } } } while (0)

struct XcdBarrier {
    unsigned* bar; unsigned x;
    volatile LAS unsigned* st;
};

__device__ __forceinline__ XcdBarrier xcd_barrier_post(unsigned* bar, volatile LAS unsigned* st) {
    XcdBarrier b; b.bar = bar; b.x = xb_xcc_id(); b.st = st;
    if (threadIdx.x == 0) (void)xb_add(&bar[XB_XCNT(b.x)], 1u);
    return b;
}
__device__ __forceinline__ void xcd_barrier_complete(unsigned* bar, unsigned x, unsigned& nloc, unsigned& nx) {
    const unsigned G = gridDim.x * gridDim.y * gridDim.z;
    unsigned sum, cnt, mine, sp = 0u;
    for (;;) {
        sum = 0u; cnt = 0u; mine = 0u;
#pragma unroll
        for (unsigned j = 0; j < 16; ++j) { const unsigned c = xb_ld(&bar[XB_XCNT(j)]); sum += c; cnt += (c > 0u) ? 1u : 0u; mine = (j == x) ? c : mine; }
        if (sum == G) break;
        __builtin_amdgcn_s_sleep(1);
        if ((++sp & 255u) == 0u) { if (xb_ld(&bar[XB_TMO])) break; if (sp > XB_SPIN_CAP) { atomicAdd(&bar[XB_TMO], 1u); break; } }
    }
    nloc = mine > 0u ? mine : 1u; nx = cnt > 0u ? cnt : 1u;
}

__device__ __forceinline__ void xcd_barrier(const XcdBarrier& b) {
    asm volatile("s_waitcnt vmcnt(0)" ::: "memory");
    __syncthreads();
    if (threadIdx.x == 0) {
        unsigned* bar = b.bar;
        __builtin_amdgcn_s_waitcnt(0);
        unsigned nloc = b.st[0], nx = b.st[1];
        if (nloc == 0u) { xcd_barrier_complete(bar, b.x, nloc, nx); b.st[0] = nloc; b.st[1] = nx; }
        const unsigned old = xb_add(&bar[XB_XSUB(b.x)], 1u);
        const unsigned gen = old / nloc;
        if (old + 1u == (gen + 1u) * nloc) {
            __builtin_amdgcn_fence(__ATOMIC_RELEASE, "agent");
            asm volatile("s_waitcnt vmcnt(0)" ::: "memory");
            const unsigned og = xb_add(&bar[XB_TOP], 1u);
            const unsigned tg = og / nx;
            if (og + 1u == (tg + 1u) * nx) xb_add(&bar[XB_TOPGEN], 1u);
            else XB_SPIN(xb_ld(&bar[XB_TOPGEN]) == tg, bar);
            __builtin_amdgcn_fence(__ATOMIC_ACQUIRE, "agent");
            xb_add(&bar[XB_XGEN(b.x)], 1u);
            asm volatile("s_waitcnt vmcnt(0)" ::: "memory");
        } else {
            XB_SPIN(xb_ld(&bar[XB_XGEN(b.x)]) == gen, bar);
            __builtin_amdgcn_fence(__ATOMIC_ACQUIRE, "agent");
            asm volatile("s_waitcnt vmcnt(0)" ::: "memory");
        }
    }
    __syncthreads();
}

struct Frame {
    LAS unsigned char* lds;
    volatile LAS unsigned* MISC;
    gu32* ctl;
    int tid, lane, wave;
    int vcu, G;
    unsigned char* ws;
};
__device__ __forceinline__ float wave_sum(float v) {
#pragma unroll
    for (int o = 1; o < 64; o <<= 1) v += __shfl_xor(v, o);
    return v;
}
__device__ __forceinline__ float wave_max(float v) {
#pragma unroll
    for (int o = 1; o < 64; o <<= 1) v = fmaxf(v, __shfl_xor(v, o));
    return v;
}
__device__ __forceinline__ void transpose_item(const float* W, int ldw, int k0, int n0, bf16* WT, int K, int drow0, LAS float* scr, int lane) {
#pragma unroll 8
    for (int i = 0; i < 32; ++i) { const int kk = 2 * i + (lane >> 5); scr[kk * 33 + (lane & 31)] = W[(size_t)(k0 + kk) * ldw + n0 + (lane & 31)]; }
    LDS_WAIT(); asm volatile("" ::: "memory");
    const int c = lane & 7;
#pragma unroll
    for (int j = 0; j < 4; ++j) { const int n = (lane >> 3) + 8 * j; const LAS float* s = scr + (8 * c) * 33 + n;
        v4u o; o.x = pk2(s[0 * 33], s[1 * 33]); o.y = pk2(s[2 * 33], s[3 * 33]); o.z = pk2(s[4 * 33], s[5 * 33]); o.w = pk2(s[6 * 33], s[7 * 33]);
        *(GAS v4u*)(WT + (size_t)(drow0 + n) * K + k0 + 8 * c) = o; }
    LDS_WAIT(); asm volatile("" ::: "memory");
}
__device__ __forceinline__ void cvt_plain(const float* W, int ldw, int coff, int K, int N, bf16* WT, LAS float* scr, int it, int lane) {
    const int nblk = N / 32, kb = it / nblk, nb = it % nblk; transpose_item(W, ldw, 64 * kb, coff + 32 * nb, WT, K, 32 * nb, scr, lane);
}
__device__ __forceinline__ void cvt_gu(const float* Wg, const float* Wu, int K, int N, bf16* WT, LAS float* scr, int it, int lane) {
    const int nblk = N / 32, per = (K / 64) * nblk; const int isu = it >= per; if (isu) it -= per; const int kb = it / nblk, nb = it % nblk, n0 = 32 * nb;
    transpose_item(isu ? Wu : Wg, N, 64 * kb, n0, WT, K, (n0 / 128) * 256 + (n0 % 128) + (isu ? 128 : 0), scr, lane);
}
__device__ __forceinline__ void stage_xw(Frame& F, const float* W, int ldw, int coff) {
    LAS float* xw = (LAS float*)(F.lds + XW_OFF);
    for (int idx = F.tid; idx < 8192; idx += NWAVES * 64) { const int k = idx >> 3, g = idx & 7; xw[g * 1024 + k] = W[(size_t)k * ldw + coff + g]; }
    LDS_WAIT(); __syncthreads();
}
__device__ __forceinline__ void row_dot8(Frame& F, const f32x4 (&v)[4], float (&acc)[8]) {
    const LAS f32x4* xw = (const LAS f32x4*)(F.lds + XW_OFF);
#pragma unroll
    for (int g = 0; g < 8; ++g) { float a = 0.f;
#pragma unroll
        for (int j = 0; j < 4; ++j) { const f32x4 w = xw[g * 256 + j * 64 + F.lane]; a += v[j][0] * w[0] + v[j][1] * w[1] + v[j][2] * w[2] + v[j][3] * w[3]; }
        acc[g] = wave_sum(a); }
}
__device__ __forceinline__ float log_sigmoid(float x) { return fminf(x, 0.f) - log1pf(expf(-fabsf(x))); }
__device__ __forceinline__ void store_row_bf16(bf16* orow, const f32x4 (&y)[4], int lane) {
    GAS unsigned long long* o8 = (GAS unsigned long long*)orow + lane;
#pragma unroll
    for (int j = 0; j < 4; ++j) o8[64 * j] = (unsigned long long)pk2(y[j][0], y[j][1]) | ((unsigned long long)pk2(y[j][2], y[j][3]) << 32);
}
__device__ __forceinline__ void write_gates(Frame& F, const f32x4 (&y)[4], const float* gbias, float* grow) {
    float a[8]; row_dot8(F, y, a);
    if (F.lane < 8) { float r = 0.f;
#pragma unroll
        for (int g = 0; g < 8; ++g) if (F.lane == g) r = a[g];
        r += gbias[F.lane]; if (F.lane >= 4) r = log_sigmoid(r); grow[F.lane] = r; }
}
struct In {
    const float* x; const int* pos; const float *w_in, *gate_bias, *conv_w, *conv_b, *norm_attn, *norm_ml, *w_out, *ln1_g, *ln1_b, *dg, *du, *dd, *router_w, *router_b, *mg, *mu, *md, *ln2_g, *ln2_b;
};
__device__ __forceinline__ void p_prologue(Frame& F, const In& I) {
    unsigned char* ws = F.ws;
    stage_xw(F, I.w_in, NIN, NPROJ);
    LAS float* scr = (LAS float*)(F.lds + F.wave * 8704);
    const int gw = F.vcu * NWAVES + F.wave, NGW = F.G * NWAVES;
    constexpr int I_IN = (D / 64) * (NPROJ / 32), I_OUT = (D / 64) * (D / 32), I_GU = 2 * (D / 64) * (DFF / 32), I_DD = (DFF / 64) * (D / 32);
    constexpr int NITEMS = 2 * I_IN + 2 * I_OUT + I_GU + I_DD;
    for (int it = gw; it < NITEMS; it += NGW) {
        int r = it;
        if (r < 2 * I_IN) { const int l = r / I_IN; r -= l * I_IN; cvt_plain(I.w_in + (size_t)l * D * NIN, NIN, 0, D, NPROJ, (bf16*)(ws + WS_WIN) + (size_t)l * NPROJ * D, scr, r, F.lane); continue; } r -= 2 * I_IN;
        if (r < 2 * I_OUT) { const int l = r / I_OUT; r -= l * I_OUT; cvt_plain(I.w_out + (size_t)l * D * D, D, 0, D, D, (bf16*)(ws + WS_WOUT) + (size_t)l * D * D, scr, r, F.lane); continue; } r -= 2 * I_OUT;
        if (r < I_GU) { cvt_gu(I.dg, I.du, D, DFF, (bf16*)(ws + WS_WGU), scr, r, F.lane); continue; } r -= I_GU;
        cvt_plain(I.dd, D, 0, DFF, D, (bf16*)(ws + WS_WD), scr, r, F.lane);
    }
    for (int e = blockIdx.x * (NWAVES * 64) + F.tid; e < M * 8; e += F.G * NWAVES * 64) { const int row = e >> 3, i = e & 7;
        const float inv = powf(500000.0f, -(float)i / 8.0f); const float ang = (float)I.pos[row] * inv; float s, c; sincosf(ang, &s, &c);
        float* rp = (float*)(ws + WS_ROPE) + (size_t)row * 16; rp[i] = c; rp[8 + i] = s; }
    for (int m = gw; m < M; m += NGW) { const GAS f32x4* xr = (const GAS f32x4*)(I.x + (size_t)m * D) + F.lane; f32x4 v[4];
#pragma unroll
        for (int j = 0; j < 4; ++j) v[j] = xr[64 * j];
        store_row_bf16((bf16*)(ws + WS_XB) + (size_t)m * D, v, F.lane);
        write_gates(F, v, I.gate_bias, (float*)(ws + WS_GATES) + (size_t)m * 8); }
}
template <int ADD, int EXTRA>
__device__ __forceinline__ void ln_phase(Frame& F, const float* res, const float* addf, const bf16* y0, const bf16* y1, const float* g, const float* bt, float* outf, bf16* outb,
                                         const float* xbias, float* gates_out, int* list, float* listw) {
    const int gw = F.vcu * NWAVES + F.wave, NGW = F.G * NWAVES;
    f32x4 gv[4], bv[4];
#pragma unroll
    for (int j = 0; j < 4; ++j) { gv[j] = ((const GAS f32x4*)g)[64 * j + F.lane]; bv[j] = ((const GAS f32x4*)bt)[64 * j + F.lane]; }
    for (int m = gw; m < M; m += NGW) {
        const GAS f32x4* rr = (const GAS f32x4*)(res + (size_t)m * D) + F.lane; f32x4 v[4]; float s = 0.f;
        if (ADD == 0) { const GAS f32x4* ar = (const GAS f32x4*)(addf + (size_t)m * D) + F.lane;
#pragma unroll
            for (int j = 0; j < 4; ++j) v[j] = rr[64 * j] * ALPHA + ar[64 * j];
        } else { const GAS v2u* a0 = (const GAS v2u*)(y0 + (size_t)m * D) + F.lane; const GAS v2u* a1 = (const GAS v2u*)(y1 + (size_t)m * D) + F.lane;
#pragma unroll
            for (int j = 0; j < 4; ++j) { const v2u p = a0[64 * j], q = a1[64 * j]; const f32x4 a = {bflo(p.x) + bflo(q.x), bfhi(p.x) + bfhi(q.x), bflo(p.y) + bflo(q.y), bfhi(p.y) + bfhi(q.y)}; v[j] = rr[64 * j] * ALPHA + a; } }
#pragma unroll
        for (int j = 0; j < 4; ++j) s += (v[j][0] + v[j][1]) + (v[j][2] + v[j][3]);
        const float mean = wave_sum(s) * (1.f / D); float s2 = 0.f;
#pragma unroll
        for (int j = 0; j < 4; ++j) { v[j] = v[j] - mean; s2 += (v[j][0] * v[j][0] + v[j][1] * v[j][1]) + (v[j][2] * v[j][2] + v[j][3] * v[j][3]); }
        const float rstd = 1.f / sqrtf(wave_sum(s2) * (1.f / D) + LN_EPS);
#pragma unroll
        for (int j = 0; j < 4; ++j) v[j] = v[j] * rstd * gv[j] + bv[j];
        GAS f32x4* of = (GAS f32x4*)(outf + (size_t)m * D) + F.lane;
#pragma unroll
        for (int j = 0; j < 4; ++j) of[64 * j] = v[j];
        if (outb) store_row_bf16(outb + (size_t)m * D, v, F.lane);
        if (EXTRA == 1) write_gates(F, v, xbias, gates_out + (size_t)m * 8);
        if (EXTRA == 2) { float a[8]; row_dot8(F, v, a);
#pragma unroll
            for (int e = 0; e < 8; ++e) a[e] += xbias[e];
            int i0 = 0; float v0 = a[0];
#pragma unroll
            for (int e = 1; e < 8; ++e) if (a[e] > v0) { v0 = a[e]; i0 = e; }
            int i1 = -1; float v1 = -INFINITY;
#pragma unroll
            for (int e = 0; e < 8; ++e) if (e != i0 && a[e] > v1) { v1 = a[e]; i1 = e; }
            const float w1 = 1.f / (1.f + expf(v0 - v1)), w0 = 1.f - w1;
            if (F.lane < 2) { const int e = F.lane ? i1 : i0; const float w = F.lane ? w1 : w0;
                const unsigned p = __hip_atomic_fetch_add((unsigned*)(F.ctl + CW_ECNT + 64 * e), 1u, RLX_AGENT);
                list[(size_t)e * M + p] = m * 2 + F.lane; listw[(size_t)e * M + p] = w; } }
    }
}
__device__ __forceinline__ int moe_plan(Frame& F) {
    LAS int* texp = (LAS int*)(F.lds + TEXP_OFF);
    if (F.tid == 0) { int t = 0;
        for (int e = 0; e < NE; ++e) { const int c = (int)__hip_atomic_load((unsigned*)(F.ctl + CW_ECNT + 64 * e), RLX_AGENT); const int nt = (c + 255) >> 8; texp[MAXT + 1 + e] = t * 256;
            for (int k = 0; k < nt && t < MAXT; ++k) texp[t++] = e; }
        texp[MAXT] = t; }
    LDS_WAIT(); __syncthreads();
    return texp[MAXT];
}
__device__ __forceinline__ void moe_gather(Frame& F, int ntiles, const bf16* X1B, bf16* XS, const int* list, const float* listw, int* rowmap, float* roww) {
    const LAS int* texp = (const LAS int*)(F.lds + TEXP_OFF);
    const int gw = F.vcu * NWAVES + F.wave, NGW = F.G * NWAVES;
    for (int r = gw; r < ntiles * 256; r += NGW) { const int e = texp[r >> 8], i = r - texp[MAXT + 1 + e];
        const int c = (int)__hip_atomic_load((unsigned*)(F.ctl + CW_ECNT + 64 * e), RLX_AGENT);
        v4u a = {0u, 0u, 0u, 0u}, b = a; int ts = -1; float w = 0.f;
        if (i < c) { ts = list[(size_t)e * M + i]; w = listw[(size_t)e * M + i]; const GAS v4u* src = (const GAS v4u*)(X1B + (size_t)(ts >> 1) * D); a = src[F.lane]; b = src[64 + F.lane]; }
        GAS v4u* dst = (GAS v4u*)(XS + (size_t)r * D); dst[F.lane] = a; dst[64 + F.lane] = b;
        if (F.lane == 0) { rowmap[r] = ts; roww[r] = w; } }
}
__device__ __forceinline__ void moe_cvt(Frame& F, const In& I) {
    LAS float* scr = (LAS float*)(F.lds + F.wave * 8704);
    const int gw = F.vcu * NWAVES + F.wave, NGW = F.G * NWAVES;
    constexpr int I_GU = 2 * (D / 64) * (DEX / 32), I_DD = (DEX / 64) * (D / 32), PER = I_GU + I_DD;
    for (int it = gw; it < NE * PER; it += NGW) { const int e = it / PER; int r = it - e * PER;
        if (r < I_GU) cvt_gu(I.mg + (size_t)e * D * DEX, I.mu + (size_t)e * D * DEX, D, DEX, (bf16*)(F.ws + WS_MGU) + (size_t)e * 2 * DEX * D, scr, r, F.lane);
        else cvt_plain(I.md + (size_t)e * DEX * D, D, 0, DEX, D, (bf16*)(F.ws + WS_MD) + (size_t)e * D * DEX, scr, r - I_GU, F.lane); }
}

__device__ __forceinline__ float dot64_bf16(const LAS float* qs, const bf16* kr) {
    const GAS v4u* kp = (const GAS v4u*)kr; float a = 0.f;
#pragma unroll
    for (int c = 0; c < 8; ++c) { const v4u w = kp[c]; const LAS f32x4* q4 = (const LAS f32x4*)(qs + 8 * c); const f32x4 qa = q4[0], qb = q4[1];
        a += qa[0] * bflo(w.x) + qa[1] * bfhi(w.x) + qa[2] * bflo(w.y) + qa[3] * bfhi(w.y) + qb[0] * bflo(w.z) + qb[1] * bfhi(w.z) + qb[2] * bflo(w.w) + qb[3] * bfhi(w.w); }
    return a;
}
__device__ __forceinline__ void attn_naive(Frame& F, const bf16* PROJ, const float* ksum, const float* norm_attn, bf16* CAT, int w_lo, int w_n) {
    LAS float* qs = (LAS float*)(F.lds + F.wave * 4608); LAS float* ps = qs + 64;
    const int lane = F.lane; const int gwa = F.vcu * NWAVES + F.wave - w_lo;
    if (gwa < 0) return;
    for (int task = gwa; task < M * AH; task += w_n) {
        const int bh = task >> 13, t = task & 8191, b = bh >> 3, h = bh & 7; const size_t row = (size_t)b * SEQ + t; const int blk = t >> 8;
        qs[lane] = bf2f(PROJ[row * NPROJ + C_AQ + h * 64 + lane]); LDS_WAIT();
        float g = -INFINITY;
        if (lane < blk) { const float* km = ksum + ((size_t)(b * NB + lane) * 512 + h * 64); float a = 0.f;
            for (int d = 0; d < 64; ++d) a += qs[d] * km[d];
            g = a; }
        int sel[3];
#pragma unroll
        for (int k = 0; k < 3; ++k) { float v = g; int idx = lane;
#pragma unroll
            for (int o = 1; o < 64; o <<= 1) { const float ov = __shfl_xor(v, o); const int oi = __shfl_xor(idx, o); if (ov > v || (ov == v && oi < idx)) { v = ov; idx = oi; } }
            idx = __builtin_amdgcn_readfirstlane(idx); const bool ok = __builtin_amdgcn_readfirstlane(v > -INFINITY ? 1 : 0) != 0;
            sel[k] = ok ? idx : -1; if (lane == idx) g = -INFINITY; }
        float sc[4][4]; float mx = -INFINITY;
#pragma unroll
        for (int s = 0; s < 4; ++s) { const int jb = (s < 3) ? sel[s] : blk;
#pragma unroll
            for (int i = 0; i < 4; ++i) { float a = -INFINITY;
                if (jb >= 0) { const int kp = jb * 256 + i * 64 + lane; if (s < 3 || kp <= t) a = dot64_bf16(qs, PROJ + ((size_t)b * SEQ + kp) * NPROJ + C_AK + h * 64); }
                sc[s][i] = a; mx = fmaxf(mx, a); } }
        mx = wave_max(mx); float sum = 0.f;
#pragma unroll
        for (int s = 0; s < 4; ++s)
#pragma unroll
            for (int i = 0; i < 4; ++i) { const float p = __builtin_amdgcn_exp2f(sc[s][i] - mx); sum += p; ps[s * 256 + i * 64 + lane] = p; }
        sum = wave_sum(sum); LDS_WAIT();
        float o = 0.f;
#pragma unroll
        for (int s = 0; s < 4; ++s) { const int jb = (s < 3) ? sel[s] : blk; if (jb < 0) continue; const int kmax = (s < 3) ? 256 : (t - blk * 256 + 1);
            const bf16* vb = PROJ + ((size_t)b * SEQ + jb * 256) * NPROJ + C_AV + h * 64 + lane;
#pragma unroll 8
            for (int k = 0; k < kmax; ++k) o += ps[s * 256 + k] * bf2f(vb[(size_t)k * NPROJ]); }
        o = o / sum; const float ms = wave_sum(o * o) * (1.f / 64.f);
        o = o * (1.f / sqrtf(ms + RMS_EPS)) * norm_attn[h * 64 + lane];
        CAT[row * D + h * 64 + lane] = (bf16)f2bf(o);
        LDS_WAIT();
    }
}
__device__ __forceinline__ void mlstm_naive(Frame& F, int bh, const bf16* PROJ, const float* GATES, const float* conv_w, const float* conv_b, const float* norm_ml, bf16* CAT) {
    const int b = bh >> 2, h = bh & 3, tid = F.tid;
    LAS float* Cst = (LAS float*)(F.lds);
    LAS float* nst = (LAS float*)(F.lds + 33280);
    LAS float* qf = (LAS float*)(F.lds + 33792);
    LAS float* kf = (LAS float*)(F.lds + 67072);
    LAS bf16* vb = (LAS bf16*)(F.lds + 100352);
    LAS float* bs = (LAS float*)(F.lds + 133120);
    LAS float* ig = bs + 128;
    LAS float* mt = bs + 256;
    LAS float* wst = bs + 384;
    LAS float* scal = bs + 512;
    for (int e = tid; e < 128 * 65; e += 512) Cst[e] = 0.f;
    if (tid < 64) nst[tid] = 0.f;
    if (tid == 0) scal[0] = 0.f;
    __syncthreads();
    for (int c = 0; c < NCH; ++c) {
        const size_t row0 = (size_t)b * SEQ + (size_t)c * MLC;
        if (tid < 128) { ig[tid] = GATES[(row0 + tid) * 8 + h]; bs[tid] = GATES[(row0 + tid) * 8 + 4 + h]; }
        for (int e = tid; e < 128 * 128; e += 512) { const int t = e >> 7, cc = e & 127; const int isk = cc >> 6, d = cc & 63; const int ch = isk * 256 + h * 64 + d;
            float a = conv_b[ch];
#pragma unroll
            for (int j = 0; j < 4; ++j) { const int tt = c * MLC + t - 3 + j; if (tt >= 0) a += conv_w[j * 512 + ch] * bf2f(PROJ[((size_t)b * SEQ + tt) * NPROJ + C_MQ + ch]); }
            a = a / (1.f + expf(-a));
            if (isk) kf[t * 65 + d] = a; else qf[t * 65 + d] = a * 0.125f; }
        for (int e = tid; e < 128 * 128; e += 512) { const int t = e >> 7, vv = e & 127; vb[t * 128 + vv] = PROJ[(row0 + t) * NPROJ + C_MV + h * 128 + vv]; }
        __syncthreads();
        if (tid == 0) { const float mc = scal[0]; float run = 0.f, cm = -INFINITY;
            for (int t = 0; t < 128; ++t) { run += bs[t]; bs[t] = run; cm = fmaxf(cm, ig[t] - run); mt[t] = run + fmaxf(mc, cm); }
            const float bl = run; const float mnew = fmaxf(bl + mc, bl + cm); scal[1] = mnew; scal[2] = bl; }
        __syncthreads();
        if (tid < 128) wst[tid] = expf(scal[2] - bs[tid] + ig[tid] - scal[1]);
#pragma unroll 1
        for (int pass = 0; pass < 2; ++pass) {
            const int t = pass * 64 + (tid >> 3), vq = tid & 7; const float mc = scal[0]; const float bt = bs[t], mtt = mt[t];
            float q[64];
#pragma unroll
            for (int d = 0; d < 64; ++d) q[d] = qf[t * 65 + d];
            float num[16]; float den = 0.f;
#pragma unroll
            for (int j = 0; j < 16; ++j) num[j] = 0.f;
            const int tmax = pass * 64 + ((tid >> 6) << 3) + 7;
#pragma unroll 1
            for (int s = 0; s <= tmax; ++s) { if (s <= t) { float dot = 0.f;
#pragma unroll
                    for (int d = 0; d < 64; ++d) dot += q[d] * kf[s * 65 + d];
                    const float sw = dot * expf(bt - bs[s] + ig[s] - mtt); den += sw;
#pragma unroll
                    for (int j = 0; j < 16; ++j) num[j] += sw * bf2f(vb[s * 128 + vq * 16 + j]); } }
            const float wi = expf(bt + mc - mtt); float nq = 0.f;
#pragma unroll
            for (int d = 0; d < 64; ++d) nq += nst[d] * q[d];
            den += wi * nq;
            { float cq[16];
#pragma unroll
              for (int j = 0; j < 16; ++j) cq[j] = 0.f;
#pragma unroll 1
              for (int d = 0; d < 64; ++d) { const float qd = qf[t * 65 + d]; const LAS float* cr = Cst + (vq * 16) * 65 + d;
#pragma unroll
                  for (int j = 0; j < 16; ++j) cq[j] += cr[j * 65] * qd; }
#pragma unroll
              for (int j = 0; j < 16; ++j) num[j] += wi * cq[j]; }
            const float dn = 1.f / fmaxf(fabsf(den), expf(-mtt)); float ss = 0.f;
#pragma unroll
            for (int j = 0; j < 16; ++j) { num[j] *= dn; ss += num[j] * num[j]; }
            ss += __shfl_xor(ss, 1); ss += __shfl_xor(ss, 2); ss += __shfl_xor(ss, 4);
            const float rs = 1.f / sqrtf(ss * (1.f / 128.f) + RMS_EPS);
            const size_t row = row0 + t; const bf16* mo = PROJ + row * NPROJ + C_MO + h * 128 + vq * 16; bf16* out = CAT + row * D + 512 + h * 128 + vq * 16; const float* gn = norm_ml + h * 128 + vq * 16;
#pragma unroll
            for (int j = 0; j < 16; ++j) { const float o = bf2f(mo[j]); out[j] = (bf16)f2bf(num[j] * rs * gn[j] / (1.f + expf(-o))); }
        }
        __syncthreads();
        {
            const float cs = expf(scal[2] + scal[0] - scal[1]);
            for (int e = tid; e < 128 * 64; e += 512) { const int vv = e >> 6, d = e & 63; float a = 0.f;
                for (int s = 0; s < 128; ++s) a += wst[s] * bf2f(vb[s * 128 + vv]) * kf[s * 65 + d];
                Cst[vv * 65 + d] = cs * Cst[vv * 65 + d] + a; }
            if (tid < 64) { float a = 0.f; for (int s = 0; s < 128; ++s) a += wst[s] * kf[s * 65 + tid]; nst[tid] = cs * nst[tid] + a; }
        }
        __syncthreads();
        if (tid == 0) scal[0] = scal[1];
        __syncthreads();
    }
}

constexpr int N_PHASES = 18;
struct Args { In in; float* out; unsigned char* ws; int ph_lo, ph_hi; };
__global__ void __launch_bounds__(NWAVES * 64, 2) hymba_fwd(Args args) {
    extern __shared__ __attribute__((aligned(16))) unsigned char lds[];
    Frame F;
    F.lds = (LAS unsigned char*)lds;
    F.MISC = (volatile LAS unsigned*)(F.lds + MISC_OFF);
    F.tid = threadIdx.x; F.lane = F.tid & 63; F.wave = __builtin_amdgcn_readfirstlane(F.tid >> 6);
    F.G = gridDim.x; { const int bx = blockIdx.x; F.vcu = (F.G % 8 == 0) ? (bx % 8) * (F.G / 8) + bx / 8 : bx; }
    F.ws = args.ws; unsigned char* ws = args.ws;
    F.ctl = (gu32*)(ws + WS_CTL);
    const In& I = args.in;
    for (int u = F.tid; u < (LDS_BYTES - MISC_OFF) / 4; u += NWAVES * 64) ((LAS unsigned*)(F.lds + MISC_OFF))[u] = 0u;
    __syncthreads();
    const int lo = args.ph_lo, hi = args.ph_hi;
    const bool multi = (hi - lo) > 1;
    XcdBarrier bar; bar.bar = (unsigned*)(F.ctl + CW_BAR); bar.x = 0; bar.st = nullptr;
    if (multi) bar = xcd_barrier_post((unsigned*)(F.ctl + CW_BAR), F.MISC + 8);
#define IN(k) (lo <= (k) && (k) < hi)
#define SEAM(k) do { if (IN(k) && IN((k) + 1)) xcd_barrier(bar); } while (0)
    bf16* XB = (bf16*)(ws + WS_XB); bf16* X1B = (bf16*)(ws + WS_X1B); float* XR = (float*)(ws + WS_XR); bf16* PROJ = (bf16*)(ws + WS_PROJ); bf16* CAT = (bf16*)(ws + WS_CAT);
    float* MIX = (float*)(ws + WS_MIX); float* MIX2 = (float*)(ws + WS_MIX2); bf16* HD = (bf16*)(ws + WS_HD); float* GATES = (float*)(ws + WS_GATES);
    const float* ROPE = (const float*)(ws + WS_ROPE);
    int* LIST = (int*)(ws + WS_LIST); float* LISTW = (float*)(ws + WS_LISTW); int* ROWMAP = (int*)(ws + WS_ROWMAP); float* ROWW = (float*)(ws + WS_ROWW);
    bf16* YB = (bf16*)(ws + WS_Y); bf16* HM = (bf16*)(ws + WS_HM); bf16* XS = (bf16*)(ws + WS_XS);

    if (IN(0)) { p_prologue(F, I); } SEAM(0);

#define LAYER_MIXER(L, P)                                                                                                                                   \
    if (IN(P)) {                                                                                                                          \
        pg8::Gemm g{XB, (const bf16*)(ws + WS_WIN) + (size_t)(L) * NPROJ * D, M, NPROJ, D}; pg8::StaticOrder S; S.init(M, NPROJ, F.G, (int)blockIdx.x);     \
        pg8::EpiProj E{PROJ, ROPE, (float*)(F.ctl + CW_KSUM) + (L) * (BATCH * NB * 512), QSCALE};                                                          \
        pg8::gemm_phase<pg8::EpiProj, pg8::StaticOrder, true, true>(F.lds, g, S, E); } SEAM(P);                                                             \
    if (IN((P) + 1)) {                                                              \
        if (F.vcu < 8) mlstm_naive(F, F.vcu, PROJ, GATES, I.conv_w + (L) * 2048, I.conv_b + (L) * 512, I.norm_ml + (L) * 512, CAT);                         \
        else attn_naive(F, PROJ, (const float*)(F.ctl + CW_KSUM) + (L) * (BATCH * NB * 512), I.norm_attn + (L) * 512, CAT, 64, F.G * NWAVES - 64); } SEAM((P) + 1); \
    if (IN((P) + 2)) {                                                                                                                   \
        pg8::Gemm g{CAT, (const bf16*)(ws + WS_WOUT) + (size_t)(L) * D * D, M, D, D}; pg8::StaticOrder S; S.init(M, D, F.G, (int)blockIdx.x);                \
        pg8::EpiF32 E{MIX, D};                                                                                                                              \
        pg8::gemm_phase<pg8::EpiF32, pg8::StaticOrder, false, true>(F.lds, g, S, E); } SEAM((P) + 2);

    LAYER_MIXER(0, 1)
    if (IN(4)) { ln_phase<0, 0>(F, I.x, MIX, nullptr, nullptr, I.ln1_g, I.ln1_b, args.out, X1B, nullptr, nullptr, nullptr, nullptr); } SEAM(4);
    if (IN(5)) {
        pg8::Gemm g{X1B, (const bf16*)(ws + WS_WGU), M, 2 * DFF, D}; pg8::StaticOrder S; S.init(M, 2 * DFF, F.G, (int)blockIdx.x);
        pg8::EpiSwiglu E{HD, DFF, 0};
        pg8::gemm_phase<pg8::EpiSwiglu, pg8::StaticOrder, true, true>(F.lds, g, S, E); } SEAM(5);
    if (IN(6)) {
        pg8::Gemm g{HD, (const bf16*)(ws + WS_WD), M, D, DFF}; pg8::StaticOrder S; S.init(M, D, F.G, (int)blockIdx.x);
        pg8::EpiF32 E{MIX2, D};
        pg8::gemm_phase<pg8::EpiF32, pg8::StaticOrder, false, true>(F.lds, g, S, E); } SEAM(6);
    if (IN(7)) { stage_xw(F, I.w_in + (size_t)D * NIN, NIN, NPROJ);
        ln_phase<0, 1>(F, args.out, MIX2, nullptr, nullptr, I.ln2_g, I.ln2_b, XR, XB, I.gate_bias + 8, GATES, nullptr, nullptr); } SEAM(7);
    LAYER_MIXER(1, 8)
    if (IN(11)) { stage_xw(F, I.router_w, 8, 0);
        ln_phase<0, 2>(F, XR, MIX, nullptr, nullptr, I.ln1_g + D, I.ln1_b + D, args.out, X1B, I.router_b, nullptr, LIST, LISTW);
        __syncthreads(); moe_cvt(F, I); } SEAM(11);
    int ntiles = 0;
    if (lo <= 16 && hi > 12) ntiles = moe_plan(F);
    if (IN(12)) { moe_gather(F, ntiles, X1B, XS, LIST, LISTW, ROWMAP, ROWW); } SEAM(12);
    const PG8_LAS int* texp = (const PG8_LAS int*)(F.lds + TEXP_OFF);
#define MOE_PASS(P, T0)                                                                                                                                     \
    if (IN(P)) { const int t0 = (T0), t1 = (ntiles < (T0) + CAP) ? ntiles : (T0) + CAP;                                                                     \
        pg8::Gemm g{XS, (const bf16*)(ws + WS_MGU), MAXT * 256, 2 * DEX, D}; pg8::GroupedOrder<false> S; S.init(t0, t1, 2 * DEX / 256, F.G, (int)blockIdx.x, texp); \
        pg8::EpiSwiglu E{HM, DEX, t0};                                                                                                                      \
        pg8::gemm_phase<pg8::EpiSwiglu, pg8::GroupedOrder<false>, true, true>(F.lds, g, S, E); } SEAM(P);                                                   \
    if (IN((P) + 1)) { const int t0 = (T0), t1 = (ntiles < (T0) + CAP) ? ntiles : (T0) + CAP;                                                               \
        pg8::Gemm g{HM, (const bf16*)(ws + WS_MD), CAP * 256, D, DEX}; pg8::GroupedOrder<true> S; S.init(t0, t1, D / 256, F.G, (int)blockIdx.x, texp);        \
        pg8::EpiScatter E{YB, ROWMAP, ROWW, t0, M};                                                                                                         \
        pg8::gemm_phase<pg8::EpiScatter, pg8::GroupedOrder<true>, true, true>(F.lds, g, S, E); } SEAM((P) + 1);
    MOE_PASS(13, 0)
    MOE_PASS(15, CAP)
    if (IN(17)) { ln_phase<1, 0>(F, args.out, nullptr, YB, YB + (size_t)M * D, I.ln2_g + D, I.ln2_b + D, args.out, nullptr, nullptr, nullptr, nullptr, nullptr); }
#undef IN
#undef SEAM
}

extern "C" void kernel_launch(void* const* d_in, const int* in_sizes, int n_in, void* d_out, int out_size, void* d_ws, size_t ws_size, hipStream_t stream) {
    static int grid = 0;
    if (grid == 0) {
        if (n_in != 21 || in_sizes[0] != M * D || out_size != M * D || ws_size < WS_END) { fprintf(stderr, "kernel_launch: unexpected shapes (n_in %d, in0 %d, out %d, ws %zu < %zu); nothing launched\n", n_in, n_in > 0 ? in_sizes[0] : -1, out_size, ws_size, (size_t)WS_END); grid = -1; return; }
        int dev = 0, cus = 0, per_cu = 0;
        if (hipGetDevice(&dev) != hipSuccess || hipDeviceGetAttribute(&cus, hipDeviceAttributeMultiprocessorCount, dev) != hipSuccess) { grid = -1; return; }
        if (hipFuncSetAttribute((const void*)hymba_fwd, hipFuncAttributeMaxDynamicSharedMemorySize, LDS_BYTES) != hipSuccess) { fprintf(stderr, "kernel_launch: hipFuncSetAttribute failed\n"); grid = -1; return; }
        if (hipOccupancyMaxActiveBlocksPerMultiprocessor(&per_cu, (const void*)hymba_fwd, NWAVES * 64, LDS_BYTES) != hipSuccess || per_cu < 1) fprintf(stderr, "kernel_launch: occupancy query reports %d\n", per_cu);
        (void)hipGetLastError();
        grid = cus;
    }
    if (grid < 0) return;
    if (hipMemsetAsync((char*)d_ws + WS_CTL, 0, CTL_ZERO_BYTES, stream) != hipSuccess) return;
    Args a{};
    const void** ip = (const void**)&a.in;
    for (int i = 0; i < 21; ++i) ip[i] = d_in[i];
    a.out = (float*)d_out; a.ws = (unsigned char*)d_ws;
#ifndef MK_ONE
    for (int p = 0; p < N_PHASES; ++p) { a.ph_lo = p; a.ph_hi = p + 1;
        hipLaunchKernelGGL(hymba_fwd, dim3(grid), dim3(NWAVES * 64), LDS_BYTES, stream, a); }
#else
    a.ph_lo = 0; a.ph_hi = N_PHASES;
    hipLaunchKernelGGL(hymba_fwd, dim3(grid), dim3(NWAVES * 64), LDS_BYTES, stream, a);
#endif
}
```

```cpp
#include <hip/hip_runtime.h>
#include <cstdio>
#include <cstdint>
#include <cmath>
namespace pg8 {
#define PG8_LAS __attribute__((address_space(3)))
typedef unsigned short bf16_t;
typedef short bf16x8 __attribute__((ext_vector_type(8)));
typedef float f32x4 __attribute__((ext_vector_type(4)));
typedef unsigned u32x4 __attribute__((ext_vector_type(4)));
constexpr int BM = 256, BK = 64, HALF = 128, HTB = HALF * BK * 2  , STAGE_BYTES = 8 * HTB, NXCD = 8, WGM = 8;

__host__ __device__ __forceinline__ int lds_byte(int r, int c) { const int st = (r >> 4) * 2 + (c >> 5), rr = r & 15, cc = c & 31, ob = rr * 64 + cc * 2; return st * 1024 + (ob ^ (((ob >> 9) & 1) << 5)); }
__host__ __device__ __forceinline__ void stage_rc(int b, int& R, int& C) { const int st = b / 1024, sb = b % 1024, swz = sb ^ (((sb >> 9) & 1) << 5); R = (st >> 1) * 16 + swz / 64; C = (st & 1) * 32 + (swz % 64) / 2; }
__host__ __device__ __forceinline__ int perm32(int rho) { const int n = rho >> 4, i = rho & 15; return 8 * (i >> 2) + 4 * n + (i & 3); }

struct Unit { int pm, pn, pb; };
struct Gemm { const bf16_t* A; const bf16_t* Bt; int M, N, K; };

struct StaticOrder {
    int nM, nN, nwg, G, c;
    __host__ __device__ void init(int M, int N, int G_, int c_) { nM = M / BM; nN = N / BM; nwg = nM * nN; G = G_; c = c_; }
    __host__ __device__ bool next(int i, Unit& u) const {
        const long L = (long)i * G + c; if (L >= nwg) return false;
        int wgid = (int)L; { const int q = nwg / NXCD, r = nwg % NXCD, xcd = wgid % NXCD, off = wgid / NXCD; wgid = (xcd < r ? xcd * (q + 1) : r * (q + 1) + (xcd - r) * q) + off; }
        const int nig = WGM * nN, gid = wgid / nig, fm = gid * WGM, gsz = (nM - fm) < WGM ? (nM - fm) : WGM;
        u.pm = fm + ((wgid % nig) % gsz); u.pn = (wgid % nig) / gsz; u.pb = u.pn; return true;
    }
    __device__ __forceinline__ void a_ready(const Unit&) const {}
    __device__ __forceinline__ void done(const Unit&) const {}
};


__device__ __forceinline__ unsigned cvt_pk_bf16(float lo, float hi) { unsigned r; asm volatile("v_cvt_pk_bf16_f32 %0, %1, %2" : "=v"(r) : "v"(lo), "v"(hi)); return r; }
__device__ __forceinline__ u32x4 pack8(const f32x4 v0, const f32x4 v1) { u32x4 w; w.x = cvt_pk_bf16(v0[0], v0[1]); w.y = cvt_pk_bf16(v0[2], v0[3]); w.z = cvt_pk_bf16(v1[0], v1[1]); w.w = cvt_pk_bf16(v1[2], v1[3]); return w; }
__device__ __forceinline__ f32x4 shx16(const f32x4 v) { f32x4 r; r[0] = __shfl_xor(v[0], 16); r[1] = __shfl_xor(v[1], 16); r[2] = __shfl_xor(v[2], 16); r[3] = __shfl_xor(v[3], 16); return r; }

struct EpiF32 {
    static constexpr bool PERM = false, AFTER_DRAIN = false;
    float* C; int ldc;
    __device__ __forceinline__ void operator()(const f32x4 (&acc)[2][2][4][2], const Unit& u, int wr, int wc, int fr, int fq) const {
        const int row0 = u.pm * BM + wr * 64 + fr, col0 = u.pn * BM + wc * 32 + 4 * fq;
#pragma unroll
        for (int ai = 0; ai < 2; ++ai)
#pragma unroll
            for (int m = 0; m < 4; ++m) { float* rowp = C + (size_t)(row0 + ai * HALF + m * 16) * ldc + col0;
#pragma unroll
                for (int bj = 0; bj < 2; ++bj)
#pragma unroll
                    for (int n = 0; n < 2; ++n) *(f32x4*)(rowp + bj * HALF + n * 16) = acc[ai][bj][m][n]; }
    }
};

struct EpiProj {
    static constexpr bool PERM = true, AFTER_DRAIN = false;
    bf16_t* O; const float* rope; float* ksum; float qscale;
    __device__ __forceinline__ void operator()(const f32x4 (&acc)[2][2][4][2], const Unit& u, int wr, int wc, int fr, int fq) const {
        const int row0 = u.pm * BM + wr * 64 + fr; const int colt = u.pn * BM; const int col0 = colt + wc * 32 + 8 * fq;
        const bool is_qk = u.pn < 4, is_q = u.pn < 2, rot = is_qk && ((wc & 1) == 0);
        float ks[2][8];
#pragma unroll
        for (int bj = 0; bj < 2; ++bj)
#pragma unroll
            for (int i = 0; i < 8; ++i) ks[bj][i] = 0.f;
#pragma unroll
        for (int ai = 0; ai < 2; ++ai)
#pragma unroll
            for (int m = 0; m < 4; ++m) { const int row = row0 + ai * HALF + m * 16; bf16_t* rowp = O + (size_t)row * 3072 + col0;
                f32x4 c0 = {1.f, 1.f, 1.f, 1.f}, c1 = c0, s0 = {0.f, 0.f, 0.f, 0.f}, s1 = s0;
                if (rot && fq < 2) { const f32x4* rp = (const f32x4*)(rope + (size_t)row * 16); c0 = rp[0]; c1 = rp[1]; s0 = rp[2]; s1 = rp[3]; if (fq == 0) { s0 = -s0; s1 = -s1; } }
#pragma unroll
                for (int bj = 0; bj < 2; ++bj) { f32x4 v0 = acc[ai][bj][m][0], v1 = acc[ai][bj][m][1];
                    if (rot) { const f32x4 p0 = shx16(v0), p1 = shx16(v1); v0 = v0 * c0 + p0 * s0; v1 = v1 * c1 + p1 * s1; }
                    if (is_q) { v0 = v0 * qscale; v1 = v1 * qscale; }
                    else if (is_qk) {
#pragma unroll
                        for (int i = 0; i < 4; ++i) { ks[bj][i] += v0[i]; ks[bj][4 + i] += v1[i]; } }
                    *(u32x4*)(rowp + bj * HALF) = pack8(v0, v1); } }
        if (is_qk && !is_q) {
            float* kd = ksum + (size_t)u.pm * 512 + (colt - 512) + wc * 32 + 8 * fq;
#pragma unroll
            for (int bj = 0; bj < 2; ++bj)
#pragma unroll
                for (int i = 0; i < 8; ++i) { float s = ks[bj][i]; s += __shfl_xor(s, 1); s += __shfl_xor(s, 2); s += __shfl_xor(s, 4); s += __shfl_xor(s, 8);
                    if (fr == 0) __hip_atomic_fetch_add(kd + bj * HALF + i, s, __ATOMIC_RELAXED, __HIP_MEMORY_SCOPE_AGENT); }
        }
    }
};

__device__ __forceinline__ float silu_f(float x) { return x * __builtin_amdgcn_rcpf(1.0f + __builtin_amdgcn_exp2f(-1.4426950408889634f * x)); }
struct EpiSwiglu {
    static constexpr bool PERM = true, AFTER_DRAIN = false;
    bf16_t* H; int ldh; int pm_off;
    __device__ __forceinline__ void operator()(const f32x4 (&acc)[2][2][4][2], const Unit& u, int wr, int wc, int fr, int fq) const {
        const int row0 = (u.pm - pm_off) * BM + wr * 64 + fr; const int col0 = u.pn * HALF + wc * 32 + 8 * fq;
#pragma unroll
        for (int ai = 0; ai < 2; ++ai)
#pragma unroll
            for (int m = 0; m < 4; ++m) { bf16_t* rowp = H + (size_t)(row0 + ai * HALF + m * 16) * ldh + col0;
                const f32x4 g0 = acc[ai][0][m][0], g1 = acc[ai][0][m][1], u0 = acc[ai][1][m][0], u1 = acc[ai][1][m][1]; f32x4 h0, h1;
#pragma unroll
                for (int i = 0; i < 4; ++i) { h0[i] = silu_f(g0[i]) * u0[i]; h1[i] = silu_f(g1[i]) * u1[i]; }
                *(u32x4*)rowp = pack8(h0, h1); }
    }
};
struct EpiScatter {
    static constexpr bool PERM = true, AFTER_DRAIN = false;
    bf16_t* Y; const int* rowmap; const float* roww; int pm_off; int mtok;
    __device__ __forceinline__ void operator()(const f32x4 (&acc)[2][2][4][2], const Unit& u, int wr, int wc, int fr, int fq) const {
        const int row0 = (u.pm + pm_off) * BM + wr * 64 + fr; const int col0 = u.pn * BM + wc * 32 + 8 * fq;
#pragma unroll
        for (int ai = 0; ai < 2; ++ai)
#pragma unroll
            for (int m = 0; m < 4; ++m) { const int r = row0 + ai * HALF + m * 16; const int ts = rowmap[r];
                if (ts >= 0) { const float w = roww[r]; bf16_t* rowp = Y + ((size_t)(ts & 1) * mtok + (ts >> 1)) * 1024 + col0;
#pragma unroll
                    for (int bj = 0; bj < 2; ++bj) *(u32x4*)(rowp + bj * HALF) = pack8(acc[ai][bj][m][0] * w, acc[ai][bj][m][1] * w); } }
    }
};
template <bool REL> struct GroupedOrder {
    int t0, nM, nN, nwg, G, c; const PG8_LAS int* texp;
    __device__ __forceinline__ void init(int t0_, int t1_, int nN_, int G_, int c_, const PG8_LAS int* texp_) { t0 = t0_; nM = t1_ - t0_; if (nM < 0) nM = 0; nN = nN_; nwg = nM * nN; G = G_; c = c_; texp = texp_; }
    __device__ __forceinline__ bool next(int i, Unit& u) const {
        const long L = (long)i * G + c; if (L >= nwg) return false;
        int wgid = (int)L; { const int q = nwg / NXCD, r = nwg % NXCD, xcd = wgid % NXCD, off = wgid / NXCD; wgid = (xcd < r ? xcd * (q + 1) : r * (q + 1) + (xcd - r) * q) + off; }
        const int nig = WGM * nN, gid = wgid / nig, fm = gid * WGM, gsz = (nM - fm) < WGM ? (nM - fm) : WGM;
        const int pmr = fm + ((wgid % nig) % gsz); u.pn = (wgid % nig) / gsz; u.pm = REL ? pmr : (t0 + pmr); u.pb = texp[t0 + pmr] * nN + u.pn; return true;
    }
    __device__ __forceinline__ void a_ready(const Unit&) const {}
    __device__ __forceinline__ void done(const Unit&) const {}
};
template <class Epi, class Sched, bool ALIGN_EPI = false, bool SP2 = false>
__device__ __forceinline__ void gemm_phase(PG8_LAS unsigned char* lds, const Gemm g, const Sched& S, const Epi& E) {
    const int tid = threadIdx.x, wid = __builtin_amdgcn_readfirstlane(tid >> 6), lane = tid & 63, wr = wid >> 2, wc = wid & 3, fr = lane & 15, fq = lane >> 4;
    const int K = g.K, nt = K / BK;
    unsigned voffA[2], voffB[2];
#pragma unroll
    for (int i = 0; i < 2; ++i) { int R, C; stage_rc(tid * 16 + i * 8192, R, C); const int Rb = Epi::PERM ? ((R & ~31) + perm32(R & 31)) : R;
        voffA[i] = (unsigned)(R * K + C) * 2u; voffB[i] = (unsigned)(Rb * K + C) * 2u; }
    const size_t kstep = (size_t)(BK * 2);
    const size_t hstep = (size_t)HALF * K * 2;
    const size_t tstep = 2 * hstep;
    const unsigned ldsw = (unsigned)wid * 1024u;
    const int aoff = lds_byte(wr * 64 + fr, fq * 8), boff = lds_byte(wc * 32 + fr, fq * 8);
#define PG8_SA(b, h) (((b) * 2 + (h)) * HTB)
#define PG8_SB(b, h) ((4 + (b) * 2 + (h)) * HTB)
#define PG8_STAGE(bufoff, gbase, voff) do { _Pragma("unroll") for (int _i = 0; _i < 2; ++_i) \
        __builtin_amdgcn_global_load_lds((const unsigned*)((const char*)(gbase) + (voff)[_i]), (PG8_LAS unsigned*)(lds + (bufoff) + ldsw + _i * 8192), 16, 0, 0); } while (0)
#define PG8_LDA(dst, b, h) do { _Pragma("unroll") for (int m = 0; m < 4; ++m) _Pragma("unroll") for (int k = 0; k < 2; ++k) dst[m][k] = *(const PG8_LAS bf16x8*)(lds + PG8_SA(b, h) + aoff + m * 2048 + k * 1024); } while (0)
#define PG8_LDB(dst, b, h) do { _Pragma("unroll") for (int n = 0; n < 2; ++n) _Pragma("unroll") for (int k = 0; k < 2; ++k) dst[n][k] = *(const PG8_LAS bf16x8*)(lds + PG8_SB(b, h) + boff + n * 2048 + k * 1024); } while (0)
#define PG8_MMA(ai, bj, At, Bt) do { __builtin_amdgcn_s_setprio(1); _Pragma("unroll") for (int m = 0; m < 4; ++m) _Pragma("unroll") for (int n = 0; n < 2; ++n) _Pragma("unroll") for (int k = 0; k < 2; ++k) \
        acc[ai][bj][m][n] = __builtin_amdgcn_mfma_f32_16x16x32_bf16(Bt[n][k], At[m][k], acc[ai][bj][m][n], 0, 0, 0); __builtin_amdgcn_s_setprio(0); } while (0)
#define PG8_WAIT_V(n) asm volatile("s_waitcnt vmcnt(" #n ")" ::: "memory")
#define PG8_WAIT_L(n) asm volatile("s_waitcnt lgkmcnt(" #n ")" ::: "memory")
#define PG8_BAR __builtin_amdgcn_s_barrier()
#define PG8_SCHED __builtin_amdgcn_sched_barrier(0)
    Unit cur, nxt; int ui = 0;
    if (!S.next(0, cur)) return;
    f32x4 acc[2][2][4][2];
#pragma unroll
    for (int a = 0; a < 2; ++a)
#pragma unroll
        for (int b = 0; b < 2; ++b)
#pragma unroll
            for (int m = 0; m < 4; ++m)
#pragma unroll
                for (int n = 0; n < 2; ++n) acc[a][b][m][n] = (f32x4){0.f, 0.f, 0.f, 0.f};
    bf16x8 At[4][2], B0[2][2], B1[2][2];
    const char* cA = (const char*)g.A + (size_t)cur.pm * tstep; const char* cB = (const char*)g.Bt + (size_t)cur.pb * tstep;
    S.a_ready(cur);
    if constexpr (SP2) {
        PG8_STAGE(PG8_SB(0, 0), cB, voffB); PG8_STAGE(PG8_SB(0, 1), cB + hstep, voffB); PG8_STAGE(PG8_SA(0, 0), cA, voffA); PG8_STAGE(PG8_SA(0, 1), cA + hstep, voffA);
        if (wr == 1) PG8_BAR;
        PG8_WAIT_V(2); PG8_BAR;
        PG8_STAGE(PG8_SB(1, 0), cB + kstep, voffB); PG8_STAGE(PG8_SA(1, 0), cA + kstep, voffA); PG8_STAGE(PG8_SB(1, 1), cB + hstep + kstep, voffB);
        PG8_WAIT_V(6); PG8_BAR;
    } else {
        PG8_STAGE(PG8_SB(0, 0), cB, voffB); PG8_STAGE(PG8_SA(0, 0), cA, voffA); PG8_STAGE(PG8_SB(0, 1), cB + hstep, voffB); PG8_STAGE(PG8_SA(0, 1), cA + hstep, voffA);
        if (wr == 1) PG8_BAR;
        PG8_WAIT_V(4); PG8_BAR;
        PG8_STAGE(PG8_SB(1, 0), cB + kstep, voffB); PG8_STAGE(PG8_SA(1, 0), cA + kstep, voffA); PG8_STAGE(PG8_SB(1, 1), cB + hstep + kstep, voffB);
        PG8_WAIT_V(6); PG8_BAR;
    }
    for (;;) {
        const bool has_next = S.next(ui + 1, nxt);
        const char* nA = has_next ? (const char*)g.A + (size_t)nxt.pm * tstep : cA; const char* nB = has_next ? (const char*)g.Bt + (size_t)nxt.pb * tstep : cB;
        for (int t = 0; t < nt; t += 2) {
            const bool last = (t == nt - 2);
            const char* a1 = cA + (size_t)(t + 1) * kstep;
            const char* a2 = last ? nA : cA + (size_t)(t + 2) * kstep; const char* b2 = last ? nB : cB + (size_t)(t + 2) * kstep;
            const char* a3 = a2 + kstep; const char* b3 = b2 + kstep;
            if (last && has_next) S.a_ready(nxt);
            if constexpr (SP2) {
            PG8_LDB(B0, 0, 0); PG8_LDB(B1, 0, 1); PG8_SCHED; PG8_LDA(At, 0, 0); PG8_STAGE(PG8_SA(1, 1), a1 + hstep, voffA);
            PG8_WAIT_V(8); PG8_WAIT_L(0); PG8_BAR; PG8_MMA(0, 0, At, B0); PG8_MMA(0, 1, At, B1); PG8_BAR; PG8_SCHED;
            PG8_LDA(At, 0, 1); PG8_STAGE(PG8_SB(0, 0), b2, voffB); PG8_STAGE(PG8_SB(0, 1), b2 + hstep, voffB); PG8_STAGE(PG8_SA(0, 0), a2, voffA);
            PG8_WAIT_V(8); PG8_WAIT_L(0); PG8_BAR; PG8_MMA(1, 0, At, B0); PG8_MMA(1, 1, At, B1); PG8_BAR; PG8_SCHED;
            PG8_LDB(B0, 1, 0); PG8_LDB(B1, 1, 1); PG8_SCHED; PG8_LDA(At, 1, 0); PG8_STAGE(PG8_SA(0, 1), a2 + hstep, voffA);
            PG8_WAIT_V(8); PG8_WAIT_L(0); PG8_BAR; PG8_MMA(0, 0, At, B0); PG8_MMA(0, 1, At, B1); PG8_BAR; PG8_SCHED;
            PG8_LDA(At, 1, 1); PG8_STAGE(PG8_SB(1, 0), b3, voffB); PG8_STAGE(PG8_SB(1, 1), b3 + hstep, voffB); PG8_STAGE(PG8_SA(1, 0), a3, voffA);
            PG8_WAIT_V(8); PG8_WAIT_L(0); PG8_BAR; PG8_MMA(1, 0, At, B0); PG8_MMA(1, 1, At, B1); PG8_BAR; PG8_SCHED;
            } else {
            PG8_LDB(B0, 0, 0); PG8_SCHED; PG8_LDA(At, 0, 0); PG8_STAGE(PG8_SA(1, 1), a1 + hstep, voffA);
            PG8_WAIT_L(8); PG8_BAR; PG8_WAIT_L(0); PG8_MMA(0, 0, At, B0); PG8_BAR; PG8_SCHED;
            PG8_LDB(B1, 0, 1); PG8_STAGE(PG8_SB(0, 0), b2, voffB);
            PG8_BAR; PG8_WAIT_L(0); PG8_MMA(0, 1, At, B1); PG8_BAR;
            PG8_LDA(At, 0, 1); PG8_STAGE(PG8_SA(0, 0), a2, voffA);
            PG8_BAR; PG8_WAIT_L(0); PG8_MMA(1, 0, At, B0); PG8_BAR; PG8_SCHED;
            PG8_STAGE(PG8_SB(0, 1), b2 + hstep, voffB);
            PG8_WAIT_V(6); PG8_BAR; PG8_MMA(1, 1, At, B1); PG8_BAR;
            PG8_LDB(B0, 1, 0); PG8_SCHED; PG8_LDA(At, 1, 0); PG8_STAGE(PG8_SA(0, 1), a2 + hstep, voffA);
            PG8_WAIT_L(8); PG8_BAR; PG8_WAIT_L(0); PG8_MMA(0, 0, At, B0); PG8_BAR; PG8_SCHED;
            PG8_LDB(B1, 1, 1); PG8_STAGE(PG8_SB(1, 0), b3, voffB);
            PG8_BAR; PG8_WAIT_L(0); PG8_MMA(0, 1, At, B1); PG8_BAR;
            PG8_LDA(At, 1, 1); PG8_STAGE(PG8_SA(1, 0), a3, voffA);
            PG8_BAR; PG8_WAIT_L(0); PG8_MMA(1, 0, At, B0); PG8_BAR; PG8_SCHED;
            PG8_STAGE(PG8_SB(1, 1), b3 + hstep, voffB);
            PG8_WAIT_V(6); PG8_BAR; PG8_MMA(1, 1, At, B1); PG8_BAR;
            }
        }
        if constexpr (ALIGN_EPI) { if (wr == 0) PG8_BAR; }
        if constexpr (!Epi::AFTER_DRAIN) { E(acc, cur, wr, wc, fr, fq); S.done(cur); }
        if (!has_next) break;
#pragma unroll
        for (int a = 0; a < 2; ++a)
#pragma unroll
            for (int b = 0; b < 2; ++b)
#pragma unroll
                for (int m = 0; m < 4; ++m)
#pragma unroll
                    for (int n = 0; n < 2; ++n) acc[a][b][m][n] = (f32x4){0.f, 0.f, 0.f, 0.f};
        cur = nxt; cA = nA; cB = nB; ++ui;
        if constexpr (ALIGN_EPI) { if (wr == 1) PG8_BAR; }
    }
    PG8_WAIT_V(0);
    if constexpr (!ALIGN_EPI) { if (wr == 0) PG8_BAR; }
    PG8_BAR;
    if constexpr (Epi::AFTER_DRAIN) { E.fused(acc, cur, wr, wc, fr, fq, lds, wid, lane); S.done(cur); }
#undef PG8_SA
#undef PG8_SB
#undef PG8_STAGE
#undef PG8_LDA
#undef PG8_LDB
#undef PG8_MMA
#undef PG8_WAIT_V
#undef PG8_WAIT_L
#undef PG8_BAR
#undef PG8_SCHED
}
}

constexpr int NWAVES = 8;
constexpr int BATCH = 2, SEQ = 8192, D = 1024, M = BATCH * SEQ;
constexpr int NPROJ = 3072, NIN = 3080;
constexpr int AH = 8, NB = 32;
constexpr int C_AQ = 0, C_AK = 512, C_AV = 1024, C_MQ = 1536, C_MK = 1792, C_MV = 2048, C_MO = 2560;
constexpr int MH = 4, MLC = 128, NCH = SEQ / MLC;
constexpr int DFF = 2816, NE = 8, DEX = 3584;
constexpr int MAXT = 136;
constexpr int CAP = 70;
constexpr float LN_EPS = 1e-5f, RMS_EPS = 1e-6f;
constexpr float ALPHA = 1.41421356237309515f;
constexpr float QSCALE = 0.125f * 1.4426950408889634f;

constexpr size_t MiB = 1u << 20;
constexpr size_t WS_CTL = 0, CTL_ZERO_BYTES = 1 * MiB;
constexpr size_t WS_ROPE = 1 * MiB;
constexpr size_t WS_GATES = 2 * MiB;
constexpr size_t WS_ROWMAP = 2 * MiB + 512 * 1024, WS_ROWW = 2 * MiB + 768 * 1024;
constexpr size_t WS_LIST = 3 * MiB, WS_LISTW = 3 * MiB + 512 * 1024;
constexpr size_t WS_WIN = 4 * MiB, WS_WOUT = 16 * MiB, WS_WGU = 20 * MiB, WS_WD = 31 * MiB;
constexpr size_t WS_MGU = 37 * MiB, WS_MD = 149 * MiB;
constexpr size_t WS_MIX2 = 37 * MiB;
constexpr size_t WS_XB = 205 * MiB, WS_X1B = 237 * MiB, WS_XR = 269 * MiB, WS_PROJ = 333 * MiB, WS_CAT = 429 * MiB;
constexpr size_t WS_MIX = 333 * MiB;
constexpr size_t WS_HD = 333 * MiB;
constexpr size_t WS_Y = 205 * MiB, WS_HM = 269 * MiB, WS_XS = 393 * MiB, WS_END = 461 * MiB;
static_assert(WS_HM + (size_t)CAP * 256 * DEX * 2 <= WS_XS && WS_XS + (size_t)MAXT * 256 * D * 2 <= WS_END, "MoE map");
static_assert(WS_HD + (size_t)M * DFF * 2 <= WS_CAT && WS_WD + (size_t)D * DFF * 2 <= WS_MGU && WS_WGU + (size_t)2 * DFF * D * 2 <= WS_WD, "map");
constexpr int CW_TMO = 0, CW_CODE = 1;
constexpr int CW_BAR = 4096;
constexpr int CW_ECNT = 16384;
constexpr int CW_KSUM = 65536;

constexpr int LDS_BYTES = 147456;
constexpr int MISC_OFF = LDS_BYTES - 1024;
constexpr int TEXP_OFF = MISC_OFF + 256;
constexpr int XW_OFF = 100 * 1024;

#define GAS __attribute__((address_space(1)))
#define LAS __attribute__((address_space(3)))
typedef unsigned short bf16;
typedef unsigned v4u __attribute__((ext_vector_type(4)));
typedef unsigned v2u __attribute__((ext_vector_type(2)));
typedef float f32x4 __attribute__((ext_vector_type(4)));
typedef GAS unsigned gu32;
#define RLX_AGENT __ATOMIC_RELAXED, __HIP_MEMORY_SCOPE_AGENT
#define LDS_WAIT() asm volatile("s_waitcnt lgkmcnt(0)" ::: "memory")
#define VM_WAIT() asm volatile("s_waitcnt vmcnt(0)" ::: "memory")
__device__ __forceinline__ unsigned f2bf(float f) { unsigned u = __builtin_bit_cast(unsigned, f); return (u + 0x7fffu + ((u >> 16) & 1u)) >> 16; }
__device__ __forceinline__ unsigned pk2(float lo, float hi) { return f2bf(lo) | (f2bf(hi) << 16); }
__device__ __forceinline__ float bf2f(unsigned short h) { return __builtin_bit_cast(float, (unsigned)h << 16); }
__device__ __forceinline__ float bflo(unsigned w) { return __builtin_bit_cast(float, w << 16); }
__device__ __forceinline__ float bfhi(unsigned w) { return __builtin_bit_cast(float, w & 0xffff0000u); }
#define XB_TMO      128
#define XB_XCNT(j)  (256  + 64 * (j))
#define XB_XSUB(j)  (1280 + 64 * (j))
#define XB_XGEN(j)  (2304 + 64 * (j))
#define XB_TOP      3328
#define XB_TOPGEN   3392
#define XCD_BAR_WORDS 3456
#define XB_SPIN_CAP (1u << 18)

__device__ __forceinline__ unsigned xb_ld(unsigned* p)              { return __hip_atomic_load(p, __ATOMIC_RELAXED, __HIP_MEMORY_SCOPE_AGENT); }
__device__ __forceinline__ unsigned xb_add(unsigned* p, unsigned v) { return __hip_atomic_fetch_add(p, v, __ATOMIC_RELAXED, __HIP_MEMORY_SCOPE_AGENT); }
__device__ __forceinline__ unsigned xb_xcc_id() { return (unsigned)__builtin_amdgcn_s_getreg((3 << 11) | 20) & 0xFu; }
#define XB_SPIN(cond, bar) do { unsigned _sp = 0; while (cond) { __builtin_amdgcn_s_sleep(1); \
    if ((++_sp & 255u) == 0u) { if (xb_ld(&(bar)[XB_TMO])) break; if (_sp > XB_SPIN_CAP) { atomicAdd(&(bar)[XB_TMO], 1u); break; } } } } while (0)

struct XcdBarrier {
    unsigned* bar; unsigned x;
    volatile LAS unsigned* st;
};

__device__ __forceinline__ XcdBarrier xcd_barrier_post(unsigned* bar, volatile LAS unsigned* st) {
    XcdBarrier b; b.bar = bar; b.x = xb_xcc_id(); b.st = st;
    if (threadIdx.x == 0) (void)xb_add(&bar[XB_XCNT(b.x)], 1u);
    return b;
}
__device__ __forceinline__ void xcd_barrier_complete(unsigned* bar, unsigned x, unsigned& nloc, unsigned& nx) {
    const unsigned G = gridDim.x * gridDim.y * gridDim.z;
    unsigned sum, cnt, mine, sp = 0u;
    for (;;) {
        sum = 0u; cnt = 0u; mine = 0u;
#pragma unroll
        for (unsigned j = 0; j < 16; ++j) { const unsigned c = xb_ld(&bar[XB_XCNT(j)]); sum += c; cnt += (c > 0u) ? 1u : 0u; mine = (j == x) ? c : mine; }
        if (sum == G) break;
        __builtin_amdgcn_s_sleep(1);
        if ((++sp & 255u) == 0u) { if (xb_ld(&bar[XB_TMO])) break; if (sp > XB_SPIN_CAP) { atomicAdd(&bar[XB_TMO], 1u); break; } }
    }
    nloc = mine > 0u ? mine : 1u; nx = cnt > 0u ? cnt : 1u;
}

__device__ __forceinline__ void xcd_barrier(const XcdBarrier& b) {
    asm volatile("s_waitcnt vmcnt(0)" ::: "memory");
    __syncthreads();
    if (threadIdx.x == 0) {
        unsigned* bar = b.bar;
        __builtin_amdgcn_s_waitcnt(0);
        unsigned nloc = b.st[0], nx = b.st[1];
        if (nloc == 0u) { xcd_barrier_complete(bar, b.x, nloc, nx); b.st[0] = nloc; b.st[1] = nx; }
        const unsigned old = xb_add(&bar[XB_XSUB(b.x)], 1u);
        const unsigned gen = old / nloc;
        if (old + 1u == (gen + 1u) * nloc) {
            __builtin_amdgcn_fence(__ATOMIC_RELEASE, "agent");
            asm volatile("s_waitcnt vmcnt(0)" ::: "memory");
            const unsigned og = xb_add(&bar[XB_TOP], 1u);
            const unsigned tg = og / nx;
            if (og + 1u == (tg + 1u) * nx) xb_add(&bar[XB_TOPGEN], 1u);
            else XB_SPIN(xb_ld(&bar[XB_TOPGEN]) == tg, bar);
            __builtin_amdgcn_fence(__ATOMIC_ACQUIRE, "agent");
            xb_add(&bar[XB_XGEN(b.x)], 1u);
            asm volatile("s_waitcnt vmcnt(0)" ::: "memory");
        } else {
            XB_SPIN(xb_ld(&bar[XB_XGEN(b.x)]) == gen, bar);
            __builtin_amdgcn_fence(__ATOMIC_ACQUIRE, "agent");
            asm volatile("s_waitcnt vmcnt(0)" ::: "memory");
        }
    }
    __syncthreads();
}

struct Frame {
    LAS unsigned char* lds;
    volatile LAS unsigned* MISC;
    gu32* ctl;
    int tid, lane, wave;
    int vcu, G;
    unsigned char* ws;
};
__device__ __forceinline__ float wave_sum(float v) {
#pragma unroll
    for (int o = 1; o < 64; o <<= 1) v += __shfl_xor(v, o);
    return v;
}
__device__ __forceinline__ float wave_max(float v) {
#pragma unroll
    for (int o = 1; o < 64; o <<= 1) v = fmaxf(v, __shfl_xor(v, o));
    return v;
}
__device__ __forceinline__ void transpose_item(const float* W, int ldw, int k0, int n0, bf16* WT, int K, int drow0, LAS float* scr, int lane) {
#pragma unroll 8
    for (int i = 0; i < 32; ++i) { const int kk = 2 * i + (lane >> 5); scr[kk * 33 + (lane & 31)] = W[(size_t)(k0 + kk) * ldw + n0 + (lane & 31)]; }
    LDS_WAIT(); asm volatile("" ::: "memory");
    const int c = lane & 7;
#pragma unroll
    for (int j = 0; j < 4; ++j) { const int n = (lane >> 3) + 8 * j; const LAS float* s = scr + (8 * c) * 33 + n;
        v4u o; o.x = pk2(s[0 * 33], s[1 * 33]); o.y = pk2(s[2 * 33], s[3 * 33]); o.z = pk2(s[4 * 33], s[5 * 33]); o.w = pk2(s[6 * 33], s[7 * 33]);
        *(GAS v4u*)(WT + (size_t)(drow0 + n) * K + k0 + 8 * c) = o; }
    LDS_WAIT(); asm volatile("" ::: "memory");
}
__device__ __forceinline__ void cvt_plain(const float* W, int ldw, int coff, int K, int N, bf16* WT, LAS float* scr, int it, int lane) {
    const int nblk = N / 32, kb = it / nblk, nb = it % nblk; transpose_item(W, ldw, 64 * kb, coff + 32 * nb, WT, K, 32 * nb, scr, lane);
}
__device__ __forceinline__ void cvt_gu(const float* Wg, const float* Wu, int K, int N, bf16* WT, LAS float* scr, int it, int lane) {
    const int nblk = N / 32, per = (K / 64) * nblk; const int isu = it >= per; if (isu) it -= per; const int kb = it / nblk, nb = it % nblk, n0 = 32 * nb;
    transpose_item(isu ? Wu : Wg, N, 64 * kb, n0, WT, K, (n0 / 128) * 256 + (n0 % 128) + (isu ? 128 : 0), scr, lane);
}
__device__ __forceinline__ void stage_xw(Frame& F, const float* W, int ldw, int coff) {
    LAS float* xw = (LAS float*)(F.lds + XW_OFF);
    for (int idx = F.tid; idx < 8192; idx += NWAVES * 64) { const int k = idx >> 3, g = idx & 7; xw[g * 1024 + k] = W[(size_t)k * ldw + coff + g]; }
    LDS_WAIT(); __syncthreads();
}
__device__ __forceinline__ void row_dot8(Frame& F, const f32x4 (&v)[4], float (&acc)[8]) {
    const LAS f32x4* xw = (const LAS f32x4*)(F.lds + XW_OFF);
#pragma unroll
    for (int g = 0; g < 8; ++g) { float a = 0.f;
#pragma unroll
        for (int j = 0; j < 4; ++j) { const f32x4 w = xw[g * 256 + j * 64 + F.lane]; a += v[j][0] * w[0] + v[j][1] * w[1] + v[j][2] * w[2] + v[j][3] * w[3]; }
        acc[g] = wave_sum(a); }
}
__device__ __forceinline__ float log_sigmoid(float x) { return fminf(x, 0.f) - log1pf(expf(-fabsf(x))); }
__device__ __forceinline__ void store_row_bf16(bf16* orow, const f32x4 (&y)[4], int lane) {
    GAS unsigned long long* o8 = (GAS unsigned long long*)orow + lane;
#pragma unroll
    for (int j = 0; j < 4; ++j) o8[64 * j] = (unsigned long long)pk2(y[j][0], y[j][1]) | ((unsigned long long)pk2(y[j][2], y[j][3]) << 32);
}
__device__ __forceinline__ void write_gates(Frame& F, const f32x4 (&y)[4], const float* gbias, float* grow) {
    float a[8]; row_dot8(F, y, a);
    if (F.lane < 8) { float r = 0.f;
#pragma unroll
        for (int g = 0; g < 8; ++g) if (F.lane == g) r = a[g];
        r += gbias[F.lane]; if (F.lane >= 4) r = log_sigmoid(r); grow[F.lane] = r; }
}
struct In {
    const float* x; const int* pos; const float *w_in, *gate_bias, *conv_w, *conv_b, *norm_attn, *norm_ml, *w_out, *ln1_g, *ln1_b, *dg, *du, *dd, *router_w, *router_b, *mg, *mu, *md, *ln2_g, *ln2_b;
};
__device__ __forceinline__ void p_prologue(Frame& F, const In& I) {
    unsigned char* ws = F.ws;
    stage_xw(F, I.w_in, NIN, NPROJ);
    LAS float* scr = (LAS float*)(F.lds + F.wave * 8704);
    const int gw = F.vcu * NWAVES + F.wave, NGW = F.G * NWAVES;
    constexpr int I_IN = (D / 64) * (NPROJ / 32), I_OUT = (D / 64) * (D / 32), I_GU = 2 * (D / 64) * (DFF / 32), I_DD = (DFF / 64) * (D / 32);
    constexpr int NITEMS = 2 * I_IN + 2 * I_OUT + I_GU + I_DD;
    for (int it = gw; it < NITEMS; it += NGW) {
        int r = it;
        if (r < 2 * I_IN) { const int l = r / I_IN; r -= l * I_IN; cvt_plain(I.w_in + (size_t)l * D * NIN, NIN, 0, D, NPROJ, (bf16*)(ws + WS_WIN) + (size_t)l * NPROJ * D, scr, r, F.lane); continue; } r -= 2 * I_IN;
        if (r < 2 * I_OUT) { const int l = r / I_OUT; r -= l * I_OUT; cvt_plain(I.w_out + (size_t)l * D * D, D, 0, D, D, (bf16*)(ws + WS_WOUT) + (size_t)l * D * D, scr, r, F.lane); continue; } r -= 2 * I_OUT;
        if (r < I_GU) { cvt_gu(I.dg, I.du, D, DFF, (bf16*)(ws + WS_WGU), scr, r, F.lane); continue; } r -= I_GU;
        cvt_plain(I.dd, D, 0, DFF, D, (bf16*)(ws + WS_WD), scr, r, F.lane);
    }
    for (int e = blockIdx.x * (NWAVES * 64) + F.tid; e < M * 8; e += F.G * NWAVES * 64) { const int row = e >> 3, i = e & 7;
        const float inv = powf(500000.0f, -(float)i / 8.0f); const float ang = (float)I.pos[row] * inv; float s, c; sincosf(ang, &s, &c);
        float* rp = (float*)(ws + WS_ROPE) + (size_t)row * 16; rp[i] = c; rp[8 + i] = s; }
    for (int m = gw; m < M; m += NGW) { const GAS f32x4* xr = (const GAS f32x4*)(I.x + (size_t)m * D) + F.lane; f32x4 v[4];
#pragma unroll
        for (int j = 0; j < 4; ++j) v[j] = xr[64 * j];
        store_row_bf16((bf16*)(ws + WS_XB) + (size_t)m * D, v, F.lane);
        write_gates(F, v, I.gate_bias, (float*)(ws + WS_GATES) + (size_t)m * 8); }
}
template <int ADD, int EXTRA>
__device__ __forceinline__ void ln_phase(Frame& F, const float* res, const float* addf, const bf16* y0, const bf16* y1, const float* g, const float* bt, float* outf, bf16* outb,
                                         const float* xbias, float* gates_out, int* list, float* listw) {
    const int gw = F.vcu * NWAVES + F.wave, NGW = F.G * NWAVES;
    f32x4 gv[4], bv[4];
#pragma unroll
    for (int j = 0; j < 4; ++j) { gv[j] = ((const GAS f32x4*)g)[64 * j + F.lane]; bv[j] = ((const GAS f32x4*)bt)[64 * j + F.lane]; }
    for (int m = gw; m < M; m += NGW) {
        const GAS f32x4* rr = (const GAS f32x4*)(res + (size_t)m * D) + F.lane; f32x4 v[4]; float s = 0.f;
        if (ADD == 0) { const GAS f32x4* ar = (const GAS f32x4*)(addf + (size_t)m * D) + F.lane;
#pragma unroll
            for (int j = 0; j < 4; ++j) v[j] = rr[64 * j] * ALPHA + ar[64 * j];
        } else { const GAS v2u* a0 = (const GAS v2u*)(y0 + (size_t)m * D) + F.lane; const GAS v2u* a1 = (const GAS v2u*)(y1 + (size_t)m * D) + F.lane;
#pragma unroll
            for (int j = 0; j < 4; ++j) { const v2u p = a0[64 * j], q = a1[64 * j]; const f32x4 a = {bflo(p.x) + bflo(q.x), bfhi(p.x) + bfhi(q.x), bflo(p.y) + bflo(q.y), bfhi(p.y) + bfhi(q.y)}; v[j] = rr[64 * j] * ALPHA + a; } }
#pragma unroll
        for (int j = 0; j < 4; ++j) s += (v[j][0] + v[j][1]) + (v[j][2] + v[j][3]);
        const float mean = wave_sum(s) * (1.f / D); float s2 = 0.f;
#pragma unroll
        for (int j = 0; j < 4; ++j) { v[j] = v[j] - mean; s2 += (v[j][0] * v[j][0] + v[j][1] * v[j][1]) + (v[j][2] * v[j][2] + v[j][3] * v[j][3]); }
        const float rstd = 1.f / sqrtf(wave_sum(s2) * (1.f / D) + LN_EPS);
#pragma unroll
        for (int j = 0; j < 4; ++j) v[j] = v[j] * rstd * gv[j] + bv[j];
        GAS f32x4* of = (GAS f32x4*)(outf + (size_t)m * D) + F.lane;
#pragma unroll
        for (int j = 0; j < 4; ++j) of[64 * j] = v[j];
        if (outb) store_row_bf16(outb + (size_t)m * D, v, F.lane);
        if (EXTRA == 1) write_gates(F, v, xbias, gates_out + (size_t)m * 8);
        if (EXTRA == 2) { float a[8]; row_dot8(F, v, a);
#pragma unroll
            for (int e = 0; e < 8; ++e) a[e] += xbias[e];
            int i0 = 0; float v0 = a[0];
#pragma unroll
            for (int e = 1; e < 8; ++e) if (a[e] > v0) { v0 = a[e]; i0 = e; }
            int i1 = -1; float v1 = -INFINITY;
#pragma unroll
            for (int e = 0; e < 8; ++e) if (e != i0 && a[e] > v1) { v1 = a[e]; i1 = e; }
            const float w1 = 1.f / (1.f + expf(v0 - v1)), w0 = 1.f - w1;
            if (F.lane < 2) { const int e = F.lane ? i1 : i0; const float w = F.lane ? w1 : w0;
                const unsigned p = __hip_atomic_fetch_add((unsigned*)(F.ctl + CW_ECNT + 64 * e), 1u, RLX_AGENT);
                list[(size_t)e * M + p] = m * 2 + F.lane; listw[(size_t)e * M + p] = w; } }
    }
}
__device__ __forceinline__ int moe_plan(Frame& F) {
    LAS int* texp = (LAS int*)(F.lds + TEXP_OFF);
    if (F.tid == 0) { int t = 0;
        for (int e = 0; e < NE; ++e) { const int c = (int)__hip_atomic_load((unsigned*)(F.ctl + CW_ECNT + 64 * e), RLX_AGENT); const int nt = (c + 255) >> 8; texp[MAXT + 1 + e] = t * 256;
            for (int k = 0; k < nt && t < MAXT; ++k) texp[t++] = e; }
        texp[MAXT] = t; }
    LDS_WAIT(); __syncthreads();
    return texp[MAXT];
}
__device__ __forceinline__ void moe_gather(Frame& F, int ntiles, const bf16* X1B, bf16* XS, const int* list, const float* listw, int* rowmap, float* roww) {
    const LAS int* texp = (const LAS int*)(F.lds + TEXP_OFF);
    const int gw = F.vcu * NWAVES + F.wave, NGW = F.G * NWAVES;
    for (int r = gw; r < ntiles * 256; r += NGW) { const int e = texp[r >> 8], i = r - texp[MAXT + 1 + e];
        const int c = (int)__hip_atomic_load((unsigned*)(F.ctl + CW_ECNT + 64 * e), RLX_AGENT);
        v4u a = {0u, 0u, 0u, 0u}, b = a; int ts = -1; float w = 0.f;
        if (i < c) { ts = list[(size_t)e * M + i]; w = listw[(size_t)e * M + i]; const GAS v4u* src = (const GAS v4u*)(X1B + (size_t)(ts >> 1) * D); a = src[F.lane]; b = src[64 + F.lane]; }
        GAS v4u* dst = (GAS v4u*)(XS + (size_t)r * D); dst[F.lane] = a; dst[64 + F.lane] = b;
        if (F.lane == 0) { rowmap[r] = ts; roww[r] = w; } }
}
__device__ __forceinline__ void moe_cvt(Frame& F, const In& I) {
    LAS float* scr = (LAS float*)(F.lds + F.wave * 8704);
    const int gw = F.vcu * NWAVES + F.wave, NGW = F.G * NWAVES;
    constexpr int I_GU = 2 * (D / 64) * (DEX / 32), I_DD = (DEX / 64) * (D / 32), PER = I_GU + I_DD;
    for (int it = gw; it < NE * PER; it += NGW) { const int e = it / PER; int r = it - e * PER;
        if (r < I_GU) cvt_gu(I.mg + (size_t)e * D * DEX, I.mu + (size_t)e * D * DEX, D, DEX, (bf16*)(F.ws + WS_MGU) + (size_t)e * 2 * DEX * D, scr, r, F.lane);
        else cvt_plain(I.md + (size_t)e * DEX * D, D, 0, DEX, D, (bf16*)(F.ws + WS_MD) + (size_t)e * D * DEX, scr, r - I_GU, F.lane); }
}

__device__ __forceinline__ float dot64_bf16(const LAS float* qs, const bf16* kr) {
    const GAS v4u* kp = (const GAS v4u*)kr; float a = 0.f;
#pragma unroll
    for (int c = 0; c < 8; ++c) { const v4u w = kp[c]; const LAS f32x4* q4 = (const LAS f32x4*)(qs + 8 * c); const f32x4 qa = q4[0], qb = q4[1];
        a += qa[0] * bflo(w.x) + qa[1] * bfhi(w.x) + qa[2] * bflo(w.y) + qa[3] * bfhi(w.y) + qb[0] * bflo(w.z) + qb[1] * bfhi(w.z) + qb[2] * bflo(w.w) + qb[3] * bfhi(w.w); }
    return a;
}
__device__ __forceinline__ void attn_naive(Frame& F, const bf16* PROJ, const float* ksum, const float* norm_attn, bf16* CAT, int w_lo, int w_n) {
    LAS float* qs = (LAS float*)(F.lds + F.wave * 4608); LAS float* ps = qs + 64;
    const int lane = F.lane; const int gwa = F.vcu * NWAVES + F.wave - w_lo;
    if (gwa < 0) return;
    for (int task = gwa; task < M * AH; task += w_n) {
        const int bh = task >> 13, t = task & 8191, b = bh >> 3, h = bh & 7; const size_t row = (size_t)b * SEQ + t; const int blk = t >> 8;
        qs[lane] = bf2f(PROJ[row * NPROJ + C_AQ + h * 64 + lane]); LDS_WAIT();
        float g = -INFINITY;
        if (lane < blk) { const float* km = ksum + ((size_t)(b * NB + lane) * 512 + h * 64); float a = 0.f;
            for (int d = 0; d < 64; ++d) a += qs[d] * km[d];
            g = a; }
        int sel[3];
#pragma unroll
        for (int k = 0; k < 3; ++k) { float v = g; int idx = lane;
#pragma unroll
            for (int o = 1; o < 64; o <<= 1) { const float ov = __shfl_xor(v, o); const int oi = __shfl_xor(idx, o); if (ov > v || (ov == v && oi < idx)) { v = ov; idx = oi; } }
            idx = __builtin_amdgcn_readfirstlane(idx); const bool ok = __builtin_amdgcn_readfirstlane(v > -INFINITY ? 1 : 0) != 0;
            sel[k] = ok ? idx : -1; if (lane == idx) g = -INFINITY; }
        float sc[4][4]; float mx = -INFINITY;
#pragma unroll
        for (int s = 0; s < 4; ++s) { const int jb = (s < 3) ? sel[s] : blk;
#pragma unroll
            for (int i = 0; i < 4; ++i) { float a = -INFINITY;
                if (jb >= 0) { const int kp = jb * 256 + i * 64 + lane; if (s < 3 || kp <= t) a = dot64_bf16(qs, PROJ + ((size_t)b * SEQ + kp) * NPROJ + C_AK + h * 64); }
                sc[s][i] = a; mx = fmaxf(mx, a); } }
        mx = wave_max(mx); float sum = 0.f;
#pragma unroll
        for (int s = 0; s < 4; ++s)
#pragma unroll
            for (int i = 0; i < 4; ++i) { const float p = __builtin_amdgcn_exp2f(sc[s][i] - mx); sum += p; ps[s * 256 + i * 64 + lane] = p; }
        sum = wave_sum(sum); LDS_WAIT();
        float o = 0.f;
#pragma unroll
        for (int s = 0; s < 4; ++s) { const int jb = (s < 3) ? sel[s] : blk; if (jb < 0) continue; const int kmax = (s < 3) ? 256 : (t - blk * 256 + 1);
            const bf16* vb = PROJ + ((size_t)b * SEQ + jb * 256) * NPROJ + C_AV + h * 64 + lane;
#pragma unroll 8
            for (int k = 0; k < kmax; ++k) o += ps[s * 256 + k] * bf2f(vb[(size_t)k * NPROJ]); }
        o = o / sum; const float ms = wave_sum(o * o) * (1.f / 64.f);
        o = o * (1.f / sqrtf(ms + RMS_EPS)) * norm_attn[h * 64 + lane];
        CAT[row * D + h * 64 + lane] = (bf16)f2bf(o);
        LDS_WAIT();
    }
}
__device__ __forceinline__ void mlstm_naive(Frame& F, int bh, const bf16* PROJ, const float* GATES, const float* conv_w, const float* conv_b, const float* norm_ml, bf16* CAT) {
    const int b = bh >> 2, h = bh & 3, tid = F.tid;
    LAS float* Cst = (LAS float*)(F.lds);
    LAS float* nst = (LAS float*)(F.lds + 33280);
    LAS float* qf = (LAS float*)(F.lds + 33792);
    LAS float* kf = (LAS float*)(F.lds + 67072);
    LAS bf16* vb = (LAS bf16*)(F.lds + 100352);
    LAS float* bs = (LAS float*)(F.lds + 133120);
    LAS float* ig = bs + 128;
    LAS float* mt = bs + 256;
    LAS float* wst = bs + 384;
    LAS float* scal = bs + 512;
    for (int e = tid; e < 128 * 65; e += 512) Cst[e] = 0.f;
    if (tid < 64) nst[tid] = 0.f;
    if (tid == 0) scal[0] = 0.f;
    __syncthreads();
    for (int c = 0; c < NCH; ++c) {
        const size_t row0 = (size_t)b * SEQ + (size_t)c * MLC;
        if (tid < 128) { ig[tid] = GATES[(row0 + tid) * 8 + h]; bs[tid] = GATES[(row0 + tid) * 8 + 4 + h]; }
        for (int e = tid; e < 128 * 128; e += 512) { const int t = e >> 7, cc = e & 127; const int isk = cc >> 6, d = cc & 63; const int ch = isk * 256 + h * 64 + d;
            float a = conv_b[ch];
#pragma unroll
            for (int j = 0; j < 4; ++j) { const int tt = c * MLC + t - 3 + j; if (tt >= 0) a += conv_w[j * 512 + ch] * bf2f(PROJ[((size_t)b * SEQ + tt) * NPROJ + C_MQ + ch]); }
            a = a / (1.f + expf(-a));
            if (isk) kf[t * 65 + d] = a; else qf[t * 65 + d] = a * 0.125f; }
        for (int e = tid; e < 128 * 128; e += 512) { const int t = e >> 7, vv = e & 127; vb[t * 128 + vv] = PROJ[(row0 + t) * NPROJ + C_MV + h * 128 + vv]; }
        __syncthreads();
        if (tid == 0) { const float mc = scal[0]; float run = 0.f, cm = -INFINITY;
            for (int t = 0; t < 128; ++t) { run += bs[t]; bs[t] = run; cm = fmaxf(cm, ig[t] - run); mt[t] = run + fmaxf(mc, cm); }
            const float bl = run; const float mnew = fmaxf(bl + mc, bl + cm); scal[1] = mnew; scal[2] = bl; }
        __syncthreads();
        if (tid < 128) wst[tid] = expf(scal[2] - bs[tid] + ig[tid] - scal[1]);
#pragma unroll 1
        for (int pass = 0; pass < 2; ++pass) {
            const int t = pass * 64 + (tid >> 3), vq = tid & 7; const float mc = scal[0]; const float bt = bs[t], mtt = mt[t];
            float q[64];
#pragma unroll
            for (int d = 0; d < 64; ++d) q[d] = qf[t * 65 + d];
            float num[16]; float den = 0.f;
#pragma unroll
            for (int j = 0; j < 16; ++j) num[j] = 0.f;
            const int tmax = pass * 64 + ((tid >> 6) << 3) + 7;
#pragma unroll 1
            for (int s = 0; s <= tmax; ++s) { if (s <= t) { float dot = 0.f;
#pragma unroll
                    for (int d = 0; d < 64; ++d) dot += q[d] * kf[s * 65 + d];
                    const float sw = dot * expf(bt - bs[s] + ig[s] - mtt); den += sw;
#pragma unroll
                    for (int j = 0; j < 16; ++j) num[j] += sw * bf2f(vb[s * 128 + vq * 16 + j]); } }
            const float wi = expf(bt + mc - mtt); float nq = 0.f;
#pragma unroll
            for (int d = 0; d < 64; ++d) nq += nst[d] * q[d];
            den += wi * nq;
            { float cq[16];
#pragma unroll
              for (int j = 0; j < 16; ++j) cq[j] = 0.f;
#pragma unroll 1
              for (int d = 0; d < 64; ++d) { const float qd = qf[t * 65 + d]; const LAS float* cr = Cst + (vq * 16) * 65 + d;
#pragma unroll
                  for (int j = 0; j < 16; ++j) cq[j] += cr[j * 65] * qd; }
#pragma unroll
              for (int j = 0; j < 16; ++j) num[j] += wi * cq[j]; }
            const float dn = 1.f / fmaxf(fabsf(den), expf(-mtt)); float ss = 0.f;
#pragma unroll
            for (int j = 0; j < 16; ++j) { num[j] *= dn; ss += num[j] * num[j]; }
            ss += __shfl_xor(ss, 1); ss += __shfl_xor(ss, 2); ss += __shfl_xor(ss, 4);
            const float rs = 1.f / sqrtf(ss * (1.f / 128.f) + RMS_EPS);
            const size_t row = row0 + t; const bf16* mo = PROJ + row * NPROJ + C_MO + h * 128 + vq * 16; bf16* out = CAT + row * D + 512 + h * 128 + vq * 16; const float* gn = norm_ml + h * 128 + vq * 16;
#pragma unroll
            for (int j = 0; j < 16; ++j) { const float o = bf2f(mo[j]); out[j] = (bf16)f2bf(num[j] * rs * gn[j] / (1.f + expf(-o))); }
        }
        __syncthreads();
        {
            const float cs = expf(scal[2] + scal[0] - scal[1]);
            for (int e = tid; e < 128 * 64; e += 512) { const int vv = e >> 6, d = e & 63; float a = 0.f;
                for (int s = 0; s < 128; ++s) a += wst[s] * bf2f(vb[s * 128 + vv]) * kf[s * 65 + d];
                Cst[vv * 65 + d] = cs * Cst[vv * 65 + d] + a; }
            if (tid < 64) { float a = 0.f; for (int s = 0; s < 128; ++s) a += wst[s] * kf[s * 65 + tid]; nst[tid] = cs * nst[tid] + a; }
        }
        __syncthreads();
        if (tid == 0) scal[0] = scal[1];
        __syncthreads();
    }
}

constexpr int N_PHASES = 18;
struct Args { In in; float* out; unsigned char* ws; int ph_lo, ph_hi; };
__global__ void __launch_bounds__(NWAVES * 64, 2) hymba_fwd(Args args) {
    extern __shared__ __attribute__((aligned(16))) unsigned char lds[];
    Frame F;
    F.lds = (LAS unsigned char*)lds;
    F.MISC = (volatile LAS unsigned*)(F.lds + MISC_OFF);
    F.tid = threadIdx.x; F.lane = F.tid & 63; F.wave = __builtin_amdgcn_readfirstlane(F.tid >> 6);
    F.G = gridDim.x; { const int bx = blockIdx.x; F.vcu = (F.G % 8 == 0) ? (bx % 8) * (F.G / 8) + bx / 8 : bx; }
    F.ws = args.ws; unsigned char* ws = args.ws;
    F.ctl = (gu32*)(ws + WS_CTL);
    const In& I = args.in;
    for (int u = F.tid; u < (LDS_BYTES - MISC_OFF) / 4; u += NWAVES * 64) ((LAS unsigned*)(F.lds + MISC_OFF))[u] = 0u;
    __syncthreads();
    const int lo = args.ph_lo, hi = args.ph_hi;
    const bool multi = (hi - lo) > 1;
    XcdBarrier bar; bar.bar = (unsigned*)(F.ctl + CW_BAR); bar.x = 0; bar.st = nullptr;
    if (multi) bar = xcd_barrier_post((unsigned*)(F.ctl + CW_BAR), F.MISC + 8);
#define IN(k) (lo <= (k) && (k) < hi)
#define SEAM(k) do { if (IN(k) && IN((k) + 1)) xcd_barrier(bar); } while (0)
    bf16* XB = (bf16*)(ws + WS_XB); bf16* X1B = (bf16*)(ws + WS_X1B); float* XR = (float*)(ws + WS_XR); bf16* PROJ = (bf16*)(ws + WS_PROJ); bf16* CAT = (bf16*)(ws + WS_CAT);
    float* MIX = (float*)(ws + WS_MIX); float* MIX2 = (float*)(ws + WS_MIX2); bf16* HD = (bf16*)(ws + WS_HD); float* GATES = (float*)(ws + WS_GATES);
    const float* ROPE = (const float*)(ws + WS_ROPE);
    int* LIST = (int*)(ws + WS_LIST); float* LISTW = (float*)(ws + WS_LISTW); int* ROWMAP = (int*)(ws + WS_ROWMAP); float* ROWW = (float*)(ws + WS_ROWW);
    bf16* YB = (bf16*)(ws + WS_Y); bf16* HM = (bf16*)(ws + WS_HM); bf16* XS = (bf16*)(ws + WS_XS);

    if (IN(0)) { p_prologue(F, I); } SEAM(0);

#define LAYER_MIXER(L, P)                                                                                                                                   \
    if (IN(P)) {                                                                                                                          \
        pg8::Gemm g{XB, (const bf16*)(ws + WS_WIN) + (size_t)(L) * NPROJ * D, M, NPROJ, D}; pg8::StaticOrder S; S.init(M, NPROJ, F.G, (int)blockIdx.x);     \
        pg8::EpiProj E{PROJ, ROPE, (float*)(F.ctl + CW_KSUM) + (L) * (BATCH * NB * 512), QSCALE};                                                          \
        pg8::gemm_phase<pg8::EpiProj, pg8::StaticOrder, true, true>(F.lds, g, S, E); } SEAM(P);                                                             \
    if (IN((P) + 1)) {                                                              \
        if (F.vcu < 8) mlstm_naive(F, F.vcu, PROJ, GATES, I.conv_w + (L) * 2048, I.conv_b + (L) * 512, I.norm_ml + (L) * 512, CAT);                         \
        else attn_naive(F, PROJ, (const float*)(F.ctl + CW_KSUM) + (L) * (BATCH * NB * 512), I.norm_attn + (L) * 512, CAT, 64, F.G * NWAVES - 64); } SEAM((P) + 1); \
    if (IN((P) + 2)) {                                                                                                                   \
        pg8::Gemm g{CAT, (const bf16*)(ws + WS_WOUT) + (size_t)(L) * D * D, M, D, D}; pg8::StaticOrder S; S.init(M, D, F.G, (int)blockIdx.x);                \
        pg8::EpiF32 E{MIX, D};                                                                                                                              \
        pg8::gemm_phase<pg8::EpiF32, pg8::StaticOrder, false, true>(F.lds, g, S, E); } SEAM((P) + 2);

    LAYER_MIXER(0, 1)
    if (IN(4)) { ln_phase<0, 0>(F, I.x, MIX, nullptr, nullptr, I.ln1_g, I.ln1_b, args.out, X1B, nullptr, nullptr, nullptr, nullptr); } SEAM(4);
    if (IN(5)) {
        pg8::Gemm g{X1B, (const bf16*)(ws + WS_WGU), M, 2 * DFF, D}; pg8::StaticOrder S; S.init(M, 2 * DFF, F.G, (int)blockIdx.x);
        pg8::EpiSwiglu E{HD, DFF, 0};
        pg8::gemm_phase<pg8::EpiSwiglu, pg8::StaticOrder, true, true>(F.lds, g, S, E); } SEAM(5);
    if (IN(6)) {
        pg8::Gemm g{HD, (const bf16*)(ws + WS_WD), M, D, DFF}; pg8::StaticOrder S; S.init(M, D, F.G, (int)blockIdx.x);
        pg8::EpiF32 E{MIX2, D};
        pg8::gemm_phase<pg8::EpiF32, pg8::StaticOrder, false, true>(F.lds, g, S, E); } SEAM(6);
    if (IN(7)) { stage_xw(F, I.w_in + (size_t)D * NIN, NIN, NPROJ);
        ln_phase<0, 1>(F, args.out, MIX2, nullptr, nullptr, I.ln2_g, I.ln2_b, XR, XB, I.gate_bias + 8, GATES, nullptr, nullptr); } SEAM(7);
    LAYER_MIXER(1, 8)
    if (IN(11)) { stage_xw(F, I.router_w, 8, 0);
        ln_phase<0, 2>(F, XR, MIX, nullptr, nullptr, I.ln1_g + D, I.ln1_b + D, args.out, X1B, I.router_b, nullptr, LIST, LISTW);
        __syncthreads(); moe_cvt(F, I); } SEAM(11);
    int ntiles = 0;
    if (lo <= 16 && hi > 12) ntiles = moe_plan(F);
    if (IN(12)) { moe_gather(F, ntiles, X1B, XS, LIST, LISTW, ROWMAP, ROWW); } SEAM(12);
    const PG8_LAS int* texp = (const PG8_LAS int*)(F.lds + TEXP_OFF);
#define MOE_PASS(P, T0)                                                                                                                                     \
    if (IN(P)) { const int t0 = (T0), t1 = (ntiles < (T0) + CAP) ? ntiles : (T0) + CAP;                                                                     \
        pg8::Gemm g{XS, (const bf16*)(ws + WS_MGU), MAXT * 256, 2 * DEX, D}; pg8::GroupedOrder<false> S; S.init(t0, t1, 2 * DEX / 256, F.G, (int)blockIdx.x, texp); \
        pg8::EpiSwiglu E{HM, DEX, t0};                                                                                                                      \
        pg8::gemm_phase<pg8::EpiSwiglu, pg8::GroupedOrder<false>, true, true>(F.lds, g, S, E); } SEAM(P);                                                   \
    if (IN((P) + 1)) { const int t0 = (T0), t1 = (ntiles < (T0) + CAP) ? ntiles : (T0) + CAP;                                                               \
        pg8::Gemm g{HM, (const bf16*)(ws + WS_MD), CAP * 256, D, DEX}; pg8::GroupedOrder<true> S; S.init(t0, t1, D / 256, F.G, (int)blockIdx.x, texp);        \
        pg8::EpiScatter E{YB, ROWMAP, ROWW, t0, M};                                                                                                         \
        pg8::gemm_phase<pg8::EpiScatter, pg8::GroupedOrder<true>, true, true>(F.lds, g, S, E); } SEAM((P) + 1);
    MOE_PASS(13, 0)
    MOE_PASS(15, CAP)
    if (IN(17)) { ln_phase<1, 0>(F, args.out, nullptr, YB, YB + (size_t)M * D, I.ln2_g + D, I.ln2_b + D, args.out, nullptr, nullptr, nullptr, nullptr, nullptr); }
#undef IN
#undef SEAM
}

extern "C" void kernel_launch(void* const* d_in, const int* in_sizes, int n_in, void* d_out, int out_size, void* d_ws, size_t ws_size, hipStream_t stream) {
    static int grid = 0;
    if (grid == 0) {
        if (n_in != 21 || in_sizes[0] != M * D || out_size != M * D || ws_size < WS_END) { fprintf(stderr, "kernel_launch: unexpected shapes (n_in %d, in0 %d, out %d, ws %zu < %zu); nothing launched\n", n_in, n_in > 0 ? in_sizes[0] : -1, out_size, ws_size, (size_t)WS_END); grid = -1; return; }
        int dev = 0, cus = 0, per_cu = 0;
        if (hipGetDevice(&dev) != hipSuccess || hipDeviceGetAttribute(&cus, hipDeviceAttributeMultiprocessorCount, dev) != hipSuccess) { grid = -1; return; }
        if (hipFuncSetAttribute((const void*)hymba_fwd, hipFuncAttributeMaxDynamicSharedMemorySize, LDS_BYTES) != hipSuccess) { fprintf(stderr, "kernel_launch: hipFuncSetAttribute failed\n"); grid = -1; return; }
        if (hipOccupancyMaxActiveBlocksPerMultiprocessor(&per_cu, (const void*)hymba_fwd, NWAVES * 64, LDS_BYTES) != hipSuccess || per_cu < 1) fprintf(stderr, "kernel_launch: occupancy query reports %d\n", per_cu);
        (void)hipGetLastError();
        grid = cus;
    }
    if (grid < 0) return;
    if (hipMemsetAsync((char*)d_ws + WS_CTL, 0, CTL_ZERO_BYTES, stream) != hipSuccess) return;
    Args a{};
    const void** ip = (const void**)&a.in;
    for (int i = 0; i < 21; ++i) ip[i] = d_in[i];
    a.out = (float*)d_out; a.ws = (unsigned char*)d_ws;
#if defined(MK_MULTI)
    for (int p = 0; p < N_PHASES; ++p) { a.ph_lo = p; a.ph_hi = p + 1;
        hipLaunchKernelGGL(hymba_fwd, dim3(grid), dim3(NWAVES * 64), LDS_BYTES, stream, a); }
#else
    a.ph_lo = 0; a.ph_hi = N_PHASES;
    hipLaunchKernelGGL(hymba_fwd, dim3(grid), dim3(NWAVES * 64), LDS_BYTES, stream, a);
#endif
}
```

```cpp
#include <hip/hip_runtime.h>
#include <cstdio>
#include <cstdint>
#include <cmath>
namespace pg8 {
#define PG8_LAS __attribute__((address_space(3)))
typedef unsigned short bf16_t;
typedef short bf16x8 __attribute__((ext_vector_type(8)));
typedef float f32x4 __attribute__((ext_vector_type(4)));
typedef unsigned u32x4 __attribute__((ext_vector_type(4)));
constexpr int BM = 256, BK = 64, HALF = 128, HTB = HALF * BK * 2  , STAGE_BYTES = 8 * HTB, NXCD = 8, WGM = 8;

__host__ __device__ __forceinline__ int lds_byte(int r, int c) { const int st = (r >> 4) * 2 + (c >> 5), rr = r & 15, cc = c & 31, ob = rr * 64 + cc * 2; return st * 1024 + (ob ^ (((ob >> 9) & 1) << 5)); }
__host__ __device__ __forceinline__ void stage_rc(int b, int& R, int& C) { const int st = b / 1024, sb = b % 1024, swz = sb ^ (((sb >> 9) & 1) << 5); R = (st >> 1) * 16 + swz / 64; C = (st & 1) * 32 + (swz % 64) / 2; }
__host__ __device__ __forceinline__ int perm32(int rho) { const int n = rho >> 4, i = rho & 15; return 8 * (i >> 2) + 4 * n + (i & 3); }

struct Unit { int pm, pn, pb; };
struct Gemm { const bf16_t* A; const bf16_t* Bt; int M, N, K; };

struct StaticOrder {
    int nM, nN, nwg, G, c;
    __host__ __device__ void init(int M, int N, int G_, int c_) { nM = M / BM; nN = N / BM; nwg = nM * nN; G = G_; c = c_; }
    __host__ __device__ bool next(int i, Unit& u) const {
        const long L = (long)i * G + c; if (L >= nwg) return false;
        int wgid = (int)L; { const int q = nwg / NXCD, r = nwg % NXCD, xcd = wgid % NXCD, off = wgid / NXCD; wgid = (xcd < r ? xcd * (q + 1) : r * (q + 1) + (xcd - r) * q) + off; }
        const int nig = WGM * nN, gid = wgid / nig, fm = gid * WGM, gsz = (nM - fm) < WGM ? (nM - fm) : WGM;
        u.pm = fm + ((wgid % nig) % gsz); u.pn = (wgid % nig) / gsz; u.pb = u.pn; return true;
    }
    __device__ __forceinline__ void a_ready(const Unit&) const {}
    __device__ __forceinline__ void done(const Unit&) const {}
};


__device__ __forceinline__ unsigned cvt_pk_bf16(float lo, float hi) { unsigned r; asm volatile("v_cvt_pk_bf16_f32 %0, %1, %2" : "=v"(r) : "v"(lo), "v"(hi)); return r; }
__device__ __forceinline__ u32x4 pack8(const f32x4 v0, const f32x4 v1) { u32x4 w; w.x = cvt_pk_bf16(v0[0], v0[1]); w.y = cvt_pk_bf16(v0[2], v0[3]); w.z = cvt_pk_bf16(v1[0], v1[1]); w.w = cvt_pk_bf16(v1[2], v1[3]); return w; }
__device__ __forceinline__ f32x4 shx16(const f32x4 v) { f32x4 r; r[0] = __shfl_xor(v[0], 16); r[1] = __shfl_xor(v[1], 16); r[2] = __shfl_xor(v[2], 16); r[3] = __shfl_xor(v[3], 16); return r; }

struct EpiF32 {
    static constexpr bool PERM = false, AFTER_DRAIN = false;
    float* C; int ldc;
    __device__ __forceinline__ void operator()(const f32x4 (&acc)[2][2][4][2], const Unit& u, int wr, int wc, int fr, int fq) const {
        const int row0 = u.pm * BM + wr * 64 + fr, col0 = u.pn * BM + wc * 32 + 4 * fq;
#pragma unroll
        for (int ai = 0; ai < 2; ++ai)
#pragma unroll
            for (int m = 0; m < 4; ++m) { float* rowp = C + (size_t)(row0 + ai * HALF + m * 16) * ldc + col0;
#pragma unroll
                for (int bj = 0; bj < 2; ++bj)
#pragma unroll
                    for (int n = 0; n < 2; ++n) *(f32x4*)(rowp + bj * HALF + n * 16) = acc[ai][bj][m][n]; }
    }
};

struct EpiProj {
    static constexpr bool PERM = true, AFTER_DRAIN = false;
    bf16_t* O; const float* rope; float* ksum; float qscale;
    __device__ __forceinline__ void operator()(const f32x4 (&acc)[2][2][4][2], const Unit& u, int wr, int wc, int fr, int fq) const {
        const int row0 = u.pm * BM + wr * 64 + fr; const int colt = u.pn * BM; const int col0 = colt + wc * 32 + 8 * fq;
        const bool is_qk = u.pn < 4, is_q = u.pn < 2, rot = is_qk && ((wc & 1) == 0);
        float ks[2][8];
#pragma unroll
        for (int bj = 0; bj < 2; ++bj)
#pragma unroll
            for (int i = 0; i < 8; ++i) ks[bj][i] = 0.f;
#pragma unroll
        for (int ai = 0; ai < 2; ++ai)
#pragma unroll
            for (int m = 0; m < 4; ++m) { const int row = row0 + ai * HALF + m * 16; bf16_t* rowp = O + (size_t)row * 3072 + col0;
                f32x4 c0 = {1.f, 1.f, 1.f, 1.f}, c1 = c0, s0 = {0.f, 0.f, 0.f, 0.f}, s1 = s0;
                if (rot && fq < 2) { const f32x4* rp = (const f32x4*)(rope + (size_t)row * 16); c0 = rp[0]; c1 = rp[1]; s0 = rp[2]; s1 = rp[3]; if (fq == 0) { s0 = -s0; s1 = -s1; } }
#pragma unroll
                for (int bj = 0; bj < 2; ++bj) { f32x4 v0 = acc[ai][bj][m][0], v1 = acc[ai][bj][m][1];
                    if (rot) { const f32x4 p0 = shx16(v0), p1 = shx16(v1); v0 = v0 * c0 + p0 * s0; v1 = v1 * c1 + p1 * s1; }
                    if (is_q) { v0 = v0 * qscale; v1 = v1 * qscale; }
                    else if (is_qk) {
#pragma unroll
                        for (int i = 0; i < 4; ++i) { ks[bj][i] += v0[i]; ks[bj][4 + i] += v1[i]; } }
                    *(u32x4*)(rowp + bj * HALF) = pack8(v0, v1); } }
        if (is_qk && !is_q) {
            float* kd = ksum + (size_t)u.pm * 512 + (colt - 512) + wc * 32 + 8 * fq;
#pragma unroll
            for (int bj = 0; bj < 2; ++bj)
#pragma unroll
                for (int i = 0; i < 8; ++i) { float s = ks[bj][i]; s += __shfl_xor(s, 1); s += __shfl_xor(s, 2); s += __shfl_xor(s, 4); s += __shfl_xor(s, 8);
                    if (fr == 0) __hip_atomic_fetch_add(kd + bj * HALF + i, s, __ATOMIC_RELAXED, __HIP_MEMORY_SCOPE_AGENT); }
        }
    }
};

__device__ __forceinline__ float silu_f(float x) { return x * __builtin_amdgcn_rcpf(1.0f + __builtin_amdgcn_exp2f(-1.4426950408889634f * x)); }
struct EpiSwiglu {
    static constexpr bool PERM = true, AFTER_DRAIN = false;
    bf16_t* H; int ldh; int pm_off;
    __device__ __forceinline__ void operator()(const f32x4 (&acc)[2][2][4][2], const Unit& u, int wr, int wc, int fr, int fq) const {
        const int row0 = (u.pm - pm_off) * BM + wr * 64 + fr; const int col0 = u.pn * HALF + wc * 32 + 8 * fq;
#pragma unroll
        for (int ai = 0; ai < 2; ++ai)
#pragma unroll
            for (int m = 0; m < 4; ++m) { bf16_t* rowp = H + (size_t)(row0 + ai * HALF + m * 16) * ldh + col0;
                const f32x4 g0 = acc[ai][0][m][0], g1 = acc[ai][0][m][1], u0 = acc[ai][1][m][0], u1 = acc[ai][1][m][1]; f32x4 h0, h1;
#pragma unroll
                for (int i = 0; i < 4; ++i) { h0[i] = silu_f(g0[i]) * u0[i]; h1[i] = silu_f(g1[i]) * u1[i]; }
                *(u32x4*)rowp = pack8(h0, h1); }
    }
};
struct EpiScatter {
    static constexpr bool PERM = true, AFTER_DRAIN = false;
    bf16_t* Y; const int* rowmap; const float* roww; int pm_off; int mtok;
    __device__ __forceinline__ void operator()(const f32x4 (&acc)[2][2][4][2], const Unit& u, int wr, int wc, int fr, int fq) const {
        const int row0 = (u.pm + pm_off) * BM + wr * 64 + fr; const int col0 = u.pn * BM + wc * 32 + 8 * fq;
#pragma unroll
        for (int ai = 0; ai < 2; ++ai)
#pragma unroll
            for (int m = 0; m < 4; ++m) { const int r = row0 + ai * HALF + m * 16; const int ts = rowmap[r];
                if (ts >= 0) { const float w = roww[r]; bf16_t* rowp = Y + ((size_t)(ts & 1) * mtok + (ts >> 1)) * 1024 + col0;
#pragma unroll
                    for (int bj = 0; bj < 2; ++bj) *(u32x4*)(rowp + bj * HALF) = pack8(acc[ai][bj][m][0] * w, acc[ai][bj][m][1] * w); } }
    }
};
template <bool REL> struct GroupedOrder {
    int t0, nM, nN, nwg, G, c; const PG8_LAS int* texp;
    __device__ __forceinline__ void init(int t0_, int t1_, int nN_, int G_, int c_, const PG8_LAS int* texp_) { t0 = t0_; nM = t1_ - t0_; if (nM < 0) nM = 0; nN = nN_; nwg = nM * nN; G = G_; c = c_; texp = texp_; }
    __device__ __forceinline__ bool next(int i, Unit& u) const {
        const long L = (long)i * G + c; if (L >= nwg) return false;
        int wgid = (int)L; { const int q = nwg / NXCD, r = nwg % NXCD, xcd = wgid % NXCD, off = wgid / NXCD; wgid = (xcd < r ? xcd * (q + 1) : r * (q + 1) + (xcd - r) * q) + off; }
        const int nig = WGM * nN, gid = wgid / nig, fm = gid * WGM, gsz = (nM - fm) < WGM ? (nM - fm) : WGM;
        const int pmr = fm + ((wgid % nig) % gsz); u.pn = (wgid % nig) / gsz; u.pm = REL ? pmr : (t0 + pmr); u.pb = texp[t0 + pmr] * nN + u.pn; return true;
    }
    __device__ __forceinline__ void a_ready(const Unit&) const {}
    __device__ __forceinline__ void done(const Unit&) const {}
};
template <class Epi, class Sched, bool ALIGN_EPI = false, bool SP2 = false>
__device__ __forceinline__ void gemm_phase(PG8_LAS unsigned char* lds, const Gemm g, const Sched& S, const Epi& E) {
    const int tid = threadIdx.x, wid = __builtin_amdgcn_readfirstlane(tid >> 6), lane = tid & 63, wr = wid >> 2, wc = wid & 3, fr = lane & 15, fq = lane >> 4;
    const int K = g.K, nt = K / BK;
    unsigned voffA[2], voffB[2];
#pragma unroll
    for (int i = 0; i < 2; ++i) { int R, C; stage_rc(tid * 16 + i * 8192, R, C); const int Rb = Epi::PERM ? ((R & ~31) + perm32(R & 31)) : R;
        voffA[i] = (unsigned)(R * K + C) * 2u; voffB[i] = (unsigned)(Rb * K + C) * 2u; }
    const size_t kstep = (size_t)(BK * 2);
    const size_t hstep = (size_t)HALF * K * 2;
    const size_t tstep = 2 * hstep;
    const unsigned ldsw = (unsigned)wid * 1024u;
    const int aoff = lds_byte(wr * 64 + fr, fq * 8), boff = lds_byte(wc * 32 + fr, fq * 8);
#define PG8_SA(b, h) (((b) * 2 + (h)) * HTB)
#define PG8_SB(b, h) ((4 + (b) * 2 + (h)) * HTB)
#define PG8_STAGE(bufoff, gbase, voff) do { _Pragma("unroll") for (int _i = 0; _i < 2; ++_i) \
        __builtin_amdgcn_global_load_lds((const unsigned*)((const char*)(gbase) + (voff)[_i]), (PG8_LAS unsigned*)(lds + (bufoff) + ldsw + _i * 8192), 16, 0, 0); } while (0)
#define PG8_LDA(dst, b, h) do { _Pragma("unroll") for (int m = 0; m < 4; ++m) _Pragma("unroll") for (int k = 0; k < 2; ++k) dst[m][k] = *(const PG8_LAS bf16x8*)(lds + PG8_SA(b, h) + aoff + m * 2048 + k * 1024); } while (0)
#define PG8_LDB(dst, b, h) do { _Pragma("unroll") for (int n = 0; n < 2; ++n) _Pragma("unroll") for (int k = 0; k < 2; ++k) dst[n][k] = *(const PG8_LAS bf16x8*)(lds + PG8_SB(b, h) + boff + n * 2048 + k * 1024); } while (0)
#define PG8_MMA(ai, bj, At, Bt) do { __builtin_amdgcn_s_setprio(1); _Pragma("unroll") for (int m = 0; m < 4; ++m) _Pragma("unroll") for (int n = 0; n < 2; ++n) _Pragma("unroll") for (int k = 0; k < 2; ++k) \
        acc[ai][bj][m][n] = __builtin_amdgcn_mfma_f32_16x16x32_bf16(Bt[n][k], At[m][k], acc[ai][bj][m][n], 0, 0, 0); __builtin_amdgcn_s_setprio(0); } while (0)
#define PG8_WAIT_V(n) asm volatile("s_waitcnt vmcnt(" #n ")" ::: "memory")
#define PG8_WAIT_L(n) asm volatile("s_waitcnt lgkmcnt(" #n ")" ::: "memory")
#define PG8_BAR __builtin_amdgcn_s_barrier()
#define PG8_SCHED __builtin_amdgcn_sched_barrier(0)
    Unit cur, nxt; int ui = 0;
    if (!S.next(0, cur)) return;
    f32x4 acc[2][2][4][2];
#pragma unroll
    for (int a = 0; a < 2; ++a)
#pragma unroll
        for (int b = 0; b < 2; ++b)
#pragma unroll
            for (int m = 0; m < 4; ++m)
#pragma unroll
                for (int n = 0; n < 2; ++n) acc[a][b][m][n] = (f32x4){0.f, 0.f, 0.f, 0.f};
    bf16x8 At[4][2], B0[2][2], B1[2][2];
    const char* cA = (const char*)g.A + (size_t)cur.pm * tstep; const char* cB = (const char*)g.Bt + (size_t)cur.pb * tstep;
    S.a_ready(cur);
    if constexpr (SP2) {
        PG8_STAGE(PG8_SB(0, 0), cB, voffB); PG8_STAGE(PG8_SB(0, 1), cB + hstep, voffB); PG8_STAGE(PG8_SA(0, 0), cA, voffA); PG8_STAGE(PG8_SA(0, 1), cA + hstep, voffA);
        if (wr == 1) PG8_BAR;
        PG8_WAIT_V(2); PG8_BAR;
        PG8_STAGE(PG8_SB(1, 0), cB + kstep, voffB); PG8_STAGE(PG8_SA(1, 0), cA + kstep, voffA); PG8_STAGE(PG8_SB(1, 1), cB + hstep + kstep, voffB);
        PG8_WAIT_V(6); PG8_BAR;
    } else {
        PG8_STAGE(PG8_SB(0, 0), cB, voffB); PG8_STAGE(PG8_SA(0, 0), cA, voffA); PG8_STAGE(PG8_SB(0, 1), cB + hstep, voffB); PG8_STAGE(PG8_SA(0, 1), cA + hstep, voffA);
        if (wr == 1) PG8_BAR;
        PG8_WAIT_V(4); PG8_BAR;
        PG8_STAGE(PG8_SB(1, 0), cB + kstep, voffB); PG8_STAGE(PG8_SA(1, 0), cA + kstep, voffA); PG8_STAGE(PG8_SB(1, 1), cB + hstep + kstep, voffB);
        PG8_WAIT_V(6); PG8_BAR;
    }
    for (;;) {
        const bool has_next = S.next(ui + 1, nxt);
        const char* nA = has_next ? (const char*)g.A + (size_t)nxt.pm * tstep : cA; const char* nB = has_next ? (const char*)g.Bt + (size_t)nxt.pb * tstep : cB;
        for (int t = 0; t < nt; t += 2) {
            const bool last = (t == nt - 2);
            const char* a1 = cA + (size_t)(t + 1) * kstep;
            const char* a2 = last ? nA : cA + (size_t)(t + 2) * kstep; const char* b2 = last ? nB : cB + (size_t)(t + 2) * kstep;
            const char* a3 = a2 + kstep; const char* b3 = b2 + kstep;
            if (last && has_next) S.a_ready(nxt);
            if constexpr (SP2) {
            PG8_LDB(B0, 0, 0); PG8_LDB(B1, 0, 1); PG8_SCHED; PG8_LDA(At, 0, 0); PG8_STAGE(PG8_SA(1, 1), a1 + hstep, voffA);
            PG8_WAIT_V(8); PG8_WAIT_L(0); PG8_BAR; PG8_MMA(0, 0, At, B0); PG8_MMA(0, 1, At, B1); PG8_BAR; PG8_SCHED;
            PG8_LDA(At, 0, 1); PG8_STAGE(PG8_SB(0, 0), b2, voffB); PG8_STAGE(PG8_SB(0, 1), b2 + hstep, voffB); PG8_STAGE(PG8_SA(0, 0), a2, voffA);
            PG8_WAIT_V(8); PG8_WAIT_L(0); PG8_BAR; PG8_MMA(1, 0, At, B0); PG8_MMA(1, 1, At, B1); PG8_BAR; PG8_SCHED;
            PG8_LDB(B0, 1, 0); PG8_LDB(B1, 1, 1); PG8_SCHED; PG8_LDA(At, 1, 0); PG8_STAGE(PG8_SA(0, 1), a2 + hstep, voffA);
            PG8_WAIT_V(8); PG8_WAIT_L(0); PG8_BAR; PG8_MMA(0, 0, At, B0); PG8_MMA(0, 1, At, B1); PG8_BAR; PG8_SCHED;
            PG8_LDA(At, 1, 1); PG8_STAGE(PG8_SB(1, 0), b3, voffB); PG8_STAGE(PG8_SB(1, 1), b3 + hstep, voffB); PG8_STAGE(PG8_SA(1, 0), a3, voffA);
            PG8_WAIT_V(8); PG8_WAIT_L(0); PG8_BAR; PG8_MMA(1, 0, At, B0); PG8_MMA(1, 1, At, B1); PG8_BAR; PG8_SCHED;
            } else {
            PG8_LDB(B0, 0, 0); PG8_SCHED; PG8_LDA(At, 0, 0); PG8_STAGE(PG8_SA(1, 1), a1 + hstep, voffA);
            PG8_WAIT_L(8); PG8_BAR; PG8_WAIT_L(0); PG8_MMA(0, 0, At, B0); PG8_BAR; PG8_SCHED;
            PG8_LDB(B1, 0, 1); PG8_STAGE(PG8_SB(0, 0), b2, voffB);
            PG8_BAR; PG8_WAIT_L(0); PG8_MMA(0, 1, At, B1); PG8_BAR;
            PG8_LDA(At, 0, 1); PG8_STAGE(PG8_SA(0, 0), a2, voffA);
            PG8_BAR; PG8_WAIT_L(0); PG8_MMA(1, 0, At, B0); PG8_BAR; PG8_SCHED;
            PG8_STAGE(PG8_SB(0, 1), b2 + hstep, voffB);
            PG8_WAIT_V(6); PG8_BAR; PG8_MMA(1, 1, At, B1); PG8_BAR;
            PG8_LDB(B0, 1, 0); PG8_SCHED; PG8_LDA(At, 1, 0); PG8_STAGE(PG8_SA(0, 1), a2 + hstep, voffA);
            PG8_WAIT_L(8); PG8_BAR; PG8_WAIT_L(0); PG8_MMA(0, 0, At, B0); PG8_BAR; PG8_SCHED;
            PG8_LDB(B1, 1, 1); PG8_STAGE(PG8_SB(1, 0), b3, voffB);
            PG8_BAR; PG8_WAIT_L(0); PG8_MMA(0, 1, At, B1); PG8_BAR;
            PG8_LDA(At, 1, 1); PG8_STAGE(PG8_SA(1, 0), a3, voffA);
            PG8_BAR; PG8_WAIT_L(0); PG8_MMA(1, 0, At, B0); PG8_BAR; PG8_SCHED;
            PG8_STAGE(PG8_SB(1, 1), b3 + hstep, voffB);
            PG8_WAIT_V(6); PG8_BAR; PG8_MMA(1, 1, At, B1); PG8_BAR;
            }
        }
        if constexpr (ALIGN_EPI) { if (wr == 0) PG8_BAR; }
        if constexpr (!Epi::AFTER_DRAIN) { E(acc, cur, wr, wc, fr, fq); S.done(cur); }
        if (!has_next) break;
#pragma unroll
        for (int a = 0; a < 2; ++a)
#pragma unroll
            for (int b = 0; b < 2; ++b)
#pragma unroll
                for (int m = 0; m < 4; ++m)
#pragma unroll
                    for (int n = 0; n < 2; ++n) acc[a][b][m][n] = (f32x4){0.f, 0.f, 0.f, 0.f};
        cur = nxt; cA = nA; cB = nB; ++ui;
        if constexpr (ALIGN_EPI) { if (wr == 1) PG8_BAR; }
    }
    PG8_WAIT_V(0);
    if constexpr (!ALIGN_EPI) { if (wr == 0) PG8_BAR; }
    PG8_BAR;
    if constexpr (Epi::AFTER_DRAIN) { E.fused(acc, cur, wr, wc, fr, fq, lds, wid, lane); S.done(cur); }
#undef PG8_SA
#undef PG8_SB
#undef PG8_STAGE
#undef PG8_LDA
#undef PG8_LDB
#undef PG8_MMA
#undef PG8_WAIT_V
#undef PG8_WAIT_L
#undef PG8_BAR
#undef PG8_SCHED
}
}

constexpr int NWAVES = 8;
constexpr int BATCH = 2, SEQ = 8192, D = 1024, M = BATCH * SEQ;
constexpr int NPROJ = 3072, NIN = 3080;
constexpr int AH = 8, NB = 32;
constexpr int C_AQ = 0, C_AK = 512, C_AV = 1024, C_MQ = 1536, C_MK = 1792, C_MV = 2048, C_MO = 2560;
constexpr int MH = 4, MLC = 128, NCH = SEQ / MLC;
constexpr int DFF = 2816, NE = 8, DEX = 3584;
constexpr int MAXT = 136;
constexpr int CAP = 70;
constexpr float LN_EPS = 1e-5f, RMS_EPS = 1e-6f;
constexpr float ALPHA = 1.41421356237309515f;
constexpr float QSCALE = 0.125f * 1.4426950408889634f;

constexpr size_t MiB = 1u << 20;
constexpr size_t WS_CTL = 0, CTL_ZERO_BYTES = 1 * MiB;
constexpr size_t WS_ROPE = 1 * MiB;
constexpr size_t WS_GATES = 2 * MiB;
constexpr size_t WS_ROWMAP = 2 * MiB + 512 * 1024, WS_ROWW = 2 * MiB + 768 * 1024;
constexpr size_t WS_LIST = 3 * MiB, WS_LISTW = 3 * MiB + 512 * 1024;
constexpr size_t WS_WIN = 4 * MiB, WS_WOUT = 16 * MiB, WS_WGU = 20 * MiB, WS_WD = 31 * MiB;
constexpr size_t WS_MGU = 37 * MiB, WS_MD = 149 * MiB;
constexpr size_t WS_MIX2 = 37 * MiB;
constexpr size_t WS_QC = 37 * MiB, WS_KC = 45 * MiB, WS_DC = 53 * MiB, WS_CST = 69 * MiB, WS_DN = 77 * MiB, WS_NST = 77 * MiB + 256 * 1024, WS_SC = 77 * MiB + 512 * 1024, WS_MC = 77 * MiB + 768 * 1024;
constexpr size_t WS_CAT2 = 141 * MiB;
constexpr size_t WS_XB = 205 * MiB, WS_X1B = 237 * MiB, WS_XR = 269 * MiB, WS_PROJ = 333 * MiB, WS_CAT = 429 * MiB;
constexpr size_t WS_MIX = 333 * MiB;
constexpr size_t WS_HD = 333 * MiB;
constexpr size_t WS_Y = 205 * MiB, WS_HM = 269 * MiB, WS_XS = 393 * MiB, WS_END = 461 * MiB;
static_assert(WS_HM + (size_t)CAP * 256 * DEX * 2 <= WS_XS && WS_XS + (size_t)MAXT * 256 * D * 2 <= WS_END, "MoE map");
static_assert(WS_HD + (size_t)M * DFF * 2 <= WS_CAT && WS_WD + (size_t)D * DFF * 2 <= WS_MGU && WS_WGU + (size_t)2 * DFF * D * 2 <= WS_WD, "map");
constexpr int CW_TMO = 0, CW_CODE = 1;
constexpr int CW_BAR = 4096;
constexpr int CW_ECNT = 16384;
constexpr int CW_DBG = 2048;
constexpr int CW_KSUM = 65536;

constexpr int LDS_BYTES = 147456;
constexpr int MISC_OFF = LDS_BYTES - 1024;
constexpr int TEXP_OFF = MISC_OFF + 256;
constexpr int XW_OFF = 100 * 1024;

#define GAS __attribute__((address_space(1)))
#define LAS __attribute__((address_space(3)))
typedef unsigned short bf16;
typedef unsigned v4u __attribute__((ext_vector_type(4)));
typedef unsigned v2u __attribute__((ext_vector_type(2)));
typedef float f32x4 __attribute__((ext_vector_type(4)));
typedef GAS unsigned gu32;
#define RLX_AGENT __ATOMIC_RELAXED, __HIP_MEMORY_SCOPE_AGENT
#define LDS_WAIT() asm volatile("s_waitcnt lgkmcnt(0)" ::: "memory")
#define VM_WAIT() asm volatile("s_waitcnt vmcnt(0)" ::: "memory")
__device__ __forceinline__ unsigned f2bf(float f) { unsigned u = __builtin_bit_cast(unsigned, f); return (u + 0x7fffu + ((u >> 16) & 1u)) >> 16; }
__device__ __forceinline__ unsigned pk2(float lo, float hi) { return f2bf(lo) | (f2bf(hi) << 16); }
__device__ __forceinline__ float bf2f(unsigned short h) { return __builtin_bit_cast(float, (unsigned)h << 16); }
__device__ __forceinline__ float bflo(unsigned w) { return __builtin_bit_cast(float, w << 16); }
__device__ __forceinline__ float bfhi(unsigned w) { return __builtin_bit_cast(float, w & 0xffff0000u); }
#define XB_TMO      128
#define XB_XCNT(j)  (256  + 64 * (j))
#define XB_XSUB(j)  (1280 + 64 * (j))
#define XB_XGEN(j)  (2304 + 64 * (j))
#define XB_TOP      3328
#define XB_TOPGEN   3392
#define XCD_BAR_WORDS 3456
#define XB_SPIN_CAP (1u << 18)

__device__ __forceinline__ unsigned xb_ld(unsigned* p)              { return __hip_atomic_load(p, __ATOMIC_RELAXED, __HIP_MEMORY_SCOPE_AGENT); }
__device__ __forceinline__ unsigned xb_add(unsigned* p, unsigned v) { return __hip_atomic_fetch_add(p, v, __ATOMIC_RELAXED, __HIP_MEMORY_SCOPE_AGENT); }
__device__ __forceinline__ unsigned xb_xcc_id() { return (unsigned)__builtin_amdgcn_s_getreg((3 << 11) | 20) & 0xFu; }
#define XB_SPIN(cond, bar) do { unsigned _sp = 0; while (cond) { __builtin_amdgcn_s_sleep(1); \
    if ((++_sp & 255u) == 0u) { if (xb_ld(&(bar)[XB_TMO])) break; if (_sp > XB_SPIN_CAP) { atomicAdd(&(bar)[XB_TMO], 1u); break; } } } } while (0)

struct XcdBarrier {
    unsigned* bar; unsigned x;
    volatile LAS unsigned* st;
};

__device__ __forceinline__ XcdBarrier xcd_barrier_post(unsigned* bar, volatile LAS unsigned* st) {
    XcdBarrier b; b.bar = bar; b.x = xb_xcc_id(); b.st = st;
    if (threadIdx.x == 0) (void)xb_add(&bar[XB_XCNT(b.x)], 1u);
    return b;
}
__device__ __forceinline__ void xcd_barrier_complete(unsigned* bar, unsigned x, unsigned& nloc, unsigned& nx) {
    const unsigned G = gridDim.x * gridDim.y * gridDim.z;
    unsigned sum, cnt, mine, sp = 0u;
    for (;;) {
        sum = 0u; cnt = 0u; mine = 0u;
#pragma unroll
        for (unsigned j = 0; j < 16; ++j) { const unsigned c = xb_ld(&bar[XB_XCNT(j)]); sum += c; cnt += (c > 0u) ? 1u : 0u; mine = (j == x) ? c : mine; }
        if (sum == G) break;
        __builtin_amdgcn_s_sleep(1);
        if ((++sp & 255u) == 0u) { if (xb_ld(&bar[XB_TMO])) break; if (sp > XB_SPIN_CAP) { atomicAdd(&bar[XB_TMO], 1u); break; } }
    }
    nloc = mine > 0u ? mine : 1u; nx = cnt > 0u ? cnt : 1u;
}

__device__ __forceinline__ void xcd_barrier(const XcdBarrier& b) {
    asm volatile("s_waitcnt vmcnt(0)" ::: "memory");
    __syncthreads();
    if (threadIdx.x == 0) {
        unsigned* bar = b.bar;
        __builtin_amdgcn_s_waitcnt(0);
        unsigned nloc = b.st[0], nx = b.st[1];
        if (nloc == 0u) { xcd_barrier_complete(bar, b.x, nloc, nx); b.st[0] = nloc; b.st[1] = nx; }
        const unsigned old = xb_add(&bar[XB_XSUB(b.x)], 1u);
        const unsigned gen = old / nloc;
        if (old + 1u == (gen + 1u) * nloc) {
            __builtin_amdgcn_fence(__ATOMIC_RELEASE, "agent");
            asm volatile("s_waitcnt vmcnt(0)" ::: "memory");
            const unsigned og = xb_add(&bar[XB_TOP], 1u);
            const unsigned tg = og / nx;
            if (og + 1u == (tg + 1u) * nx) xb_add(&bar[XB_TOPGEN], 1u);
            else XB_SPIN(xb_ld(&bar[XB_TOPGEN]) == tg, bar);
            __builtin_amdgcn_fence(__ATOMIC_ACQUIRE, "agent");
            xb_add(&bar[XB_XGEN(b.x)], 1u);
            asm volatile("s_waitcnt vmcnt(0)" ::: "memory");
        } else {
            XB_SPIN(xb_ld(&bar[XB_XGEN(b.x)]) == gen, bar);
            __builtin_amdgcn_fence(__ATOMIC_ACQUIRE, "agent");
            asm volatile("s_waitcnt vmcnt(0)" ::: "memory");
        }
    }
    __syncthreads();
}

struct Frame {
    LAS unsigned char* lds;
    volatile LAS unsigned* MISC;
    gu32* ctl;
    int tid, lane, wave;
    int vcu, G;
    unsigned char* ws;
};
__device__ __forceinline__ float wave_sum(float v) {
#pragma unroll
    for (int o = 1; o < 64; o <<= 1) v += __shfl_xor(v, o);
    return v;
}
__device__ __forceinline__ float wave_max(float v) {
#pragma unroll
    for (int o = 1; o < 64; o <<= 1) v = fmaxf(v, __shfl_xor(v, o));
    return v;
}
__device__ __forceinline__ void transpose_item(const float* W, int ldw, int k0, int n0, bf16* WT, int K, int drow0, LAS float* scr, int lane) {
#pragma unroll 8
    for (int i = 0; i < 32; ++i) { const int kk = 2 * i + (lane >> 5); scr[kk * 33 + (lane & 31)] = W[(size_t)(k0 + kk) * ldw + n0 + (lane & 31)]; }
    LDS_WAIT(); asm volatile("" ::: "memory");
    const int c = lane & 7;
#pragma unroll
    for (int j = 0; j < 4; ++j) { const int n = (lane >> 3) + 8 * j; const LAS float* s = scr + (8 * c) * 33 + n;
        v4u o; o.x = pk2(s[0 * 33], s[1 * 33]); o.y = pk2(s[2 * 33], s[3 * 33]); o.z = pk2(s[4 * 33], s[5 * 33]); o.w = pk2(s[6 * 33], s[7 * 33]);
        *(GAS v4u*)(WT + (size_t)(drow0 + n) * K + k0 + 8 * c) = o; }
    LDS_WAIT(); asm volatile("" ::: "memory");
}
__device__ __forceinline__ void cvt_plain(const float* W, int ldw, int coff, int K, int N, bf16* WT, LAS float* scr, int it, int lane) {
    const int nblk = N / 32, kb = it / nblk, nb = it % nblk; transpose_item(W, ldw, 64 * kb, coff + 32 * nb, WT, K, 32 * nb, scr, lane);
}
__device__ __forceinline__ void cvt_gu(const float* Wg, const float* Wu, int K, int N, bf16* WT, LAS float* scr, int it, int lane) {
    const int nblk = N / 32, per = (K / 64) * nblk; const int isu = it >= per; if (isu) it -= per; const int kb = it / nblk, nb = it % nblk, n0 = 32 * nb;
    transpose_item(isu ? Wu : Wg, N, 64 * kb, n0, WT, K, (n0 / 128) * 256 + (n0 % 128) + (isu ? 128 : 0), scr, lane);
}
__device__ __forceinline__ void stage_xw(Frame& F, const float* W, int ldw, int coff) {
    LAS float* xw = (LAS float*)(F.lds + XW_OFF);
    for (int idx = F.tid; idx < 8192; idx += NWAVES * 64) { const int k = idx >> 3, g = idx & 7; xw[g * 1024 + k] = W[(size_t)k * ldw + coff + g]; }
    LDS_WAIT(); __syncthreads();
}
__device__ __forceinline__ void row_dot8(Frame& F, const f32x4 (&v)[4], float (&acc)[8]) {
    const LAS f32x4* xw = (const LAS f32x4*)(F.lds + XW_OFF);
#pragma unroll
    for (int g = 0; g < 8; ++g) { float a = 0.f;
#pragma unroll
        for (int j = 0; j < 4; ++j) { const f32x4 w = xw[g * 256 + j * 64 + F.lane]; a += v[j][0] * w[0] + v[j][1] * w[1] + v[j][2] * w[2] + v[j][3] * w[3]; }
        acc[g] = wave_sum(a); }
}
__device__ __forceinline__ float log_sigmoid(float x) { return fminf(x, 0.f) - log1pf(expf(-fabsf(x))); }
__device__ __forceinline__ void store_row_bf16(bf16* orow, const f32x4 (&y)[4], int lane) {
    GAS unsigned long long* o8 = (GAS unsigned long long*)orow + lane;
#pragma unroll
    for (int j = 0; j < 4; ++j) o8[64 * j] = (unsigned long long)pk2(y[j][0], y[j][1]) | ((unsigned long long)pk2(y[j][2], y[j][3]) << 32);
}
__device__ __forceinline__ void write_gates(Frame& F, const f32x4 (&y)[4], const float* gbias, float* grow) {
    float a[8]; row_dot8(F, y, a);
    if (F.lane < 8) { float r = 0.f;
#pragma unroll
        for (int g = 0; g < 8; ++g) if (F.lane == g) r = a[g];
        r += gbias[F.lane]; if (F.lane >= 4) r = log_sigmoid(r); grow[F.lane] = r; }
}
struct In {
    const float* x; const int* pos; const float *w_in, *gate_bias, *conv_w, *conv_b, *norm_attn, *norm_ml, *w_out, *ln1_g, *ln1_b, *dg, *du, *dd, *router_w, *router_b, *mg, *mu, *md, *ln2_g, *ln2_b;
};
__device__ __forceinline__ void p_prologue(Frame& F, const In& I) {
    unsigned char* ws = F.ws;
    stage_xw(F, I.w_in, NIN, NPROJ);
    LAS float* scr = (LAS float*)(F.lds + F.wave * 8704);
    const int gw = F.vcu * NWAVES + F.wave, NGW = F.G * NWAVES;
    constexpr int I_IN = (D / 64) * (NPROJ / 32), I_OUT = (D / 64) * (D / 32), I_GU = 2 * (D / 64) * (DFF / 32), I_DD = (DFF / 64) * (D / 32);
    constexpr int NITEMS = 2 * I_IN + 2 * I_OUT + I_GU + I_DD;
    for (int it = gw; it < NITEMS; it += NGW) {
        int r = it;
        if (r < 2 * I_IN) { const int l = r / I_IN; r -= l * I_IN; cvt_plain(I.w_in + (size_t)l * D * NIN, NIN, 0, D, NPROJ, (bf16*)(ws + WS_WIN) + (size_t)l * NPROJ * D, scr, r, F.lane); continue; } r -= 2 * I_IN;
        if (r < 2 * I_OUT) { const int l = r / I_OUT; r -= l * I_OUT; cvt_plain(I.w_out + (size_t)l * D * D, D, 0, D, D, (bf16*)(ws + WS_WOUT) + (size_t)l * D * D, scr, r, F.lane); continue; } r -= 2 * I_OUT;
        if (r < I_GU) { cvt_gu(I.dg, I.du, D, DFF, (bf16*)(ws + WS_WGU), scr, r, F.lane); continue; } r -= I_GU;
        cvt_plain(I.dd, D, 0, DFF, D, (bf16*)(ws + WS_WD), scr, r, F.lane);
    }
    for (int e = blockIdx.x * (NWAVES * 64) + F.tid; e < M * 8; e += F.G * NWAVES * 64) { const int row = e >> 3, i = e & 7;
        const float inv = powf(500000.0f, -(float)i / 8.0f); const float ang = (float)I.pos[row] * inv; float s, c; sincosf(ang, &s, &c);
        float* rp = (float*)(ws + WS_ROPE) + (size_t)row * 16; rp[i] = c; rp[8 + i] = s; }
    for (int m = gw; m < M; m += NGW) { const GAS f32x4* xr = (const GAS f32x4*)(I.x + (size_t)m * D) + F.lane; f32x4 v[4];
#pragma unroll
        for (int j = 0; j < 4; ++j) v[j] = xr[64 * j];
        store_row_bf16((bf16*)(ws + WS_XB) + (size_t)m * D, v, F.lane);
        write_gates(F, v, I.gate_bias, (float*)(ws + WS_GATES) + (size_t)m * 8); }
}
template <int ADD, int EXTRA>
__device__ __forceinline__ void ln_phase(Frame& F, const float* res, const float* addf, const bf16* y0, const bf16* y1, const float* g, const float* bt, float* outf, bf16* outb,
                                         const float* xbias, float* gates_out, int* list, float* listw, float oscale) {
    const int gw = F.vcu * NWAVES + F.wave, NGW = F.G * NWAVES;
    f32x4 gv[4], bv[4];
#pragma unroll
    for (int j = 0; j < 4; ++j) { gv[j] = ((const GAS f32x4*)g)[64 * j + F.lane]; bv[j] = ((const GAS f32x4*)bt)[64 * j + F.lane]; }
    for (int m = gw; m < M; m += NGW) {
        const GAS f32x4* rr = (const GAS f32x4*)(res + (size_t)m * D) + F.lane; f32x4 v[4]; float s = 0.f;
        if (ADD == 0) { const GAS f32x4* ar = (const GAS f32x4*)(addf + (size_t)m * D) + F.lane;
#pragma unroll
            for (int j = 0; j < 4; ++j) v[j] = rr[64 * j] * ALPHA + ar[64 * j];
        } else { const GAS v2u* a0 = (const GAS v2u*)(y0 + (size_t)m * D) + F.lane; const GAS v2u* a1 = (const GAS v2u*)(y1 + (size_t)m * D) + F.lane;
#pragma unroll
            for (int j = 0; j < 4; ++j) { const v2u p = a0[64 * j], q = a1[64 * j]; const f32x4 a = {bflo(p.x) + bflo(q.x), bfhi(p.x) + bfhi(q.x), bflo(p.y) + bflo(q.y), bfhi(p.y) + bfhi(q.y)}; v[j] = rr[64 * j] * ALPHA + a; } }
#pragma unroll
        for (int j = 0; j < 4; ++j) s += (v[j][0] + v[j][1]) + (v[j][2] + v[j][3]);
        const float mean = wave_sum(s) * (1.f / D); float s2 = 0.f;
#pragma unroll
        for (int j = 0; j < 4; ++j) { v[j] = v[j] - mean; s2 += (v[j][0] * v[j][0] + v[j][1] * v[j][1]) + (v[j][2] * v[j][2] + v[j][3] * v[j][3]); }
        const float rstd = 1.f / sqrtf(wave_sum(s2) * (1.f / D) + LN_EPS);
#pragma unroll
        for (int j = 0; j < 4; ++j) v[j] = (v[j] * rstd * gv[j] + bv[j]) * oscale;
        GAS f32x4* of = (GAS f32x4*)(outf + (size_t)m * D) + F.lane;
#pragma unroll
        for (int j = 0; j < 4; ++j) of[64 * j] = v[j];
        if (outb) store_row_bf16(outb + (size_t)m * D, v, F.lane);
        if (EXTRA == 1) write_gates(F, v, xbias, gates_out + (size_t)m * 8);
        if (EXTRA == 2) { float a[8]; row_dot8(F, v, a);
#pragma unroll
            for (int e = 0; e < 8; ++e) a[e] += xbias[e];
            int i0 = 0; float v0 = a[0];
#pragma unroll
            for (int e = 1; e < 8; ++e) if (a[e] > v0) { v0 = a[e]; i0 = e; }
            int i1 = -1; float v1 = -INFINITY;
#pragma unroll
            for (int e = 0; e < 8; ++e) if (e != i0 && a[e] > v1) { v1 = a[e]; i1 = e; }
            const float w1 = 1.f / (1.f + expf(v0 - v1)), w0 = 1.f - w1;
            if (F.lane < 2) { const int e = F.lane ? i1 : i0; const float w = F.lane ? w1 : w0;
                const unsigned p = __hip_atomic_fetch_add((unsigned*)(F.ctl + CW_ECNT + 64 * e), 1u, RLX_AGENT);
                list[(size_t)e * M + p] = m * 2 + F.lane; listw[(size_t)e * M + p] = w; } }
    }
}
__device__ __forceinline__ int moe_plan(Frame& F) {
    LAS int* texp = (LAS int*)(F.lds + TEXP_OFF);
    if (F.tid == 0) { int t = 0;
        for (int e = 0; e < NE; ++e) { const int c = (int)__hip_atomic_load((unsigned*)(F.ctl + CW_ECNT + 64 * e), RLX_AGENT); const int nt = (c + 255) >> 8; texp[MAXT + 1 + e] = t * 256;
            for (int k = 0; k < nt && t < MAXT; ++k) texp[t++] = e; }
        texp[MAXT] = t; }
    LDS_WAIT(); __syncthreads();
    return texp[MAXT];
}
__device__ __forceinline__ void moe_gather(Frame& F, int ntiles, const bf16* X1B, bf16* XS, const int* list, const float* listw, int* rowmap, float* roww) {
    const LAS int* texp = (const LAS int*)(F.lds + TEXP_OFF);
    const int gw = F.vcu * NWAVES + F.wave, NGW = F.G * NWAVES;
    for (int r = gw; r < ntiles * 256; r += NGW) { const int e = texp[r >> 8], i = r - texp[MAXT + 1 + e];
        const int c = (int)__hip_atomic_load((unsigned*)(F.ctl + CW_ECNT + 64 * e), RLX_AGENT);
        v4u a = {0u, 0u, 0u, 0u}, b = a; int ts = -1; float w = 0.f;
        if (i < c) { ts = list[(size_t)e * M + i]; w = listw[(size_t)e * M + i]; const GAS v4u* src = (const GAS v4u*)(X1B + (size_t)(ts >> 1) * D); a = src[F.lane]; b = src[64 + F.lane]; }
        GAS v4u* dst = (GAS v4u*)(XS + (size_t)r * D); dst[F.lane] = a; dst[64 + F.lane] = b;
        if (F.lane == 0) { rowmap[r] = ts; roww[r] = w; } }
}
__device__ __forceinline__ void moe_cvt(Frame& F, const In& I) {
    LAS float* scr = (LAS float*)(F.lds + F.wave * 8704);
    const int gw = F.vcu * NWAVES + F.wave, NGW = F.G * NWAVES;
    constexpr int I_GU = 2 * (D / 64) * (DEX / 32), I_DD = (DEX / 64) * (D / 32), PER = I_GU + I_DD;
    for (int it = gw; it < NE * PER; it += NGW) { const int e = it / PER; int r = it - e * PER;
        if (r < I_GU) cvt_gu(I.mg + (size_t)e * D * DEX, I.mu + (size_t)e * D * DEX, D, DEX, (bf16*)(F.ws + WS_MGU) + (size_t)e * 2 * DEX * D, scr, r, F.lane);
        else cvt_plain(I.md + (size_t)e * DEX * D, D, 0, DEX, D, (bf16*)(F.ws + WS_MD) + (size_t)e * D * DEX, scr, r - I_GU, F.lane); }
}

__device__ __forceinline__ float dot64_bf16(const LAS float* qs, const bf16* kr) {
    const GAS v4u* kp = (const GAS v4u*)kr; float a = 0.f;
#pragma unroll
    for (int c = 0; c < 8; ++c) { const v4u w = kp[c]; const LAS f32x4* q4 = (const LAS f32x4*)(qs + 8 * c); const f32x4 qa = q4[0], qb = q4[1];
        a += qa[0] * bflo(w.x) + qa[1] * bfhi(w.x) + qa[2] * bflo(w.y) + qa[3] * bfhi(w.y) + qb[0] * bflo(w.z) + qb[1] * bfhi(w.z) + qb[2] * bflo(w.w) + qb[3] * bfhi(w.w); }
    return a;
}
__device__ __forceinline__ void attn_naive(Frame& F, const bf16* PROJ, const float* ksum, const float* norm_attn, bf16* CAT, int w_lo, int w_n) {
    LAS float* qs = (LAS float*)(F.lds + F.wave * 4608); LAS float* ps = qs + 64;
    const int lane = F.lane; const int gwa = F.vcu * NWAVES + F.wave - w_lo;
    if (gwa < 0) return;
    for (int task = gwa; task < M * AH; task += w_n) {
        const int bh = task >> 13, t = task & 8191, b = bh >> 3, h = bh & 7; const size_t row = (size_t)b * SEQ + t; const int blk = t >> 8;
        qs[lane] = bf2f(PROJ[row * NPROJ + C_AQ + h * 64 + lane]); LDS_WAIT();
        float g = -INFINITY;
        if (lane < blk) { const float* km = ksum + ((size_t)(b * NB + lane) * 512 + h * 64); float a = 0.f;
            for (int d = 0; d < 64; ++d) a += qs[d] * km[d];
            g = a; }
        int sel[3];
#pragma unroll
        for (int k = 0; k < 3; ++k) { float v = g; int idx = lane;
#pragma unroll
            for (int o = 1; o < 64; o <<= 1) { const float ov = __shfl_xor(v, o); const int oi = __shfl_xor(idx, o); if (ov > v || (ov == v && oi < idx)) { v = ov; idx = oi; } }
            idx = __builtin_amdgcn_readfirstlane(idx); const bool ok = __builtin_amdgcn_readfirstlane(v > -INFINITY ? 1 : 0) != 0;
            sel[k] = ok ? idx : -1; if (lane == idx) g = -INFINITY; }
        float sc[4][4]; float mx = -INFINITY;
#pragma unroll
        for (int s = 0; s < 4; ++s) { const int jb = (s < 3) ? sel[s] : blk;
#pragma unroll
            for (int i = 0; i < 4; ++i) { float a = -INFINITY;
                if (jb >= 0) { const int kp = jb * 256 + i * 64 + lane; if (s < 3 || kp <= t) a = dot64_bf16(qs, PROJ + ((size_t)b * SEQ + kp) * NPROJ + C_AK + h * 64); }
                sc[s][i] = a; mx = fmaxf(mx, a); } }
        mx = wave_max(mx); float sum = 0.f;
#pragma unroll
        for (int s = 0; s < 4; ++s)
#pragma unroll
            for (int i = 0; i < 4; ++i) { const float p = __builtin_amdgcn_exp2f(sc[s][i] - mx); sum += p; ps[s * 256 + i * 64 + lane] = p; }
        sum = wave_sum(sum); LDS_WAIT();
        float o = 0.f;
#pragma unroll
        for (int s = 0; s < 4; ++s) { const int jb = (s < 3) ? sel[s] : blk; if (jb < 0) continue; const int kmax = (s < 3) ? 256 : (t - blk * 256 + 1);
            const bf16* vb = PROJ + ((size_t)b * SEQ + jb * 256) * NPROJ + C_AV + h * 64 + lane;
#pragma unroll 8
            for (int k = 0; k < kmax; ++k) o += ps[s * 256 + k] * bf2f(vb[(size_t)k * NPROJ]); }
        o = o / sum; const float ms = wave_sum(o * o) * (1.f / 64.f);
        o = o * (1.f / sqrtf(ms + RMS_EPS)) * norm_attn[h * 64 + lane];
        CAT[row * D + h * 64 + lane] = (bf16)f2bf(o);
        LDS_WAIT();
    }
}
__device__ __forceinline__ void mlstm_naive(Frame& F, int bh, const bf16* PROJ, const float* GATES, const float* conv_w, const float* conv_b, const float* norm_ml, bf16* CAT) {
    const int b = bh >> 2, h = bh & 3, tid = F.tid;
    LAS float* Cst = (LAS float*)(F.lds);
    LAS float* nst = (LAS float*)(F.lds + 33280);
    LAS float* qf = (LAS float*)(F.lds + 33792);
    LAS float* kf = (LAS float*)(F.lds + 67072);
    LAS bf16* vb = (LAS bf16*)(F.lds + 100352);
    LAS float* bs = (LAS float*)(F.lds + 133120);
    LAS float* ig = bs + 128;
    LAS float* mt = bs + 256;
    LAS float* wst = bs + 384;
    LAS float* scal = bs + 512;
    for (int e = tid; e < 128 * 65; e += 512) Cst[e] = 0.f;
    if (tid < 64) nst[tid] = 0.f;
    if (tid == 0) scal[0] = 0.f;
    __syncthreads();
    for (int c = 0; c < NCH; ++c) {
        const size_t row0 = (size_t)b * SEQ + (size_t)c * MLC;
        if (tid < 128) { ig[tid] = GATES[(row0 + tid) * 8 + h]; bs[tid] = GATES[(row0 + tid) * 8 + 4 + h]; }
        for (int e = tid; e < 128 * 128; e += 512) { const int t = e >> 7, cc = e & 127; const int isk = cc >> 6, d = cc & 63; const int ch = isk * 256 + h * 64 + d;
            float a = conv_b[ch];
#pragma unroll
            for (int j = 0; j < 4; ++j) { const int tt = c * MLC + t - 3 + j; if (tt >= 0) a += conv_w[j * 512 + ch] * bf2f(PROJ[((size_t)b * SEQ + tt) * NPROJ + C_MQ + ch]); }
            a = a / (1.f + expf(-a));
            if (isk) kf[t * 65 + d] = a; else qf[t * 65 + d] = a * 0.125f; }
        for (int e = tid; e < 128 * 128; e += 512) { const int t = e >> 7, vv = e & 127; vb[t * 128 + vv] = PROJ[(row0 + t) * NPROJ + C_MV + h * 128 + vv]; }
        __syncthreads();
        if (tid == 0) { const float mc = scal[0]; float run = 0.f, cm = -INFINITY;
            for (int t = 0; t < 128; ++t) { run += bs[t]; bs[t] = run; cm = fmaxf(cm, ig[t] - run); mt[t] = run + fmaxf(mc, cm); }
            const float bl = run; const float mnew = fmaxf(bl + mc, bl + cm); scal[1] = mnew; scal[2] = bl; }
        __syncthreads();
        if (tid < 128) wst[tid] = expf(scal[2] - bs[tid] + ig[tid] - scal[1]);
#pragma unroll 1
        for (int pass = 0; pass < 2; ++pass) {
            const int t = pass * 64 + (tid >> 3), vq = tid & 7; const float mc = scal[0]; const float bt = bs[t], mtt = mt[t];
            float q[64];
#pragma unroll
            for (int d = 0; d < 64; ++d) q[d] = qf[t * 65 + d];
            float num[16]; float den = 0.f;
#pragma unroll
            for (int j = 0; j < 16; ++j) num[j] = 0.f;
            const int tmax = pass * 64 + ((tid >> 6) << 3) + 7;
#pragma unroll 1
            for (int s = 0; s <= tmax; ++s) { if (s <= t) { float dot = 0.f;
#pragma unroll
                    for (int d = 0; d < 64; ++d) dot += q[d] * kf[s * 65 + d];
                    const float sw = dot * expf(bt - bs[s] + ig[s] - mtt); den += sw;
#pragma unroll
                    for (int j = 0; j < 16; ++j) num[j] += sw * bf2f(vb[s * 128 + vq * 16 + j]); } }
            const float wi = expf(bt + mc - mtt); float nq = 0.f;
#pragma unroll
            for (int d = 0; d < 64; ++d) nq += nst[d] * q[d];
            den += wi * nq;
            { float cq[16];
#pragma unroll
              for (int j = 0; j < 16; ++j) cq[j] = 0.f;
#pragma unroll 1
              for (int d = 0; d < 64; ++d) { const float qd = qf[t * 65 + d]; const LAS float* cr = Cst + (vq * 16) * 65 + d;
#pragma unroll
                  for (int j = 0; j < 16; ++j) cq[j] += cr[j * 65] * qd; }
#pragma unroll
              for (int j = 0; j < 16; ++j) num[j] += wi * cq[j]; }
            const float dn = 1.f / fmaxf(fabsf(den), expf(-mtt)); float ss = 0.f;
#pragma unroll
            for (int j = 0; j < 16; ++j) { num[j] *= dn; ss += num[j] * num[j]; }
            ss += __shfl_xor(ss, 1); ss += __shfl_xor(ss, 2); ss += __shfl_xor(ss, 4);
            const float rs = 1.f / sqrtf(ss * (1.f / 128.f) + RMS_EPS);
            const size_t row = row0 + t; const bf16* mo = PROJ + row * NPROJ + C_MO + h * 128 + vq * 16; bf16* out = CAT + row * D + 512 + h * 128 + vq * 16; const float* gn = norm_ml + h * 128 + vq * 16;
#pragma unroll
            for (int j = 0; j < 16; ++j) { const float o = bf2f(mo[j]); out[j] = (bf16)f2bf(num[j] * rs * gn[j] / (1.f + expf(-o))); }
        }
        __syncthreads();
        {
            const float cs = expf(scal[2] + scal[0] - scal[1]);
            for (int e = tid; e < 128 * 64; e += 512) { const int vv = e >> 6, d = e & 63; float a = 0.f;
                for (int s = 0; s < 128; ++s) a += wst[s] * bf2f(vb[s * 128 + vv]) * kf[s * 65 + d];
                Cst[vv * 65 + d] = cs * Cst[vv * 65 + d] + a; }
            if (tid < 64) { float a = 0.f; for (int s = 0; s < 128; ++s) a += wst[s] * kf[s * 65 + tid]; nst[tid] = cs * nst[tid] + a; }
        }
        __syncthreads();
        if (tid == 0) scal[0] = scal[1];
        __syncthreads();
    }
}

typedef short bf16x8_t __attribute__((ext_vector_type(8)));
#define MFMA16(a, b, c) __builtin_amdgcn_mfma_f32_16x16x32_bf16((a), (b), (c), 0, 0, 0)
__device__ __forceinline__ float wave_incl_sum(float v, int lane) {
#pragma unroll
    for (int o = 1; o < 64; o <<= 1) { const float y = __shfl_up(v, o); if (lane >= o) v += y; }
    return v;
}
__device__ __forceinline__ float wave_incl_max(float v, int lane) {
#pragma unroll
    for (int o = 1; o < 64; o <<= 1) { const float y = __shfl_up(v, o); if (lane >= o) v = fmaxf(v, y); }
    return v;
}
struct MlBufs { bf16* QC; bf16* KC; float* DC; bf16* CST; float* DN; float* NST; float* SC; float* MC; };
constexpr int ML_KW = 0, ML_VT = 17408, ML_ARR = 52224;
constexpr int MC_QS = 0, MC_KS = 18432, MC_VT = 36864, MC_CM = 76032, MC_SS = 96768, MC_ARR = 131584;

__device__ __forceinline__ void ml_stage_vt(Frame& F, const bf16* PROJ, size_t row0, int h, LAS bf16* VT) {
    for (int e = F.tid; e < 128 * 16; e += NWAVES * 64) { const int t = e >> 4, v0 = (e & 15) * 8;
        const v4u w = *(const GAS v4u*)(PROJ + (row0 + t) * NPROJ + C_MV + h * 128 + v0);
        VT[(v0 + 0) * 136 + t] = (bf16)(w.x & 0xffffu); VT[(v0 + 1) * 136 + t] = (bf16)(w.x >> 16); VT[(v0 + 2) * 136 + t] = (bf16)(w.y & 0xffffu); VT[(v0 + 3) * 136 + t] = (bf16)(w.y >> 16);
        VT[(v0 + 4) * 136 + t] = (bf16)(w.z & 0xffffu); VT[(v0 + 5) * 136 + t] = (bf16)(w.z >> 16); VT[(v0 + 6) * 136 + t] = (bf16)(w.w & 0xffffu); VT[(v0 + 7) * 136 + t] = (bf16)(w.w >> 16); }
}
__device__ __forceinline__ void ml_phase_a(Frame& F, int unit, const bf16* PROJ, const float* GATES, const float* conv_w, const float* conv_b, const MlBufs& B) {
    const int bh = unit >> 6, c = unit & 63, b = bh >> 2, h = bh & 3, tid = F.tid, lane = F.lane;
    const size_t row0 = (size_t)b * SEQ + (size_t)c * MLC;
    LAS bf16* KW = (LAS bf16*)(F.lds + ML_KW); LAS bf16* VT = (LAS bf16*)(F.lds + ML_VT);
    LAS float* wst = (LAS float*)(F.lds + ML_ARR);
    if (F.wave == 0) {
        const float i0 = GATES[(row0 + 2 * lane) * 8 + h], i1 = GATES[(row0 + 2 * lane + 1) * 8 + h], f0 = GATES[(row0 + 2 * lane) * 8 + 4 + h], f1 = GATES[(row0 + 2 * lane + 1) * 8 + 4 + h];
        const float tot = wave_incl_sum(f0 + f1, lane); const float b0 = tot - f1, b1 = tot;
        const float a0 = i0 - b0, a1 = i1 - b1; const float amax = wave_max(fmaxf(a0, a1)); const float bl = __shfl(b1, 63);
        wst[2 * lane] = expf(a0 - amax); wst[2 * lane + 1] = expf(a1 - amax);
        if (lane == 0) { B.SC[unit * 2] = bl + amax; B.SC[unit * 2 + 1] = bl; }
    }
    LDS_WAIT(); __syncthreads();
    for (int e = tid; e < 128 * 16; e += NWAVES * 64) { const int t = e >> 4, g8 = e & 15, isk = g8 >> 3, d0 = (g8 & 7) * 8; const int ch = isk * 256 + h * 64 + d0;
        float a[8];
#pragma unroll
        for (int i = 0; i < 8; ++i) a[i] = conv_b[ch + i];
#pragma unroll
        for (int j = 0; j < 4; ++j) { const int tt = c * MLC + t - 3 + j;
            if (tt >= 0) { const v4u w = *(const GAS v4u*)(PROJ + ((size_t)b * SEQ + tt) * NPROJ + C_MQ + ch); const f32x4 w0 = *(const GAS f32x4*)(conv_w + j * 512 + ch), w1 = *(const GAS f32x4*)(conv_w + j * 512 + ch + 4);
                a[0] += w0[0] * bflo(w.x); a[1] += w0[1] * bfhi(w.x); a[2] += w0[2] * bflo(w.y); a[3] += w0[3] * bfhi(w.y); a[4] += w1[0] * bflo(w.z); a[5] += w1[1] * bfhi(w.z); a[6] += w1[2] * bflo(w.w); a[7] += w1[3] * bfhi(w.w); } }
#pragma unroll
        for (int i = 0; i < 8; ++i) a[i] = a[i] / (1.f + expf(-a[i]));
        if (isk) { v4u o; o.x = pk2(a[0], a[1]); o.y = pk2(a[2], a[3]); o.z = pk2(a[4], a[5]); o.w = pk2(a[6], a[7]); *(GAS v4u*)(B.KC + (row0 + t) * 256 + h * 64 + d0) = o;
            const float ws = wst[t];
#pragma unroll
            for (int i = 0; i < 8; ++i) KW[(d0 + i) * 136 + t] = (bf16)f2bf(a[i] * ws);
        } else { v4u o; o.x = pk2(a[0] * 0.125f, a[1] * 0.125f); o.y = pk2(a[2] * 0.125f, a[3] * 0.125f); o.z = pk2(a[4] * 0.125f, a[5] * 0.125f); o.w = pk2(a[6] * 0.125f, a[7] * 0.125f);
            *(GAS v4u*)(B.QC + (row0 + t) * 256 + h * 64 + d0) = o; } }
    ml_stage_vt(F, PROJ, row0, h, VT);
    LDS_WAIT(); __syncthreads();
    {
        const int w = F.wave, r = lane & 15, q4 = lane >> 4; f32x4 acc[4];
#pragma unroll
        for (int nt = 0; nt < 4; ++nt) acc[nt] = (f32x4){0.f, 0.f, 0.f, 0.f};
#pragma unroll
        for (int ks = 0; ks < 4; ++ks) { const bf16x8_t a = *(const LAS bf16x8_t*)(VT + (16 * w + r) * 136 + 32 * ks + 8 * q4);
#pragma unroll
            for (int nt = 0; nt < 4; ++nt) { const bf16x8_t bb = *(const LAS bf16x8_t*)(KW + (16 * nt + r) * 136 + 32 * ks + 8 * q4); acc[nt] = MFMA16(a, bb, acc[nt]); } }
        float* dc = B.DC + (size_t)unit * 8192;
#pragma unroll
        for (int nt = 0; nt < 4; ++nt)
#pragma unroll
            for (int j = 0; j < 4; ++j) dc[(16 * w + 4 * q4 + j) * 64 + 16 * nt + r] = acc[nt][j];
        if (tid < 64) { float s = 0.f; for (int t = 0; t < 128; ++t) s += bf2f(KW[tid * 136 + t]); B.DN[unit * 64 + tid] = s; }
    }
    LDS_WAIT(); __syncthreads();
}
__device__ __forceinline__ void ml_phase_b(Frame& F, int u, const MlBufs& B) {
    const int bh = u >> 5, eb = (u & 31) * 256, tid = F.tid;
    LAS float* sC = (LAS float*)(F.lds); LAS float* sD = sC + 64;
    LAS float* scl = sD + 64;
    if (tid < 128) scl[tid] = B.SC[bh * 128 + tid];
    LDS_WAIT(); __syncthreads();
    if (tid == 0) { float m = 0.f;
        for (int c = 0; c < 64; ++c) { const float ac = scl[c * 2], bl = scl[c * 2 + 1]; const float mn = fmaxf(bl + m, ac);
            sC[c] = expf(bl + m - mn); sD[c] = expf(ac - mn); if ((u & 31) == 0) B.MC[bh * 64 + c] = m; m = mn; } }
    LDS_WAIT(); __syncthreads();
    if (tid < 256) { float C = 0.f; const float* dc = B.DC + (size_t)bh * 64 * 8192 + eb + tid; bf16* cs = B.CST + (size_t)bh * 64 * 8192 + eb + tid;
#pragma unroll 8
        for (int c = 0; c < 64; ++c) { cs[(size_t)c * 8192] = (bf16)f2bf(C); C = sC[c] * C + sD[c] * dc[(size_t)c * 8192]; } }
    else if (tid < 320 && (u & 31) == 0) { const int d = tid - 256; float n = 0.f;
        for (int c = 0; c < 64; ++c) { B.NST[(bh * 64 + c) * 64 + d] = n; n = sC[c] * n + sD[c] * B.DN[(bh * 64 + c) * 64 + d]; } }
    __syncthreads();
}
__device__ __forceinline__ void ml_phase_c(Frame& F, int unit, const bf16* PROJ, const float* GATES, const float* norm_ml, bf16* CAT, const MlBufs& B) {
    const int bh = unit >> 6, c = unit & 63, b = bh >> 2, h = bh & 3, tid = F.tid, lane = F.lane;
    const size_t row0 = (size_t)b * SEQ + (size_t)c * MLC;
    LAS bf16* QS = (LAS bf16*)(F.lds + MC_QS); LAS bf16* KS = (LAS bf16*)(F.lds + MC_KS); LAS bf16* VT = (LAS bf16*)(F.lds + MC_VT); LAS bf16* CM = (LAS bf16*)(F.lds + MC_CM); LAS bf16* SS = (LAS bf16*)(F.lds + MC_SS);
    LAS float* aa = (LAS float*)(F.lds + MC_ARR); LAS float* rt = aa + 128; LAS float* wint = aa + 256; LAS float* emt = aa + 384;
    if (F.wave == 0) {
        const float mc = B.MC[unit];
        const float i0 = GATES[(row0 + 2 * lane) * 8 + h], i1 = GATES[(row0 + 2 * lane + 1) * 8 + h], f0 = GATES[(row0 + 2 * lane) * 8 + 4 + h], f1 = GATES[(row0 + 2 * lane + 1) * 8 + 4 + h];
        const float tot = wave_incl_sum(f0 + f1, lane); const float b0 = tot - f1, b1 = tot;
        const float a0 = i0 - b0, a1 = i1 - b1; const float cmx = wave_incl_max(fmaxf(a0, a1), lane); const float cmprev = __shfl_up(cmx, 1);
        const float cm0 = (lane == 0) ? a0 : fmaxf(cmprev, a0), cm1 = cmx;
        const float mt0 = b0 + fmaxf(mc, cm0), mt1 = b1 + fmaxf(mc, cm1);
        aa[2 * lane] = a0; aa[2 * lane + 1] = a1; rt[2 * lane] = b0 - mt0; rt[2 * lane + 1] = b1 - mt1;
        wint[2 * lane] = expf(b0 + mc - mt0); wint[2 * lane + 1] = expf(b1 + mc - mt1); emt[2 * lane] = expf(-mt0); emt[2 * lane + 1] = expf(-mt1);
    }
    for (int e = tid; e < 128 * 8; e += NWAVES * 64) { const int t = e >> 3, ch = (e & 7) * 8;
        *(LAS v4u*)(QS + t * 72 + ch) = *(const GAS v4u*)(B.QC + (row0 + t) * 256 + h * 64 + ch);
        *(LAS v4u*)(KS + t * 72 + ch) = *(const GAS v4u*)(B.KC + (row0 + t) * 256 + h * 64 + ch);
        *(LAS v4u*)(CM + t * 72 + ch) = *(const GAS v4u*)(B.CST + (size_t)unit * 8192 + t * 64 + ch); }
    ml_stage_vt(F, PROJ, row0, h, VT);
    for (int e = tid; e < 16 * 128; e += NWAVES * 64) { const int rr = e >> 7, cc = e & 127; VT[(128 + rr) * 136 + cc] = (rr == 0) ? (bf16)0x3f80 : (bf16)0; }
    for (int e = tid; e < 16 * 64; e += NWAVES * 64) { const int rr = e >> 6, cc = e & 63; CM[(128 + rr) * 72 + cc] = (rr == 0) ? (bf16)f2bf(B.NST[unit * 64 + cc]) : (bf16)0; }
    LDS_WAIT(); __syncthreads();
    const int w = F.wave, r = lane & 15, q4 = lane >> 4;
    {
        bf16x8_t a[2];
#pragma unroll
        for (int ks = 0; ks < 2; ++ks) a[ks] = *(const LAS bf16x8_t*)(QS + (16 * w + r) * 72 + 32 * ks + 8 * q4);
        float rtj[4];
#pragma unroll
        for (int j = 0; j < 4; ++j) rtj[j] = rt[16 * w + 4 * q4 + j];
        for (int nt = 0; nt <= (w | 1); ++nt) { f32x4 acc = {0.f, 0.f, 0.f, 0.f};
#pragma unroll
            for (int ks = 0; ks < 2; ++ks) { const bf16x8_t bb = *(const LAS bf16x8_t*)(KS + (16 * nt + r) * 72 + 32 * ks + 8 * q4); acc = MFMA16(a[ks], bb, acc); }
            const int s = 16 * nt + r; const float as = aa[s];
#pragma unroll
            for (int j = 0; j < 4; ++j) { const int t = 16 * w + 4 * q4 + j; const float v = (s <= t) ? acc[j] * expf(rtj[j] + as) : 0.f; SS[t * 136 + s] = (bf16)f2bf(v); } }
    }
    LDS_WAIT();
    f32x4 accS[9], accQ[9];
#pragma unroll
    for (int nt = 0; nt < 9; ++nt) { accS[nt] = (f32x4){0.f, 0.f, 0.f, 0.f}; accQ[nt] = (f32x4){0.f, 0.f, 0.f, 0.f}; }
    for (int ks = 0; ks <= (16 * w + 15) / 32; ++ks) { const bf16x8_t a = *(const LAS bf16x8_t*)(SS + (16 * w + r) * 136 + 32 * ks + 8 * q4);
#pragma unroll
        for (int nt = 0; nt < 9; ++nt) { const bf16x8_t bb = *(const LAS bf16x8_t*)(VT + (16 * nt + r) * 136 + 32 * ks + 8 * q4); accS[nt] = MFMA16(a, bb, accS[nt]); } }
#pragma unroll
    for (int ks = 0; ks < 2; ++ks) { const bf16x8_t a = *(const LAS bf16x8_t*)(QS + (16 * w + r) * 72 + 32 * ks + 8 * q4);
#pragma unroll
        for (int nt = 0; nt < 9; ++nt) { const bf16x8_t bb = *(const LAS bf16x8_t*)(CM + (16 * nt + r) * 72 + 32 * ks + 8 * q4); accQ[nt] = MFMA16(a, bb, accQ[nt]); } }
    LDS_WAIT();
    {
        float gn[8];
#pragma unroll
        for (int nt = 0; nt < 8; ++nt) gn[nt] = norm_ml[h * 128 + 16 * nt + r];
#pragma unroll
        for (int j = 0; j < 4; ++j) { const int t = 16 * w + 4 * q4 + j; const float wi = wint[t];
            const float dS = __shfl(accS[8][j], lane & 48), dQ = __shfl(accQ[8][j], lane & 48);
            const float den = dS + wi * dQ; const float dn = 1.f / fmaxf(fabsf(den), emt[t]);
            float hv[8]; float ss = 0.f;
#pragma unroll
            for (int nt = 0; nt < 8; ++nt) { hv[nt] = (accS[nt][j] + wi * accQ[nt][j]) * dn; ss += hv[nt] * hv[nt]; }
            ss += __shfl_xor(ss, 1); ss += __shfl_xor(ss, 2); ss += __shfl_xor(ss, 4); ss += __shfl_xor(ss, 8);
            const float rs = 1.f / sqrtf(ss * (1.f / 128.f) + RMS_EPS);
#pragma unroll
            for (int nt = 0; nt < 8; ++nt) SS[t * 136 + 16 * nt + r] = (bf16)f2bf(hv[nt] * rs * gn[nt]); }
    }
    LDS_WAIT();
    for (int e = lane; e < 16 * 16; e += 64) { const int t = 16 * w + (e >> 4), v0 = (e & 15) * 8;
        const v4u hh = *(const LAS v4u*)(SS + t * 136 + v0); const v4u mo = *(const GAS v4u*)(PROJ + (row0 + t) * NPROJ + C_MO + h * 128 + v0);
        v4u o;
#define SGM(x) (1.f / (1.f + expf(-(x))))
        o.x = pk2(bflo(hh.x) * SGM(bflo(mo.x)), bfhi(hh.x) * SGM(bfhi(mo.x))); o.y = pk2(bflo(hh.y) * SGM(bflo(mo.y)), bfhi(hh.y) * SGM(bfhi(mo.y)));
        o.z = pk2(bflo(hh.z) * SGM(bflo(mo.z)), bfhi(hh.z) * SGM(bfhi(mo.z))); o.w = pk2(bflo(hh.w) * SGM(bflo(mo.w)), bfhi(hh.w) * SGM(bfhi(mo.w)));
#undef SGM
        *(GAS v4u*)(CAT + (row0 + t) * D + 512 + h * 128 + v0) = o; }
    LDS_WAIT(); __syncthreads();
}

constexpr int N_PHASES = 22;
struct Args { In in; float* out; unsigned char* ws; int ph_lo, ph_hi; };
__global__ void __launch_bounds__(NWAVES * 64, 2) hymba_fwd(Args args) {
    extern __shared__ __attribute__((aligned(16))) unsigned char lds[];
    Frame F;
    F.lds = (LAS unsigned char*)lds;
    F.MISC = (volatile LAS unsigned*)(F.lds + MISC_OFF);
    F.tid = threadIdx.x; F.lane = F.tid & 63; F.wave = __builtin_amdgcn_readfirstlane(F.tid >> 6);
    F.G = gridDim.x; { const int bx = blockIdx.x; F.vcu = (F.G % 8 == 0) ? (bx % 8) * (F.G / 8) + bx / 8 : bx; }
    F.ws = args.ws; unsigned char* ws = args.ws;
    F.ctl = (gu32*)(ws + WS_CTL);
    const In& I = args.in;
    for (int u = F.tid; u < (LDS_BYTES - MISC_OFF) / 4; u += NWAVES * 64) ((LAS unsigned*)(F.lds + MISC_OFF))[u] = 0u;
    __syncthreads();
    const int lo = args.ph_lo, hi = args.ph_hi;
    const bool multi = (hi - lo) > 1;
    XcdBarrier bar; bar.bar = (unsigned*)(F.ctl + CW_BAR); bar.x = 0; bar.st = nullptr;
    if (multi) bar = xcd_barrier_post((unsigned*)(F.ctl + CW_BAR), F.MISC + 8);
#define IN(k) (lo <= (k) && (k) < hi)
#define SEAM(k) do { if (IN(k) && IN((k) + 1)) xcd_barrier(bar); } while (0)
    bf16* XB = (bf16*)(ws + WS_XB); bf16* X1B = (bf16*)(ws + WS_X1B); float* XR = (float*)(ws + WS_XR); bf16* PROJ = (bf16*)(ws + WS_PROJ); bf16* CAT = (bf16*)(ws + WS_CAT);
    float* MIX = (float*)(ws + WS_MIX); float* MIX2 = (float*)(ws + WS_MIX2); bf16* HD = (bf16*)(ws + WS_HD); float* GATES = (float*)(ws + WS_GATES);
    const float* ROPE = (const float*)(ws + WS_ROPE);
    int* LIST = (int*)(ws + WS_LIST); float* LISTW = (float*)(ws + WS_LISTW); int* ROWMAP = (int*)(ws + WS_ROWMAP); float* ROWW = (float*)(ws + WS_ROWW);
    bf16* YB = (bf16*)(ws + WS_Y); bf16* HM = (bf16*)(ws + WS_HM); bf16* XS = (bf16*)(ws + WS_XS);

    if (IN(0)) { p_prologue(F, I); } SEAM(0);
    MlBufs MLB{(bf16*)(ws + WS_QC), (bf16*)(ws + WS_KC), (float*)(ws + WS_DC), (bf16*)(ws + WS_CST), (float*)(ws + WS_DN), (float*)(ws + WS_NST), (float*)(ws + WS_SC), (float*)(ws + WS_MC)};
#ifdef DBG_ML
    bf16* CAT2 = (bf16*)(ws + WS_CAT2);
#define DBG_ML_NAIVE(L) if (F.vcu < 8) mlstm_naive(F, F.vcu, PROJ, GATES, I.conv_w + (L) * 2048, I.conv_b + (L) * 512, I.norm_ml + (L) * 512, CAT2);
#define DBG_ML_CMP() { float ds = 0.f; for (size_t e = (size_t)blockIdx.x * 512 + F.tid; e < (size_t)M * 512; e += (size_t)F.G * 512) { const size_t idx = (e >> 9) * D + 512 + (e & 511); ds += fabsf(bf2f(CAT[idx]) - bf2f(CAT2[idx])); } \
        ds = wave_sum(ds); if (F.lane == 0) __hip_atomic_fetch_add((float*)(F.ctl + CW_DBG), ds, RLX_AGENT); }
#else
#define DBG_ML_NAIVE(L)
#define DBG_ML_CMP()
#endif

#define LAYER_MIXER(L, P)                                                                                                                                   \
    if (IN(P)) {                                                                                                                          \
        pg8::Gemm g{XB, (const bf16*)(ws + WS_WIN) + (size_t)(L) * NPROJ * D, M, NPROJ, D}; pg8::StaticOrder S; S.init(M, NPROJ, F.G, (int)blockIdx.x);     \
        pg8::EpiProj E{PROJ, ROPE, (float*)(F.ctl + CW_KSUM) + (L) * (BATCH * NB * 512), QSCALE};                                                          \
        pg8::gemm_phase<pg8::EpiProj, pg8::StaticOrder, true, true>(F.lds, g, S, E); } SEAM(P);                                                             \
    if (IN((P) + 1)) {                                                                           \
        for (int u = F.vcu; u < 512; u += F.G) ml_phase_a(F, u, PROJ, GATES, I.conv_w + (L) * 2048, I.conv_b + (L) * 512, MLB);                             \
        DBG_ML_NAIVE(L)                                                                                                                                     \
        attn_naive(F, PROJ, (const float*)(F.ctl + CW_KSUM) + (L) * (BATCH * NB * 512), I.norm_attn + (L) * 512, CAT, 0, F.G * NWAVES); } SEAM((P) + 1);   \
    if (IN((P) + 2)) { for (int u = F.vcu; u < 256; u += F.G) ml_phase_b(F, u, MLB); } SEAM((P) + 2);                                                       \
    if (IN((P) + 3)) { for (int u = F.vcu; u < 512; u += F.G) ml_phase_c(F, u, PROJ, GATES, I.norm_ml + (L) * 512, CAT, MLB); } SEAM((P) + 3);            \
    if (IN((P) + 4)) {                                                                                                                   \
        DBG_ML_CMP()                                                                                                                                        \
        pg8::Gemm g{CAT, (const bf16*)(ws + WS_WOUT) + (size_t)(L) * D * D, M, D, D}; pg8::StaticOrder S; S.init(M, D, F.G, (int)blockIdx.x);                \
        pg8::EpiF32 E{MIX, D};                                                                                                                              \
        pg8::gemm_phase<pg8::EpiF32, pg8::StaticOrder, false, true>(F.lds, g, S, E); } SEAM((P) + 4);

    LAYER_MIXER(0, 1)
    if (IN(6)) { ln_phase<0, 0>(F, I.x, MIX, nullptr, nullptr, I.ln1_g, I.ln1_b, args.out, X1B, nullptr, nullptr, nullptr, nullptr, 1.f); } SEAM(6);
    if (IN(7)) {
        pg8::Gemm g{X1B, (const bf16*)(ws + WS_WGU), M, 2 * DFF, D}; pg8::StaticOrder S; S.init(M, 2 * DFF, F.G, (int)blockIdx.x);
        pg8::EpiSwiglu E{HD, DFF, 0};
        pg8::gemm_phase<pg8::EpiSwiglu, pg8::StaticOrder, true, true>(F.lds, g, S, E); } SEAM(7);
    if (IN(8)) {
        pg8::Gemm g{HD, (const bf16*)(ws + WS_WD), M, D, DFF}; pg8::StaticOrder S; S.init(M, D, F.G, (int)blockIdx.x);
        pg8::EpiF32 E{MIX2, D};
        pg8::gemm_phase<pg8::EpiF32, pg8::StaticOrder, false, true>(F.lds, g, S, E); } SEAM(8);
    if (IN(9)) { stage_xw(F, I.w_in + (size_t)D * NIN, NIN, NPROJ);
        ln_phase<0, 1>(F, args.out, MIX2, nullptr, nullptr, I.ln2_g, I.ln2_b, XR, XB, I.gate_bias + 8, GATES, nullptr, nullptr, 1.f); } SEAM(9);
    LAYER_MIXER(1, 10)
    if (IN(15)) { stage_xw(F, I.router_w, 8, 0);
        ln_phase<0, 2>(F, XR, MIX, nullptr, nullptr, I.ln1_g + D, I.ln1_b + D, args.out, X1B, I.router_b, nullptr, LIST, LISTW, 1.f);
        __syncthreads(); moe_cvt(F, I); } SEAM(15);
    int ntiles = 0;
    if (lo <= 20 && hi > 16) ntiles = moe_plan(F);
    if (IN(16)) { moe_gather(F, ntiles, X1B, XS, LIST, LISTW, ROWMAP, ROWW); } SEAM(16);
    const PG8_LAS int* texp = (const PG8_LAS int*)(F.lds + TEXP_OFF);
#define MOE_PASS(P, T0)                                                                                                                                     \
    if (IN(P)) { const int t0 = (T0), t1 = (ntiles < (T0) + CAP) ? ntiles : (T0) + CAP;                                                                     \
        pg8::Gemm g{XS, (const bf16*)(ws + WS_MGU), MAXT * 256, 2 * DEX, D}; pg8::GroupedOrder<false> S; S.init(t0, t1, 2 * DEX / 256, F.G, (int)blockIdx.x, texp); \
        pg8::EpiSwiglu E{HM, DEX, t0};                                                                                                                      \
        pg8::gemm_phase<pg8::EpiSwiglu, pg8::GroupedOrder<false>, true, true>(F.lds, g, S, E); } SEAM(P);                                                   \
    if (IN((P) + 1)) { const int t0 = (T0), t1 = (ntiles < (T0) + CAP) ? ntiles : (T0) + CAP;                                                               \
        pg8::Gemm g{HM, (const bf16*)(ws + WS_MD), CAP * 256, D, DEX}; pg8::GroupedOrder<true> S; S.init(t0, t1, D / 256, F.G, (int)blockIdx.x, texp);        \
        pg8::EpiScatter E{YB, ROWMAP, ROWW, t0, M};                                                                                                         \
        pg8::gemm_phase<pg8::EpiScatter, pg8::GroupedOrder<true>, true, true>(F.lds, g, S, E); } SEAM((P) + 1);
    MOE_PASS(17, 0)
    MOE_PASS(19, CAP)
    if (IN(21)) { float osc = 1.f;
#if defined(DBG_ML)
        osc = 1.f + 10.f * __hip_atomic_load((float*)(F.ctl + CW_DBG), RLX_AGENT) / (2.f * (float)M * 512.f);
#endif
        ln_phase<1, 0>(F, args.out, nullptr, YB, YB + (size_t)M * D, I.ln2_g + D, I.ln2_b + D, args.out, nullptr, nullptr, nullptr, nullptr, nullptr, osc); }
#undef IN
#undef SEAM
}

extern "C" void kernel_launch(void* const* d_in, const int* in_sizes, int n_in, void* d_out, int out_size, void* d_ws, size_t ws_size, hipStream_t stream) {
    static int grid = 0;
    if (grid == 0) {
        if (n_in != 21 || in_sizes[0] != M * D || out_size != M * D || ws_size < WS_END) { fprintf(stderr, "kernel_launch: unexpected shapes (n_in %d, in0 %d, out %d, ws %zu < %zu); nothing launched\n", n_in, n_in > 0 ? in_sizes[0] : -1, out_size, ws_size, (size_t)WS_END); grid = -1; return; }
        int dev = 0, cus = 0, per_cu = 0;
        if (hipGetDevice(&dev) != hipSuccess || hipDeviceGetAttribute(&cus, hipDeviceAttributeMultiprocessorCount, dev) != hipSuccess) { grid = -1; return; }
        if (hipFuncSetAttribute((const void*)hymba_fwd, hipFuncAttributeMaxDynamicSharedMemorySize, LDS_BYTES) != hipSuccess) { fprintf(stderr, "kernel_launch: hipFuncSetAttribute failed\n"); grid = -1; return; }
        if (hipOccupancyMaxActiveBlocksPerMultiprocessor(&per_cu, (const void*)hymba_fwd, NWAVES * 64, LDS_BYTES) != hipSuccess || per_cu < 1) fprintf(stderr, "kernel_launch: occupancy query reports %d\n", per_cu);
        (void)hipGetLastError();
        grid = cus;
    }
    if (grid < 0) return;
    if (hipMemsetAsync((char*)d_ws + WS_CTL, 0, CTL_ZERO_BYTES, stream) != hipSuccess) return;
    Args a{};
    const void** ip = (const void**)&a.in;
    for (int i = 0; i < 21; ++i) ip[i] = d_in[i];
    a.out = (float*)d_out; a.ws = (unsigned char*)d_ws;
#if defined(MK_MULTI)
    for (int p = 0; p < N_PHASES; ++p) { a.ph_lo = p; a.ph_hi = p + 1;
        hipLaunchKernelGGL(hymba_fwd, dim3(grid), dim3(NWAVES * 64), LDS_BYTES, stream, a); }
#else
    a.ph_lo = 0; a.ph_hi = N_PHASES;
    hipLaunchKernelGGL(hymba_fwd, dim3(grid), dim3(NWAVES * 64), LDS_BYTES, stream, a);
#endif
}
```

```cpp
#include <hip/hip_runtime.h>
#include <cstdio>
#include <cstdint>
#include <cmath>
namespace pg8 {
#define PG8_LAS __attribute__((address_space(3)))
typedef unsigned short bf16_t;
typedef short bf16x8 __attribute__((ext_vector_type(8)));
typedef float f32x4 __attribute__((ext_vector_type(4)));
typedef unsigned u32x4 __attribute__((ext_vector_type(4)));
constexpr int BM = 256, BK = 64, HALF = 128, HTB = HALF * BK * 2  , STAGE_BYTES = 8 * HTB, NXCD = 8, WGM = 8;

__host__ __device__ __forceinline__ int lds_byte(int r, int c) { const int st = (r >> 4) * 2 + (c >> 5), rr = r & 15, cc = c & 31, ob = rr * 64 + cc * 2; return st * 1024 + (ob ^ (((ob >> 9) & 1) << 5)); }
__host__ __device__ __forceinline__ void stage_rc(int b, int& R, int& C) { const int st = b / 1024, sb = b % 1024, swz = sb ^ (((sb >> 9) & 1) << 5); R = (st >> 1) * 16 + swz / 64; C = (st & 1) * 32 + (swz % 64) / 2; }
__host__ __device__ __forceinline__ int perm32(int rho) { const int n = rho >> 4, i = rho & 15; return 8 * (i >> 2) + 4 * n + (i & 3); }

struct Unit { int pm, pn, pb; };
struct Gemm { const bf16_t* A; const bf16_t* Bt; int M, N, K; };

struct StaticOrder {
    int nM, nN, nwg, G, c;
    __host__ __device__ void init(int M, int N, int G_, int c_) { nM = M / BM; nN = N / BM; nwg = nM * nN; G = G_; c = c_; }
    __host__ __device__ bool next(int i, Unit& u) const {
        const long L = (long)i * G + c; if (L >= nwg) return false;
        int wgid = (int)L; { const int q = nwg / NXCD, r = nwg % NXCD, xcd = wgid % NXCD, off = wgid / NXCD; wgid = (xcd < r ? xcd * (q + 1) : r * (q + 1) + (xcd - r) * q) + off; }
        const int nig = WGM * nN, gid = wgid / nig, fm = gid * WGM, gsz = (nM - fm) < WGM ? (nM - fm) : WGM;
        u.pm = fm + ((wgid % nig) % gsz); u.pn = (wgid % nig) / gsz; u.pb = u.pn; return true;
    }
    __device__ __forceinline__ void a_ready(const Unit&) const {}
    __device__ __forceinline__ void done(const Unit&) const {}
};


__device__ __forceinline__ unsigned cvt_pk_bf16(float lo, float hi) { unsigned r; asm volatile("v_cvt_pk_bf16_f32 %0, %1, %2" : "=v"(r) : "v"(lo), "v"(hi)); return r; }
__device__ __forceinline__ u32x4 pack8(const f32x4 v0, const f32x4 v1) { u32x4 w; w.x = cvt_pk_bf16(v0[0], v0[1]); w.y = cvt_pk_bf16(v0[2], v0[3]); w.z = cvt_pk_bf16(v1[0], v1[1]); w.w = cvt_pk_bf16(v1[2], v1[3]); return w; }
__device__ __forceinline__ f32x4 shx16(const f32x4 v) { f32x4 r; r[0] = __shfl_xor(v[0], 16); r[1] = __shfl_xor(v[1], 16); r[2] = __shfl_xor(v[2], 16); r[3] = __shfl_xor(v[3], 16); return r; }

struct EpiF32 {
    static constexpr bool PERM = false, AFTER_DRAIN = false;
    float* C; int ldc;
    __device__ __forceinline__ void operator()(const f32x4 (&acc)[2][2][4][2], const Unit& u, int wr, int wc, int fr, int fq) const {
        const int row0 = u.pm * BM + wr * 64 + fr, col0 = u.pn * BM + wc * 32 + 4 * fq;
#pragma unroll
        for (int ai = 0; ai < 2; ++ai)
#pragma unroll
            for (int m = 0; m < 4; ++m) { float* rowp = C + (size_t)(row0 + ai * HALF + m * 16) * ldc + col0;
#pragma unroll
                for (int bj = 0; bj < 2; ++bj)
#pragma unroll
                    for (int n = 0; n < 2; ++n) *(f32x4*)(rowp + bj * HALF + n * 16) = acc[ai][bj][m][n]; }
    }
};

struct EpiProj {
    static constexpr bool PERM = true, AFTER_DRAIN = false;
    bf16_t* O; const float* rope; float* ksum; float qscale;
    __device__ __forceinline__ void operator()(const f32x4 (&acc)[2][2][4][2], const Unit& u, int wr, int wc, int fr, int fq) const {
        const int row0 = u.pm * BM + wr * 64 + fr; const int colt = u.pn * BM; const int col0 = colt + wc * 32 + 8 * fq;
        const bool is_qk = u.pn < 4, is_q = u.pn < 2, rot = is_qk && ((wc & 1) == 0);
        float ks[2][8];
#pragma unroll
        for (int bj = 0; bj < 2; ++bj)
#pragma unroll
            for (int i = 0; i < 8; ++i) ks[bj][i] = 0.f;
#pragma unroll
        for (int ai = 0; ai < 2; ++ai)
#pragma unroll
            for (int m = 0; m < 4; ++m) { const int row = row0 + ai * HALF + m * 16; bf16_t* rowp = O + (size_t)row * 3072 + col0;
                f32x4 c0 = {1.f, 1.f, 1.f, 1.f}, c1 = c0, s0 = {0.f, 0.f, 0.f, 0.f}, s1 = s0;
                if (rot && fq < 2) { const f32x4* rp = (const f32x4*)(rope + (size_t)row * 16); c0 = rp[0]; c1 = rp[1]; s0 = rp[2]; s1 = rp[3]; if (fq == 0) { s0 = -s0; s1 = -s1; } }
#pragma unroll
                for (int bj = 0; bj < 2; ++bj) { f32x4 v0 = acc[ai][bj][m][0], v1 = acc[ai][bj][m][1];
                    if (rot) { const f32x4 p0 = shx16(v0), p1 = shx16(v1); v0 = v0 * c0 + p0 * s0; v1 = v1 * c1 + p1 * s1; }
                    if (is_q) { v0 = v0 * qscale; v1 = v1 * qscale; }
                    else if (is_qk) {
#pragma unroll
                        for (int i = 0; i < 4; ++i) { ks[bj][i] += v0[i]; ks[bj][4 + i] += v1[i]; } }
                    *(u32x4*)(rowp + bj * HALF) = pack8(v0, v1); } }
        if (is_qk && !is_q) {
            float* kd = ksum + (size_t)u.pm * 512 + (colt - 512) + wc * 32 + 8 * fq;
#pragma unroll
            for (int bj = 0; bj < 2; ++bj)
#pragma unroll
                for (int i = 0; i < 8; ++i) { float s = ks[bj][i]; s += __shfl_xor(s, 1); s += __shfl_xor(s, 2); s += __shfl_xor(s, 4); s += __shfl_xor(s, 8);
                    if (fr == 0) __hip_atomic_fetch_add(kd + bj * HALF + i, s, __ATOMIC_RELAXED, __HIP_MEMORY_SCOPE_AGENT); }
        }
    }
};

__device__ __forceinline__ float silu_f(float x) { return x * __builtin_amdgcn_rcpf(1.0f + __builtin_amdgcn_exp2f(-1.4426950408889634f * x)); }
struct EpiSwiglu {
    static constexpr bool PERM = true, AFTER_DRAIN = false;
    bf16_t* H; int ldh; int pm_off;
    __device__ __forceinline__ void operator()(const f32x4 (&acc)[2][2][4][2], const Unit& u, int wr, int wc, int fr, int fq) const {
        const int row0 = (u.pm - pm_off) * BM + wr * 64 + fr; const int col0 = u.pn * HALF + wc * 32 + 8 * fq;
#pragma unroll
        for (int ai = 0; ai < 2; ++ai)
#pragma unroll
            for (int m = 0; m < 4; ++m) { bf16_t* rowp = H + (size_t)(row0 + ai * HALF + m * 16) * ldh + col0;
                const f32x4 g0 = acc[ai][0][m][0], g1 = acc[ai][0][m][1], u0 = acc[ai][1][m][0], u1 = acc[ai][1][m][1]; f32x4 h0, h1;
#pragma unroll
                for (int i = 0; i < 4; ++i) { h0[i] = silu_f(g0[i]) * u0[i]; h1[i] = silu_f(g1[i]) * u1[i]; }
                *(u32x4*)rowp = pack8(h0, h1); }
    }
};
struct EpiScatter {
    static constexpr bool PERM = true, AFTER_DRAIN = false;
    bf16_t* Y; const int* rowmap; const float* roww; int pm_off; int mtok;
    __device__ __forceinline__ void operator()(const f32x4 (&acc)[2][2][4][2], const Unit& u, int wr, int wc, int fr, int fq) const {
        const int row0 = (u.pm + pm_off) * BM + wr * 64 + fr; const int col0 = u.pn * BM + wc * 32 + 8 * fq;
#pragma unroll
        for (int ai = 0; ai < 2; ++ai)
#pragma unroll
            for (int m = 0; m < 4; ++m) { const int r = row0 + ai * HALF + m * 16; const int ts = rowmap[r];
                if (ts >= 0) { const float w = roww[r]; bf16_t* rowp = Y + ((size_t)(ts & 1) * mtok + (ts >> 1)) * 1024 + col0;
#pragma unroll
                    for (int bj = 0; bj < 2; ++bj) *(u32x4*)(rowp + bj * HALF) = pack8(acc[ai][bj][m][0] * w, acc[ai][bj][m][1] * w); } }
    }
};
template <bool REL> struct GroupedOrder {
    int t0, nM, nN, nwg, G, c; const PG8_LAS int* texp;
    __device__ __forceinline__ void init(int t0_, int t1_, int nN_, int G_, int c_, const PG8_LAS int* texp_) { t0 = t0_; nM = t1_ - t0_; if (nM < 0) nM = 0; nN = nN_; nwg = nM * nN; G = G_; c = c_; texp = texp_; }
    __device__ __forceinline__ bool next(int i, Unit& u) const {
        const long L = (long)i * G + c; if (L >= nwg) return false;
        int wgid = (int)L; { const int q = nwg / NXCD, r = nwg % NXCD, xcd = wgid % NXCD, off = wgid / NXCD; wgid = (xcd < r ? xcd * (q + 1) : r * (q + 1) + (xcd - r) * q) + off; }
        const int nig = WGM * nN, gid = wgid / nig, fm = gid * WGM, gsz = (nM - fm) < WGM ? (nM - fm) : WGM;
        const int pmr = fm + ((wgid % nig) % gsz); u.pn = (wgid % nig) / gsz; u.pm = REL ? pmr : (t0 + pmr); u.pb = texp[t0 + pmr] * nN + u.pn; return true;
    }
    __device__ __forceinline__ void a_ready(const Unit&) const {}
    __device__ __forceinline__ void done(const Unit&) const {}
};
template <class Epi, class Sched, bool ALIGN_EPI = false, bool SP2 = false>
__device__ __forceinline__ void gemm_phase(PG8_LAS unsigned char* lds, const Gemm g, const Sched& S, const Epi& E) {
    const int tid = threadIdx.x, wid = __builtin_amdgcn_readfirstlane(tid >> 6), lane = tid & 63, wr = wid >> 2, wc = wid & 3, fr = lane & 15, fq = lane >> 4;
    const int K = g.K, nt = K / BK;
    unsigned voffA[2], voffB[2];
#pragma unroll
    for (int i = 0; i < 2; ++i) { int R, C; stage_rc(tid * 16 + i * 8192, R, C); const int Rb = Epi::PERM ? ((R & ~31) + perm32(R & 31)) : R;
        voffA[i] = (unsigned)(R * K + C) * 2u; voffB[i] = (unsigned)(Rb * K + C) * 2u; }
    const size_t kstep = (size_t)(BK * 2);
    const size_t hstep = (size_t)HALF * K * 2;
    const size_t tstep = 2 * hstep;
    const unsigned ldsw = (unsigned)wid * 1024u;
    const int aoff = lds_byte(wr * 64 + fr, fq * 8), boff = lds_byte(wc * 32 + fr, fq * 8);
#define PG8_SA(b, h) (((b) * 2 + (h)) * HTB)
#define PG8_SB(b, h) ((4 + (b) * 2 + (h)) * HTB)
#define PG8_STAGE(bufoff, gbase, voff) do { _Pragma("unroll") for (int _i = 0; _i < 2; ++_i) \
        __builtin_amdgcn_global_load_lds((const unsigned*)((const char*)(gbase) + (voff)[_i]), (PG8_LAS unsigned*)(lds + (bufoff) + ldsw + _i * 8192), 16, 0, 0); } while (0)
#define PG8_LDA(dst, b, h) do { _Pragma("unroll") for (int m = 0; m < 4; ++m) _Pragma("unroll") for (int k = 0; k < 2; ++k) dst[m][k] = *(const PG8_LAS bf16x8*)(lds + PG8_SA(b, h) + aoff + m * 2048 + k * 1024); } while (0)
#define PG8_LDB(dst, b, h) do { _Pragma("unroll") for (int n = 0; n < 2; ++n) _Pragma("unroll") for (int k = 0; k < 2; ++k) dst[n][k] = *(const PG8_LAS bf16x8*)(lds + PG8_SB(b, h) + boff + n * 2048 + k * 1024); } while (0)
#define PG8_MMA(ai, bj, At, Bt) do { __builtin_amdgcn_s_setprio(1); _Pragma("unroll") for (int m = 0; m < 4; ++m) _Pragma("unroll") for (int n = 0; n < 2; ++n) _Pragma("unroll") for (int k = 0; k < 2; ++k) \
        acc[ai][bj][m][n] = __builtin_amdgcn_mfma_f32_16x16x32_bf16(Bt[n][k], At[m][k], acc[ai][bj][m][n], 0, 0, 0); __builtin_amdgcn_s_setprio(0); } while (0)
#define PG8_WAIT_V(n) asm volatile("s_waitcnt vmcnt(" #n ")" ::: "memory")
#define PG8_WAIT_L(n) asm volatile("s_waitcnt lgkmcnt(" #n ")" ::: "memory")
#define PG8_BAR __builtin_amdgcn_s_barrier()
#define PG8_SCHED __builtin_amdgcn_sched_barrier(0)
    Unit cur, nxt; int ui = 0;
    if (!S.next(0, cur)) return;
    f32x4 acc[2][2][4][2];
#pragma unroll
    for (int a = 0; a < 2; ++a)
#pragma unroll
        for (int b = 0; b < 2; ++b)
#pragma unroll
            for (int m = 0; m < 4; ++m)
#pragma unroll
                for (int n = 0; n < 2; ++n) acc[a][b][m][n] = (f32x4){0.f, 0.f, 0.f, 0.f};
    bf16x8 At[4][2], B0[2][2], B1[2][2];
    const char* cA = (const char*)g.A + (size_t)cur.pm * tstep; const char* cB = (const char*)g.Bt + (size_t)cur.pb * tstep;
    S.a_ready(cur);
    if constexpr (SP2) {
        PG8_STAGE(PG8_SB(0, 0), cB, voffB); PG8_STAGE(PG8_SB(0, 1), cB + hstep, voffB); PG8_STAGE(PG8_SA(0, 0), cA, voffA); PG8_STAGE(PG8_SA(0, 1), cA + hstep, voffA);
        if (wr == 1) PG8_BAR;
        PG8_WAIT_V(2); PG8_BAR;
        PG8_STAGE(PG8_SB(1, 0), cB + kstep, voffB); PG8_STAGE(PG8_SA(1, 0), cA + kstep, voffA); PG8_STAGE(PG8_SB(1, 1), cB + hstep + kstep, voffB);
        PG8_WAIT_V(6); PG8_BAR;
    } else {
        PG8_STAGE(PG8_SB(0, 0), cB, voffB); PG8_STAGE(PG8_SA(0, 0), cA, voffA); PG8_STAGE(PG8_SB(0, 1), cB + hstep, voffB); PG8_STAGE(PG8_SA(0, 1), cA + hstep, voffA);
        if (wr == 1) PG8_BAR;
        PG8_WAIT_V(4); PG8_BAR;
        PG8_STAGE(PG8_SB(1, 0), cB + kstep, voffB); PG8_STAGE(PG8_SA(1, 0), cA + kstep, voffA); PG8_STAGE(PG8_SB(1, 1), cB + hstep + kstep, voffB);
        PG8_WAIT_V(6); PG8_BAR;
    }
    for (;;) {
        const bool has_next = S.next(ui + 1, nxt);
        const char* nA = has_next ? (const char*)g.A + (size_t)nxt.pm * tstep : cA; const char* nB = has_next ? (const char*)g.Bt + (size_t)nxt.pb * tstep : cB;
        for (int t = 0; t < nt; t += 2) {
            const bool last = (t == nt - 2);
            const char* a1 = cA + (size_t)(t + 1) * kstep;
            const char* a2 = last ? nA : cA + (size_t)(t + 2) * kstep; const char* b2 = last ? nB : cB + (size_t)(t + 2) * kstep;
            const char* a3 = a2 + kstep; const char* b3 = b2 + kstep;
            if (last && has_next) S.a_ready(nxt);
            if constexpr (SP2) {
            PG8_LDB(B0, 0, 0); PG8_LDB(B1, 0, 1); PG8_SCHED; PG8_LDA(At, 0, 0); PG8_STAGE(PG8_SA(1, 1), a1 + hstep, voffA);
            PG8_WAIT_V(8); PG8_WAIT_L(0); PG8_BAR; PG8_MMA(0, 0, At, B0); PG8_MMA(0, 1, At, B1); PG8_BAR; PG8_SCHED;
            PG8_LDA(At, 0, 1); PG8_STAGE(PG8_SB(0, 0), b2, voffB); PG8_STAGE(PG8_SB(0, 1), b2 + hstep, voffB); PG8_STAGE(PG8_SA(0, 0), a2, voffA);
            PG8_WAIT_V(8); PG8_WAIT_L(0); PG8_BAR; PG8_MMA(1, 0, At, B0); PG8_MMA(1, 1, At, B1); PG8_BAR; PG8_SCHED;
            PG8_LDB(B0, 1, 0); PG8_LDB(B1, 1, 1); PG8_SCHED; PG8_LDA(At, 1, 0); PG8_STAGE(PG8_SA(0, 1), a2 + hstep, voffA);
            PG8_WAIT_V(8); PG8_WAIT_L(0); PG8_BAR; PG8_MMA(0, 0, At, B0); PG8_MMA(0, 1, At, B1); PG8_BAR; PG8_SCHED;
            PG8_LDA(At, 1, 1); PG8_STAGE(PG8_SB(1, 0), b3, voffB); PG8_STAGE(PG8_SB(1, 1), b3 + hstep, voffB); PG8_STAGE(PG8_SA(1, 0), a3, voffA);
            PG8_WAIT_V(8); PG8_WAIT_L(0); PG8_BAR; PG8_MMA(1, 0, At, B0); PG8_MMA(1, 1, At, B1); PG8_BAR; PG8_SCHED;
            } else {
            PG8_LDB(B0, 0, 0); PG8_SCHED; PG8_LDA(At, 0, 0); PG8_STAGE(PG8_SA(1, 1), a1 + hstep, voffA);
            PG8_WAIT_L(8); PG8_BAR; PG8_WAIT_L(0); PG8_MMA(0, 0, At, B0); PG8_BAR; PG8_SCHED;
            PG8_LDB(B1, 0, 1); PG8_STAGE(PG8_SB(0, 0), b2, voffB);
            PG8_BAR; PG8_WAIT_L(0); PG8_MMA(0, 1, At, B1); PG8_BAR;
            PG8_LDA(At, 0, 1); PG8_STAGE(PG8_SA(0, 0), a2, voffA);
            PG8_BAR; PG8_WAIT_L(0); PG8_MMA(1, 0, At, B0); PG8_BAR; PG8_SCHED;
            PG8_STAGE(PG8_SB(0, 1), b2 + hstep, voffB);
            PG8_WAIT_V(6); PG8_BAR; PG8_MMA(1, 1, At, B1); PG8_BAR;
            PG8_LDB(B0, 1, 0); PG8_SCHED; PG8_LDA(At, 1, 0); PG8_STAGE(PG8_SA(0, 1), a2 + hstep, voffA);
            PG8_WAIT_L(8); PG8_BAR; PG8_WAIT_L(0); PG8_MMA(0, 0, At, B0); PG8_BAR; PG8_SCHED;
            PG8_LDB(B1, 1, 1); PG8_STAGE(PG8_SB(1, 0), b3, voffB);
            PG8_BAR; PG8_WAIT_L(0); PG8_MMA(0, 1, At, B1); PG8_BAR;
            PG8_LDA(At, 1, 1); PG8_STAGE(PG8_SA(1, 0), a3, voffA);
            PG8_BAR; PG8_WAIT_L(0); PG8_MMA(1, 0, At, B0); PG8_BAR; PG8_SCHED;
            PG8_STAGE(PG8_SB(1, 1), b3 + hstep, voffB);
            PG8_WAIT_V(6); PG8_BAR; PG8_MMA(1, 1, At, B1); PG8_BAR;
            }
        }
        if constexpr (ALIGN_EPI) { if (wr == 0) PG8_BAR; }
        if constexpr (!Epi::AFTER_DRAIN) { E(acc, cur, wr, wc, fr, fq); S.done(cur); }
        if (!has_next) break;
#pragma unroll
        for (int a = 0; a < 2; ++a)
#pragma unroll
            for (int b = 0; b < 2; ++b)
#pragma unroll
                for (int m = 0; m < 4; ++m)
#pragma unroll
                    for (int n = 0; n < 2; ++n) acc[a][b][m][n] = (f32x4){0.f, 0.f, 0.f, 0.f};
        cur = nxt; cA = nA; cB = nB; ++ui;
        if constexpr (ALIGN_EPI) { if (wr == 1) PG8_BAR; }
    }
    PG8_WAIT_V(0);
    if constexpr (!ALIGN_EPI) { if (wr == 0) PG8_BAR; }
    PG8_BAR;
    if constexpr (Epi::AFTER_DRAIN) { E.fused(acc, cur, wr, wc, fr, fq, lds, wid, lane); S.done(cur); }
#undef PG8_SA
#undef PG8_SB
#undef PG8_STAGE
#undef PG8_LDA
#undef PG8_LDB
#undef PG8_MMA
#undef PG8_WAIT_V
#undef PG8_WAIT_L
#undef PG8_BAR
#undef PG8_SCHED
}
}

constexpr int NWAVES = 8;
constexpr int BATCH = 2, SEQ = 8192, D = 1024, M = BATCH * SEQ;
constexpr int NPROJ = 3072, NIN = 3080;
constexpr int AH = 8, NB = 32;
constexpr int C_AQ = 0, C_AK = 512, C_AV = 1024, C_MQ = 1536, C_MK = 1792, C_MV = 2048, C_MO = 2560;
constexpr int MH = 4, MLC = 128, NCH = SEQ / MLC;
constexpr int DFF = 2816, NE = 8, DEX = 3584;
constexpr int MAXT = 136;
constexpr int CAP = 70;
constexpr float LN_EPS = 1e-5f, RMS_EPS = 1e-6f;
constexpr float ALPHA = 1.41421356237309515f;
constexpr float QSCALE = 0.125f * 1.4426950408889634f;

constexpr size_t MiB = 1u << 20;
constexpr size_t WS_CTL = 0, CTL_ZERO_BYTES = 1 * MiB;
constexpr size_t WS_ROPE = 1 * MiB;
constexpr size_t WS_GATES = 2 * MiB;
constexpr size_t WS_ROWMAP = 2 * MiB + 512 * 1024, WS_ROWW = 2 * MiB + 768 * 1024;
constexpr size_t WS_LIST = 3 * MiB, WS_LISTW = 3 * MiB + 512 * 1024;
constexpr size_t WS_WIN = 4 * MiB, WS_WOUT = 16 * MiB, WS_WGU = 20 * MiB, WS_WD = 31 * MiB;
constexpr size_t WS_MGU = 37 * MiB, WS_MD = 149 * MiB;
constexpr size_t WS_MIX2 = 37 * MiB;
constexpr size_t WS_QC = 37 * MiB, WS_KC = 45 * MiB, WS_DC = 53 * MiB, WS_CST = 69 * MiB, WS_DN = 77 * MiB, WS_NST = 77 * MiB + 256 * 1024, WS_SC = 77 * MiB + 512 * 1024, WS_MC = 77 * MiB + 768 * 1024;
constexpr size_t WS_PO = 80 * MiB, WS_PML = 128 * MiB, WS_SEL = 131 * MiB, WS_LISTQ = 132 * MiB;
constexpr size_t WS_CAT2 = 141 * MiB;
constexpr size_t WS_XB = 205 * MiB, WS_X1B = 237 * MiB, WS_XR = 269 * MiB, WS_PROJ = 333 * MiB, WS_CAT = 429 * MiB;
constexpr size_t WS_MIX = 333 * MiB;
constexpr size_t WS_HD = 333 * MiB;
constexpr size_t WS_Y = 205 * MiB, WS_HM = 269 * MiB, WS_XS = 393 * MiB, WS_END = 461 * MiB;
static_assert(WS_HM + (size_t)CAP * 256 * DEX * 2 <= WS_XS && WS_XS + (size_t)MAXT * 256 * D * 2 <= WS_END, "MoE map");
static_assert(WS_HD + (size_t)M * DFF * 2 <= WS_CAT && WS_WD + (size_t)D * DFF * 2 <= WS_MGU && WS_WGU + (size_t)2 * DFF * D * 2 <= WS_WD, "map");
constexpr int CW_TMO = 0, CW_CODE = 1;
constexpr int CW_BAR = 4096;
constexpr int CW_ECNT = 16384;
constexpr int CW_DBG = 2048;
constexpr int CW_BCNT = 32768;
constexpr int CW_KSUM = 65536;

constexpr int LDS_BYTES = 147456;
constexpr int MISC_OFF = LDS_BYTES - 1024;
constexpr int TEXP_OFF = MISC_OFF + 256;
constexpr int XW_OFF = 100 * 1024;

#define GAS __attribute__((address_space(1)))
#define LAS __attribute__((address_space(3)))
typedef unsigned short bf16;
typedef unsigned v4u __attribute__((ext_vector_type(4)));
typedef unsigned v2u __attribute__((ext_vector_type(2)));
typedef float f32x4 __attribute__((ext_vector_type(4)));
typedef GAS unsigned gu32;
#define RLX_AGENT __ATOMIC_RELAXED, __HIP_MEMORY_SCOPE_AGENT
#define LDS_WAIT() asm volatile("s_waitcnt lgkmcnt(0)" ::: "memory")
#define VM_WAIT() asm volatile("s_waitcnt vmcnt(0)" ::: "memory")
__device__ __forceinline__ unsigned f2bf(float f) { unsigned u = __builtin_bit_cast(unsigned, f); return (u + 0x7fffu + ((u >> 16) & 1u)) >> 16; }
__device__ __forceinline__ unsigned pk2(float lo, float hi) { return f2bf(lo) | (f2bf(hi) << 16); }
__device__ __forceinline__ float bf2f(unsigned short h) { return __builtin_bit_cast(float, (unsigned)h << 16); }
__device__ __forceinline__ float bflo(unsigned w) { return __builtin_bit_cast(float, w << 16); }
__device__ __forceinline__ float bfhi(unsigned w) { return __builtin_bit_cast(float, w & 0xffff0000u); }
#define XB_TMO      128
#define XB_XCNT(j)  (256  + 64 * (j))
#define XB_XSUB(j)  (1280 + 64 * (j))
#define XB_XGEN(j)  (2304 + 64 * (j))
#define XB_TOP      3328
#define XB_TOPGEN   3392
#define XCD_BAR_WORDS 3456
#define XB_SPIN_CAP (1u << 18)

__device__ __forceinline__ unsigned xb_ld(unsigned* p)              { return __hip_atomic_load(p, __ATOMIC_RELAXED, __HIP_MEMORY_SCOPE_AGENT); }
__device__ __forceinline__ unsigned xb_add(unsigned* p, unsigned v) { return __hip_atomic_fetch_add(p, v, __ATOMIC_RELAXED, __HIP_MEMORY_SCOPE_AGENT); }
__device__ __forceinline__ unsigned xb_xcc_id() { return (unsigned)__builtin_amdgcn_s_getreg((3 << 11) | 20) & 0xFu; }
#define XB_SPIN(cond, bar) do { unsigned _sp = 0; while (cond) { __builtin_amdgcn_s_sleep(1); \
    if ((++_sp & 255u) == 0u) { if (xb_ld(&(bar)[XB_TMO])) break; if (_sp > XB_SPIN_CAP) { atomicAdd(&(bar)[XB_TMO], 1u); break; } } } } while (0)

struct XcdBarrier {
    unsigned* bar; unsigned x;
    volatile LAS unsigned* st;
};

__device__ __forceinline__ XcdBarrier xcd_barrier_post(unsigned* bar, volatile LAS unsigned* st) {
    XcdBarrier b; b.bar = bar; b.x = xb_xcc_id(); b.st = st;
    if (threadIdx.x == 0) (void)xb_add(&bar[XB_XCNT(b.x)], 1u);
    return b;
}
__device__ __forceinline__ void xcd_barrier_complete(unsigned* bar, unsigned x, unsigned& nloc, unsigned& nx) {
    const unsigned G = gridDim.x * gridDim.y * gridDim.z;
    unsigned sum, cnt, mine, sp = 0u;
    for (;;) {
        sum = 0u; cnt = 0u; mine = 0u;
#pragma unroll
        for (unsigned j = 0; j < 16; ++j) { const unsigned c = xb_ld(&bar[XB_XCNT(j)]); sum += c; cnt += (c > 0u) ? 1u : 0u; mine = (j == x) ? c : mine; }
        if (sum == G) break;
        __builtin_amdgcn_s_sleep(1);
        if ((++sp & 255u) == 0u) { if (xb_ld(&bar[XB_TMO])) break; if (sp > XB_SPIN_CAP) { atomicAdd(&bar[XB_TMO], 1u); break; } }
    }
    nloc = mine > 0u ? mine : 1u; nx = cnt > 0u ? cnt : 1u;
}

__device__ __forceinline__ void xcd_barrier(const XcdBarrier& b) {
    asm volatile("s_waitcnt vmcnt(0)" ::: "memory");
    __syncthreads();
    if (threadIdx.x == 0) {
        unsigned* bar = b.bar;
        __builtin_amdgcn_s_waitcnt(0);
        unsigned nloc = b.st[0], nx = b.st[1];
        if (nloc == 0u) { xcd_barrier_complete(bar, b.x, nloc, nx); b.st[0] = nloc; b.st[1] = nx; }
        const unsigned old = xb_add(&bar[XB_XSUB(b.x)], 1u);
        const unsigned gen = old / nloc;
        if (old + 1u == (gen + 1u) * nloc) {
            __builtin_amdgcn_fence(__ATOMIC_RELEASE, "agent");
            asm volatile("s_waitcnt vmcnt(0)" ::: "memory");
            const unsigned og = xb_add(&bar[XB_TOP], 1u);
            const unsigned tg = og / nx;
            if (og + 1u == (tg + 1u) * nx) xb_add(&bar[XB_TOPGEN], 1u);
            else XB_SPIN(xb_ld(&bar[XB_TOPGEN]) == tg, bar);
            __builtin_amdgcn_fence(__ATOMIC_ACQUIRE, "agent");
            xb_add(&bar[XB_XGEN(b.x)], 1u);
            asm volatile("s_waitcnt vmcnt(0)" ::: "memory");
        } else {
            XB_SPIN(xb_ld(&bar[XB_XGEN(b.x)]) == gen, bar);
            __builtin_amdgcn_fence(__ATOMIC_ACQUIRE, "agent");
            asm volatile("s_waitcnt vmcnt(0)" ::: "memory");
        }
    }
    __syncthreads();
}

struct Frame {
    LAS unsigned char* lds;
    volatile LAS unsigned* MISC;
    gu32* ctl;
    int tid, lane, wave;
    int vcu, G;
    unsigned char* ws;
};
__device__ __forceinline__ float wave_sum(float v) {
#pragma unroll
    for (int o = 1; o < 64; o <<= 1) v += __shfl_xor(v, o);
    return v;
}
__device__ __forceinline__ float wave_max(float v) {
#pragma unroll
    for (int o = 1; o < 64; o <<= 1) v = fmaxf(v, __shfl_xor(v, o));
    return v;
}
__device__ __forceinline__ void transpose_item(const float* W, int ldw, int k0, int n0, bf16* WT, int K, int drow0, LAS float* scr, int lane) {
#pragma unroll 8
    for (int i = 0; i < 32; ++i) { const int kk = 2 * i + (lane >> 5); scr[kk * 33 + (lane & 31)] = W[(size_t)(k0 + kk) * ldw + n0 + (lane & 31)]; }
    LDS_WAIT(); asm volatile("" ::: "memory");
    const int c = lane & 7;
#pragma unroll
    for (int j = 0; j < 4; ++j) { const int n = (lane >> 3) + 8 * j; const LAS float* s = scr + (8 * c) * 33 + n;
        v4u o; o.x = pk2(s[0 * 33], s[1 * 33]); o.y = pk2(s[2 * 33], s[3 * 33]); o.z = pk2(s[4 * 33], s[5 * 33]); o.w = pk2(s[6 * 33], s[7 * 33]);
        *(GAS v4u*)(WT + (size_t)(drow0 + n) * K + k0 + 8 * c) = o; }
    LDS_WAIT(); asm volatile("" ::: "memory");
}
__device__ __forceinline__ void cvt_plain(const float* W, int ldw, int coff, int K, int N, bf16* WT, LAS float* scr, int it, int lane) {
    const int nblk = N / 32, kb = it / nblk, nb = it % nblk; transpose_item(W, ldw, 64 * kb, coff + 32 * nb, WT, K, 32 * nb, scr, lane);
}
__device__ __forceinline__ void cvt_gu(const float* Wg, const float* Wu, int K, int N, bf16* WT, LAS float* scr, int it, int lane) {
    const int nblk = N / 32, per = (K / 64) * nblk; const int isu = it >= per; if (isu) it -= per; const int kb = it / nblk, nb = it % nblk, n0 = 32 * nb;
    transpose_item(isu ? Wu : Wg, N, 64 * kb, n0, WT, K, (n0 / 128) * 256 + (n0 % 128) + (isu ? 128 : 0), scr, lane);
}
__device__ __forceinline__ void stage_xw(Frame& F, const float* W, int ldw, int coff) {
    LAS float* xw = (LAS float*)(F.lds + XW_OFF);
    for (int idx = F.tid; idx < 8192; idx += NWAVES * 64) { const int k = idx >> 3, g = idx & 7; xw[g * 1024 + k] = W[(size_t)k * ldw + coff + g]; }
    LDS_WAIT(); __syncthreads();
}
__device__ __forceinline__ void row_dot8(Frame& F, const f32x4 (&v)[4], float (&acc)[8]) {
    const LAS f32x4* xw = (const LAS f32x4*)(F.lds + XW_OFF);
#pragma unroll
    for (int g = 0; g < 8; ++g) { float a = 0.f;
#pragma unroll
        for (int j = 0; j < 4; ++j) { const f32x4 w = xw[g * 256 + j * 64 + F.lane]; a += v[j][0] * w[0] + v[j][1] * w[1] + v[j][2] * w[2] + v[j][3] * w[3]; }
        acc[g] = wave_sum(a); }
}
__device__ __forceinline__ float log_sigmoid(float x) { return fminf(x, 0.f) - log1pf(expf(-fabsf(x))); }
__device__ __forceinline__ void store_row_bf16(bf16* orow, const f32x4 (&y)[4], int lane) {
    GAS unsigned long long* o8 = (GAS unsigned long long*)orow + lane;
#pragma unroll
    for (int j = 0; j < 4; ++j) o8[64 * j] = (unsigned long long)pk2(y[j][0], y[j][1]) | ((unsigned long long)pk2(y[j][2], y[j][3]) << 32);
}
__device__ __forceinline__ void write_gates(Frame& F, const f32x4 (&y)[4], const float* gbias, float* grow) {
    float a[8]; row_dot8(F, y, a);
    if (F.lane < 8) { float r = 0.f;
#pragma unroll
        for (int g = 0; g < 8; ++g) if (F.lane == g) r = a[g];
        r += gbias[F.lane]; if (F.lane >= 4) r = log_sigmoid(r); grow[F.lane] = r; }
}
struct In {
    const float* x; const int* pos; const float *w_in, *gate_bias, *conv_w, *conv_b, *norm_attn, *norm_ml, *w_out, *ln1_g, *ln1_b, *dg, *du, *dd, *router_w, *router_b, *mg, *mu, *md, *ln2_g, *ln2_b;
};
__device__ __forceinline__ void p_prologue(Frame& F, const In& I) {
    unsigned char* ws = F.ws;
    stage_xw(F, I.w_in, NIN, NPROJ);
    LAS float* scr = (LAS float*)(F.lds + F.wave * 8704);
    const int gw = F.vcu * NWAVES + F.wave, NGW = F.G * NWAVES;
    constexpr int I_IN = (D / 64) * (NPROJ / 32), I_OUT = (D / 64) * (D / 32), I_GU = 2 * (D / 64) * (DFF / 32), I_DD = (DFF / 64) * (D / 32);
    constexpr int NITEMS = 2 * I_IN + 2 * I_OUT + I_GU + I_DD;
    for (int it = gw; it < NITEMS; it += NGW) {
        int r = it;
        if (r < 2 * I_IN) { const int l = r / I_IN; r -= l * I_IN; cvt_plain(I.w_in + (size_t)l * D * NIN, NIN, 0, D, NPROJ, (bf16*)(ws + WS_WIN) + (size_t)l * NPROJ * D, scr, r, F.lane); continue; } r -= 2 * I_IN;
        if (r < 2 * I_OUT) { const int l = r / I_OUT; r -= l * I_OUT; cvt_plain(I.w_out + (size_t)l * D * D, D, 0, D, D, (bf16*)(ws + WS_WOUT) + (size_t)l * D * D, scr, r, F.lane); continue; } r -= 2 * I_OUT;
        if (r < I_GU) { cvt_gu(I.dg, I.du, D, DFF, (bf16*)(ws + WS_WGU), scr, r, F.lane); continue; } r -= I_GU;
        cvt_plain(I.dd, D, 0, DFF, D, (bf16*)(ws + WS_WD), scr, r, F.lane);
    }
    for (int e = blockIdx.x * (NWAVES * 64) + F.tid; e < M * 8; e += F.G * NWAVES * 64) { const int row = e >> 3, i = e & 7;
        const float inv = powf(500000.0f, -(float)i / 8.0f); const float ang = (float)I.pos[row] * inv; float s, c; sincosf(ang, &s, &c);
        float* rp = (float*)(ws + WS_ROPE) + (size_t)row * 16; rp[i] = c; rp[8 + i] = s; }
    for (int m = gw; m < M; m += NGW) { const GAS f32x4* xr = (const GAS f32x4*)(I.x + (size_t)m * D) + F.lane; f32x4 v[4];
#pragma unroll
        for (int j = 0; j < 4; ++j) v[j] = xr[64 * j];
        store_row_bf16((bf16*)(ws + WS_XB) + (size_t)m * D, v, F.lane);
        write_gates(F, v, I.gate_bias, (float*)(ws + WS_GATES) + (size_t)m * 8); }
}
template <int ADD, int EXTRA>
__device__ __forceinline__ void ln_phase(Frame& F, const float* res, const float* addf, const bf16* y0, const bf16* y1, const float* g, const float* bt, float* outf, bf16* outb,
                                         const float* xbias, float* gates_out, int* list, float* listw, float oscale) {
    const int gw = F.vcu * NWAVES + F.wave, NGW = F.G * NWAVES;
    f32x4 gv[4], bv[4];
#pragma unroll
    for (int j = 0; j < 4; ++j) { gv[j] = ((const GAS f32x4*)g)[64 * j + F.lane]; bv[j] = ((const GAS f32x4*)bt)[64 * j + F.lane]; }
    for (int m = gw; m < M; m += NGW) {
        const GAS f32x4* rr = (const GAS f32x4*)(res + (size_t)m * D) + F.lane; f32x4 v[4]; float s = 0.f;
        if (ADD == 0) { const GAS f32x4* ar = (const GAS f32x4*)(addf + (size_t)m * D) + F.lane;
#pragma unroll
            for (int j = 0; j < 4; ++j) v[j] = rr[64 * j] * ALPHA + ar[64 * j];
        } else { const GAS v2u* a0 = (const GAS v2u*)(y0 + (size_t)m * D) + F.lane; const GAS v2u* a1 = (const GAS v2u*)(y1 + (size_t)m * D) + F.lane;
#pragma unroll
            for (int j = 0; j < 4; ++j) { const v2u p = a0[64 * j], q = a1[64 * j]; const f32x4 a = {bflo(p.x) + bflo(q.x), bfhi(p.x) + bfhi(q.x), bflo(p.y) + bflo(q.y), bfhi(p.y) + bfhi(q.y)}; v[j] = rr[64 * j] * ALPHA + a; } }
#pragma unroll
        for (int j = 0; j < 4; ++j) s += (v[j][0] + v[j][1]) + (v[j][2] + v[j][3]);
        const float mean = wave_sum(s) * (1.f / D); float s2 = 0.f;
#pragma unroll
        for (int j = 0; j < 4; ++j) { v[j] = v[j] - mean; s2 += (v[j][0] * v[j][0] + v[j][1] * v[j][1]) + (v[j][2] * v[j][2] + v[j][3] * v[j][3]); }
        const float rstd = 1.f / sqrtf(wave_sum(s2) * (1.f / D) + LN_EPS);
#pragma unroll
        for (int j = 0; j < 4; ++j) v[j] = (v[j] * rstd * gv[j] + bv[j]) * oscale;
        GAS f32x4* of = (GAS f32x4*)(outf + (size_t)m * D) + F.lane;
#pragma unroll
        for (int j = 0; j < 4; ++j) of[64 * j] = v[j];
        if (outb) store_row_bf16(outb + (size_t)m * D, v, F.lane);
        if (EXTRA == 1) write_gates(F, v, xbias, gates_out + (size_t)m * 8);
        if (EXTRA == 2) { float a[8]; row_dot8(F, v, a);
#pragma unroll
            for (int e = 0; e < 8; ++e) a[e] += xbias[e];
            int i0 = 0; float v0 = a[0];
#pragma unroll
            for (int e = 1; e < 8; ++e) if (a[e] > v0) { v0 = a[e]; i0 = e; }
            int i1 = -1; float v1 = -INFINITY;
#pragma unroll
            for (int e = 0; e < 8; ++e) if (e != i0 && a[e] > v1) { v1 = a[e]; i1 = e; }
            const float w1 = 1.f / (1.f + expf(v0 - v1)), w0 = 1.f - w1;
            if (F.lane < 2) { const int e = F.lane ? i1 : i0; const float w = F.lane ? w1 : w0;
                const unsigned p = __hip_atomic_fetch_add((unsigned*)(F.ctl + CW_ECNT + 64 * e), 1u, RLX_AGENT);
                list[(size_t)e * M + p] = m * 2 + F.lane; listw[(size_t)e * M + p] = w; } }
    }
}
__device__ __forceinline__ int moe_plan(Frame& F) {
    LAS int* texp = (LAS int*)(F.lds + TEXP_OFF);
    if (F.tid == 0) { int t = 0;
        for (int e = 0; e < NE; ++e) { const int c = (int)__hip_atomic_load((unsigned*)(F.ctl + CW_ECNT + 64 * e), RLX_AGENT); const int nt = (c + 255) >> 8; texp[MAXT + 1 + e] = t * 256;
            for (int k = 0; k < nt && t < MAXT; ++k) texp[t++] = e; }
        texp[MAXT] = t; }
    LDS_WAIT(); __syncthreads();
    return texp[MAXT];
}
__device__ __forceinline__ void moe_gather(Frame& F, int ntiles, const bf16* X1B, bf16* XS, const int* list, const float* listw, int* rowmap, float* roww) {
    const LAS int* texp = (const LAS int*)(F.lds + TEXP_OFF);
    const int gw = F.vcu * NWAVES + F.wave, NGW = F.G * NWAVES;
    for (int r = gw; r < ntiles * 256; r += NGW) { const int e = texp[r >> 8], i = r - texp[MAXT + 1 + e];
        const int c = (int)__hip_atomic_load((unsigned*)(F.ctl + CW_ECNT + 64 * e), RLX_AGENT);
        v4u a = {0u, 0u, 0u, 0u}, b = a; int ts = -1; float w = 0.f;
        if (i < c) { ts = list[(size_t)e * M + i]; w = listw[(size_t)e * M + i]; const GAS v4u* src = (const GAS v4u*)(X1B + (size_t)(ts >> 1) * D); a = src[F.lane]; b = src[64 + F.lane]; }
        GAS v4u* dst = (GAS v4u*)(XS + (size_t)r * D); dst[F.lane] = a; dst[64 + F.lane] = b;
        if (F.lane == 0) { rowmap[r] = ts; roww[r] = w; } }
}
__device__ __forceinline__ void moe_cvt(Frame& F, const In& I) {
    LAS float* scr = (LAS float*)(F.lds + F.wave * 8704);
    const int gw = F.vcu * NWAVES + F.wave, NGW = F.G * NWAVES;
    constexpr int I_GU = 2 * (D / 64) * (DEX / 32), I_DD = (DEX / 64) * (D / 32), PER = I_GU + I_DD;
    for (int it = gw; it < NE * PER; it += NGW) { const int e = it / PER; int r = it - e * PER;
        if (r < I_GU) cvt_gu(I.mg + (size_t)e * D * DEX, I.mu + (size_t)e * D * DEX, D, DEX, (bf16*)(F.ws + WS_MGU) + (size_t)e * 2 * DEX * D, scr, r, F.lane);
        else cvt_plain(I.md + (size_t)e * DEX * D, D, 0, DEX, D, (bf16*)(F.ws + WS_MD) + (size_t)e * D * DEX, scr, r - I_GU, F.lane); }
}

__device__ __forceinline__ float dot64_bf16(const LAS float* qs, const bf16* kr) {
    const GAS v4u* kp = (const GAS v4u*)kr; float a = 0.f;
#pragma unroll
    for (int c = 0; c < 8; ++c) { const v4u w = kp[c]; const LAS f32x4* q4 = (const LAS f32x4*)(qs + 8 * c); const f32x4 qa = q4[0], qb = q4[1];
        a += qa[0] * bflo(w.x) + qa[1] * bfhi(w.x) + qa[2] * bflo(w.y) + qa[3] * bfhi(w.y) + qb[0] * bflo(w.z) + qb[1] * bfhi(w.z) + qb[2] * bflo(w.w) + qb[3] * bfhi(w.w); }
    return a;
}
__device__ __forceinline__ void attn_naive(Frame& F, const bf16* PROJ, const float* ksum, const float* norm_attn, bf16* CAT, int w_lo, int w_n) {
    LAS float* qs = (LAS float*)(F.lds + F.wave * 4608); LAS float* ps = qs + 64;
    const int lane = F.lane; const int gwa = F.vcu * NWAVES + F.wave - w_lo;
    if (gwa < 0) return;
    for (int task = gwa; task < M * AH; task += w_n) {
        const int bh = task >> 13, t = task & 8191, b = bh >> 3, h = bh & 7; const size_t row = (size_t)b * SEQ + t; const int blk = t >> 8;
        qs[lane] = bf2f(PROJ[row * NPROJ + C_AQ + h * 64 + lane]); LDS_WAIT();
        float g = -INFINITY;
        if (lane < blk) { const float* km = ksum + ((size_t)(b * NB + lane) * 512 + h * 64); float a = 0.f;
            for (int d = 0; d < 64; ++d) a += qs[d] * km[d];
            g = a; }
        int sel[3];
#pragma unroll
        for (int k = 0; k < 3; ++k) { float v = g; int idx = lane;
#pragma unroll
            for (int o = 1; o < 64; o <<= 1) { const float ov = __shfl_xor(v, o); const int oi = __shfl_xor(idx, o); if (ov > v || (ov == v && oi < idx)) { v = ov; idx = oi; } }
            idx = __builtin_amdgcn_readfirstlane(idx); const bool ok = __builtin_amdgcn_readfirstlane(v > -INFINITY ? 1 : 0) != 0;
            sel[k] = ok ? idx : -1; if (lane == idx) g = -INFINITY; }
        float sc[4][4]; float mx = -INFINITY;
#pragma unroll
        for (int s = 0; s < 4; ++s) { const int jb = (s < 3) ? sel[s] : blk;
#pragma unroll
            for (int i = 0; i < 4; ++i) { float a = -INFINITY;
                if (jb >= 0) { const int kp = jb * 256 + i * 64 + lane; if (s < 3 || kp <= t) a = dot64_bf16(qs, PROJ + ((size_t)b * SEQ + kp) * NPROJ + C_AK + h * 64); }
                sc[s][i] = a; mx = fmaxf(mx, a); } }
        mx = wave_max(mx); float sum = 0.f;
#pragma unroll
        for (int s = 0; s < 4; ++s)
#pragma unroll
            for (int i = 0; i < 4; ++i) { const float p = __builtin_amdgcn_exp2f(sc[s][i] - mx); sum += p; ps[s * 256 + i * 64 + lane] = p; }
        sum = wave_sum(sum); LDS_WAIT();
        float o = 0.f;
#pragma unroll
        for (int s = 0; s < 4; ++s) { const int jb = (s < 3) ? sel[s] : blk; if (jb < 0) continue; const int kmax = (s < 3) ? 256 : (t - blk * 256 + 1);
            const bf16* vb = PROJ + ((size_t)b * SEQ + jb * 256) * NPROJ + C_AV + h * 64 + lane;
#pragma unroll 8
            for (int k = 0; k < kmax; ++k) o += ps[s * 256 + k] * bf2f(vb[(size_t)k * NPROJ]); }
        o = o / sum; const float ms = wave_sum(o * o) * (1.f / 64.f);
        o = o * (1.f / sqrtf(ms + RMS_EPS)) * norm_attn[h * 64 + lane];
        CAT[row * D + h * 64 + lane] = (bf16)f2bf(o);
        LDS_WAIT();
    }
}
__device__ __forceinline__ void mlstm_naive(Frame& F, int bh, const bf16* PROJ, const float* GATES, const float* conv_w, const float* conv_b, const float* norm_ml, bf16* CAT) {
    const int b = bh >> 2, h = bh & 3, tid = F.tid;
    LAS float* Cst = (LAS float*)(F.lds);
    LAS float* nst = (LAS float*)(F.lds + 33280);
    LAS float* qf = (LAS float*)(F.lds + 33792);
    LAS float* kf = (LAS float*)(F.lds + 67072);
    LAS bf16* vb = (LAS bf16*)(F.lds + 100352);
    LAS float* bs = (LAS float*)(F.lds + 133120);
    LAS float* ig = bs + 128;
    LAS float* mt = bs + 256;
    LAS float* wst = bs + 384;
    LAS float* scal = bs + 512;
    for (int e = tid; e < 128 * 65; e += 512) Cst[e] = 0.f;
    if (tid < 64) nst[tid] = 0.f;
    if (tid == 0) scal[0] = 0.f;
    __syncthreads();
    for (int c = 0; c < NCH; ++c) {
        const size_t row0 = (size_t)b * SEQ + (size_t)c * MLC;
        if (tid < 128) { ig[tid] = GATES[(row0 + tid) * 8 + h]; bs[tid] = GATES[(row0 + tid) * 8 + 4 + h]; }
        for (int e = tid; e < 128 * 128; e += 512) { const int t = e >> 7, cc = e & 127; const int isk = cc >> 6, d = cc & 63; const int ch = isk * 256 + h * 64 + d;
            float a = conv_b[ch];
#pragma unroll
            for (int j = 0; j < 4; ++j) { const int tt = c * MLC + t - 3 + j; if (tt >= 0) a += conv_w[j * 512 + ch] * bf2f(PROJ[((size_t)b * SEQ + tt) * NPROJ + C_MQ + ch]); }
            a = a / (1.f + expf(-a));
            if (isk) kf[t * 65 + d] = a; else qf[t * 65 + d] = a * 0.125f; }
        for (int e = tid; e < 128 * 128; e += 512) { const int t = e >> 7, vv = e & 127; vb[t * 128 + vv] = PROJ[(row0 + t) * NPROJ + C_MV + h * 128 + vv]; }
        __syncthreads();
        if (tid == 0) { const float mc = scal[0]; float run = 0.f, cm = -INFINITY;
            for (int t = 0; t < 128; ++t) { run += bs[t]; bs[t] = run; cm = fmaxf(cm, ig[t] - run); mt[t] = run + fmaxf(mc, cm); }
            const float bl = run; const float mnew = fmaxf(bl + mc, bl + cm); scal[1] = mnew; scal[2] = bl; }
        __syncthreads();
        if (tid < 128) wst[tid] = expf(scal[2] - bs[tid] + ig[tid] - scal[1]);
#pragma unroll 1
        for (int pass = 0; pass < 2; ++pass) {
            const int t = pass * 64 + (tid >> 3), vq = tid & 7; const float mc = scal[0]; const float bt = bs[t], mtt = mt[t];
            float q[64];
#pragma unroll
            for (int d = 0; d < 64; ++d) q[d] = qf[t * 65 + d];
            float num[16]; float den = 0.f;
#pragma unroll
            for (int j = 0; j < 16; ++j) num[j] = 0.f;
            const int tmax = pass * 64 + ((tid >> 6) << 3) + 7;
#pragma unroll 1
            for (int s = 0; s <= tmax; ++s) { if (s <= t) { float dot = 0.f;
#pragma unroll
                    for (int d = 0; d < 64; ++d) dot += q[d] * kf[s * 65 + d];
                    const float sw = dot * expf(bt - bs[s] + ig[s] - mtt); den += sw;
#pragma unroll
                    for (int j = 0; j < 16; ++j) num[j] += sw * bf2f(vb[s * 128 + vq * 16 + j]); } }
            const float wi = expf(bt + mc - mtt); float nq = 0.f;
#pragma unroll
            for (int d = 0; d < 64; ++d) nq += nst[d] * q[d];
            den += wi * nq;
            { float cq[16];
#pragma unroll
              for (int j = 0; j < 16; ++j) cq[j] = 0.f;
#pragma unroll 1
              for (int d = 0; d < 64; ++d) { const float qd = qf[t * 65 + d]; const LAS float* cr = Cst + (vq * 16) * 65 + d;
#pragma unroll
                  for (int j = 0; j < 16; ++j) cq[j] += cr[j * 65] * qd; }
#pragma unroll
              for (int j = 0; j < 16; ++j) num[j] += wi * cq[j]; }
            const float dn = 1.f / fmaxf(fabsf(den), expf(-mtt)); float ss = 0.f;
#pragma unroll
            for (int j = 0; j < 16; ++j) { num[j] *= dn; ss += num[j] * num[j]; }
            ss += __shfl_xor(ss, 1); ss += __shfl_xor(ss, 2); ss += __shfl_xor(ss, 4);
            const float rs = 1.f / sqrtf(ss * (1.f / 128.f) + RMS_EPS);
            const size_t row = row0 + t; const bf16* mo = PROJ + row * NPROJ + C_MO + h * 128 + vq * 16; bf16* out = CAT + row * D + 512 + h * 128 + vq * 16; const float* gn = norm_ml + h * 128 + vq * 16;
#pragma unroll
            for (int j = 0; j < 16; ++j) { const float o = bf2f(mo[j]); out[j] = (bf16)f2bf(num[j] * rs * gn[j] / (1.f + expf(-o))); }
        }
        __syncthreads();
        {
            const float cs = expf(scal[2] + scal[0] - scal[1]);
            for (int e = tid; e < 128 * 64; e += 512) { const int vv = e >> 6, d = e & 63; float a = 0.f;
                for (int s = 0; s < 128; ++s) a += wst[s] * bf2f(vb[s * 128 + vv]) * kf[s * 65 + d];
                Cst[vv * 65 + d] = cs * Cst[vv * 65 + d] + a; }
            if (tid < 64) { float a = 0.f; for (int s = 0; s < 128; ++s) a += wst[s] * kf[s * 65 + tid]; nst[tid] = cs * nst[tid] + a; }
        }
        __syncthreads();
        if (tid == 0) scal[0] = scal[1];
        __syncthreads();
    }
}

typedef short bf16x8_t __attribute__((ext_vector_type(8)));
#define MFMA16(a, b, c) __builtin_amdgcn_mfma_f32_16x16x32_bf16((a), (b), (c), 0, 0, 0)
__device__ __forceinline__ float wave_incl_sum(float v, int lane) {
#pragma unroll
    for (int o = 1; o < 64; o <<= 1) { const float y = __shfl_up(v, o); if (lane >= o) v += y; }
    return v;
}
__device__ __forceinline__ float wave_incl_max(float v, int lane) {
#pragma unroll
    for (int o = 1; o < 64; o <<= 1) { const float y = __shfl_up(v, o); if (lane >= o) v = fmaxf(v, y); }
    return v;
}
struct MlBufs { bf16* QC; bf16* KC; float* DC; bf16* CST; float* DN; float* NST; float* SC; float* MC; };
constexpr int ML_KW = 0, ML_VT = 17408, ML_ARR = 52224;
constexpr int MC_QS = 0, MC_KS = 18432, MC_VT = 36864, MC_CM = 76032, MC_SS = 96768, MC_ARR = 131584;

__device__ __forceinline__ void ml_stage_vt(Frame& F, const bf16* PROJ, size_t row0, int h, LAS bf16* VT) {
    for (int e = F.tid; e < 128 * 16; e += NWAVES * 64) { const int t = e >> 4, v0 = (e & 15) * 8;
        const v4u w = *(const GAS v4u*)(PROJ + (row0 + t) * NPROJ + C_MV + h * 128 + v0);
        VT[(v0 + 0) * 136 + t] = (bf16)(w.x & 0xffffu); VT[(v0 + 1) * 136 + t] = (bf16)(w.x >> 16); VT[(v0 + 2) * 136 + t] = (bf16)(w.y & 0xffffu); VT[(v0 + 3) * 136 + t] = (bf16)(w.y >> 16);
        VT[(v0 + 4) * 136 + t] = (bf16)(w.z & 0xffffu); VT[(v0 + 5) * 136 + t] = (bf16)(w.z >> 16); VT[(v0 + 6) * 136 + t] = (bf16)(w.w & 0xffffu); VT[(v0 + 7) * 136 + t] = (bf16)(w.w >> 16); }
}
__device__ __forceinline__ void ml_phase_a(Frame& F, int unit, const bf16* PROJ, const float* GATES, const float* conv_w, const float* conv_b, const MlBufs& B) {
    const int bh = unit >> 6, c = unit & 63, b = bh >> 2, h = bh & 3, tid = F.tid, lane = F.lane;
    const size_t row0 = (size_t)b * SEQ + (size_t)c * MLC;
    LAS bf16* KW = (LAS bf16*)(F.lds + ML_KW); LAS bf16* VT = (LAS bf16*)(F.lds + ML_VT);
    LAS float* wst = (LAS float*)(F.lds + ML_ARR);
    if (F.wave == 0) {
        const float i0 = GATES[(row0 + 2 * lane) * 8 + h], i1 = GATES[(row0 + 2 * lane + 1) * 8 + h], f0 = GATES[(row0 + 2 * lane) * 8 + 4 + h], f1 = GATES[(row0 + 2 * lane + 1) * 8 + 4 + h];
        const float tot = wave_incl_sum(f0 + f1, lane); const float b0 = tot - f1, b1 = tot;
        const float a0 = i0 - b0, a1 = i1 - b1; const float amax = wave_max(fmaxf(a0, a1)); const float bl = __shfl(b1, 63);
        wst[2 * lane] = expf(a0 - amax); wst[2 * lane + 1] = expf(a1 - amax);
        if (lane == 0) { B.SC[unit * 2] = bl + amax; B.SC[unit * 2 + 1] = bl; }
    }
    LDS_WAIT(); __syncthreads();
    for (int e = tid; e < 128 * 16; e += NWAVES * 64) { const int t = e >> 4, g8 = e & 15, isk = g8 >> 3, d0 = (g8 & 7) * 8; const int ch = isk * 256 + h * 64 + d0;
        float a[8];
#pragma unroll
        for (int i = 0; i < 8; ++i) a[i] = conv_b[ch + i];
#pragma unroll
        for (int j = 0; j < 4; ++j) { const int tt = c * MLC + t - 3 + j;
            if (tt >= 0) { const v4u w = *(const GAS v4u*)(PROJ + ((size_t)b * SEQ + tt) * NPROJ + C_MQ + ch); const f32x4 w0 = *(const GAS f32x4*)(conv_w + j * 512 + ch), w1 = *(const GAS f32x4*)(conv_w + j * 512 + ch + 4);
                a[0] += w0[0] * bflo(w.x); a[1] += w0[1] * bfhi(w.x); a[2] += w0[2] * bflo(w.y); a[3] += w0[3] * bfhi(w.y); a[4] += w1[0] * bflo(w.z); a[5] += w1[1] * bfhi(w.z); a[6] += w1[2] * bflo(w.w); a[7] += w1[3] * bfhi(w.w); } }
#pragma unroll
        for (int i = 0; i < 8; ++i) a[i] = a[i] / (1.f + expf(-a[i]));
        if (isk) { v4u o; o.x = pk2(a[0], a[1]); o.y = pk2(a[2], a[3]); o.z = pk2(a[4], a[5]); o.w = pk2(a[6], a[7]); *(GAS v4u*)(B.KC + (row0 + t) * 256 + h * 64 + d0) = o;
            const float ws = wst[t];
#pragma unroll
            for (int i = 0; i < 8; ++i) KW[(d0 + i) * 136 + t] = (bf16)f2bf(a[i] * ws);
        } else { v4u o; o.x = pk2(a[0] * 0.125f, a[1] * 0.125f); o.y = pk2(a[2] * 0.125f, a[3] * 0.125f); o.z = pk2(a[4] * 0.125f, a[5] * 0.125f); o.w = pk2(a[6] * 0.125f, a[7] * 0.125f);
            *(GAS v4u*)(B.QC + (row0 + t) * 256 + h * 64 + d0) = o; } }
    ml_stage_vt(F, PROJ, row0, h, VT);
    LDS_WAIT(); __syncthreads();
    {
        const int w = F.wave, r = lane & 15, q4 = lane >> 4; f32x4 acc[4];
#pragma unroll
        for (int nt = 0; nt < 4; ++nt) acc[nt] = (f32x4){0.f, 0.f, 0.f, 0.f};
#pragma unroll
        for (int ks = 0; ks < 4; ++ks) { const bf16x8_t a = *(const LAS bf16x8_t*)(VT + (16 * w + r) * 136 + 32 * ks + 8 * q4);
#pragma unroll
            for (int nt = 0; nt < 4; ++nt) { const bf16x8_t bb = *(const LAS bf16x8_t*)(KW + (16 * nt + r) * 136 + 32 * ks + 8 * q4); acc[nt] = MFMA16(a, bb, acc[nt]); } }
        float* dc = B.DC + (size_t)unit * 8192;
#pragma unroll
        for (int nt = 0; nt < 4; ++nt)
#pragma unroll
            for (int j = 0; j < 4; ++j) dc[(16 * w + 4 * q4 + j) * 64 + 16 * nt + r] = acc[nt][j];
        if (tid < 64) { float s = 0.f; for (int t = 0; t < 128; ++t) s += bf2f(KW[tid * 136 + t]); B.DN[unit * 64 + tid] = s; }
    }
    LDS_WAIT(); __syncthreads();
}
__device__ __forceinline__ void ml_phase_b(Frame& F, int u, const MlBufs& B) {
    const int bh = u >> 5, eb = (u & 31) * 256, tid = F.tid;
    LAS float* sC = (LAS float*)(F.lds); LAS float* sD = sC + 64;
    LAS float* scl = sD + 64;
    if (tid < 128) scl[tid] = B.SC[bh * 128 + tid];
    LDS_WAIT(); __syncthreads();
    if (tid == 0) { float m = 0.f;
        for (int c = 0; c < 64; ++c) { const float ac = scl[c * 2], bl = scl[c * 2 + 1]; const float mn = fmaxf(bl + m, ac);
            sC[c] = expf(bl + m - mn); sD[c] = expf(ac - mn); if ((u & 31) == 0) B.MC[bh * 64 + c] = m; m = mn; } }
    LDS_WAIT(); __syncthreads();
    if (tid < 256) { float C = 0.f; const float* dc = B.DC + (size_t)bh * 64 * 8192 + eb + tid; bf16* cs = B.CST + (size_t)bh * 64 * 8192 + eb + tid;
#pragma unroll 8
        for (int c = 0; c < 64; ++c) { cs[(size_t)c * 8192] = (bf16)f2bf(C); C = sC[c] * C + sD[c] * dc[(size_t)c * 8192]; } }
    else if (tid < 320 && (u & 31) == 0) { const int d = tid - 256; float n = 0.f;
        for (int c = 0; c < 64; ++c) { B.NST[(bh * 64 + c) * 64 + d] = n; n = sC[c] * n + sD[c] * B.DN[(bh * 64 + c) * 64 + d]; } }
    __syncthreads();
}
__device__ __forceinline__ void ml_phase_c(Frame& F, int unit, const bf16* PROJ, const float* GATES, const float* norm_ml, bf16* CAT, const MlBufs& B) {
    const int bh = unit >> 6, c = unit & 63, b = bh >> 2, h = bh & 3, tid = F.tid, lane = F.lane;
    const size_t row0 = (size_t)b * SEQ + (size_t)c * MLC;
    LAS bf16* QS = (LAS bf16*)(F.lds + MC_QS); LAS bf16* KS = (LAS bf16*)(F.lds + MC_KS); LAS bf16* VT = (LAS bf16*)(F.lds + MC_VT); LAS bf16* CM = (LAS bf16*)(F.lds + MC_CM); LAS bf16* SS = (LAS bf16*)(F.lds + MC_SS);
    LAS float* aa = (LAS float*)(F.lds + MC_ARR); LAS float* rt = aa + 128; LAS float* wint = aa + 256; LAS float* emt = aa + 384;
    if (F.wave == 0) {
        const float mc = B.MC[unit];
        const float i0 = GATES[(row0 + 2 * lane) * 8 + h], i1 = GATES[(row0 + 2 * lane + 1) * 8 + h], f0 = GATES[(row0 + 2 * lane) * 8 + 4 + h], f1 = GATES[(row0 + 2 * lane + 1) * 8 + 4 + h];
        const float tot = wave_incl_sum(f0 + f1, lane); const float b0 = tot - f1, b1 = tot;
        const float a0 = i0 - b0, a1 = i1 - b1; const float cmx = wave_incl_max(fmaxf(a0, a1), lane); const float cmprev = __shfl_up(cmx, 1);
        const float cm0 = (lane == 0) ? a0 : fmaxf(cmprev, a0), cm1 = cmx;
        const float mt0 = b0 + fmaxf(mc, cm0), mt1 = b1 + fmaxf(mc, cm1);
        aa[2 * lane] = a0; aa[2 * lane + 1] = a1; rt[2 * lane] = b0 - mt0; rt[2 * lane + 1] = b1 - mt1;
        wint[2 * lane] = expf(b0 + mc - mt0); wint[2 * lane + 1] = expf(b1 + mc - mt1); emt[2 * lane] = expf(-mt0); emt[2 * lane + 1] = expf(-mt1);
    }
    for (int e = tid; e < 128 * 8; e += NWAVES * 64) { const int t = e >> 3, ch = (e & 7) * 8;
        *(LAS v4u*)(QS + t * 72 + ch) = *(const GAS v4u*)(B.QC + (row0 + t) * 256 + h * 64 + ch);
        *(LAS v4u*)(KS + t * 72 + ch) = *(const GAS v4u*)(B.KC + (row0 + t) * 256 + h * 64 + ch);
        *(LAS v4u*)(CM + t * 72 + ch) = *(const GAS v4u*)(B.CST + (size_t)unit * 8192 + t * 64 + ch); }
    ml_stage_vt(F, PROJ, row0, h, VT);
    for (int e = tid; e < 16 * 128; e += NWAVES * 64) { const int rr = e >> 7, cc = e & 127; VT[(128 + rr) * 136 + cc] = (rr == 0) ? (bf16)0x3f80 : (bf16)0; }
    for (int e = tid; e < 16 * 64; e += NWAVES * 64) { const int rr = e >> 6, cc = e & 63; CM[(128 + rr) * 72 + cc] = (rr == 0) ? (bf16)f2bf(B.NST[unit * 64 + cc]) : (bf16)0; }
    LDS_WAIT(); __syncthreads();
    const int w = F.wave, r = lane & 15, q4 = lane >> 4;
    {
        bf16x8_t a[2];
#pragma unroll
        for (int ks = 0; ks < 2; ++ks) a[ks] = *(const LAS bf16x8_t*)(QS + (16 * w + r) * 72 + 32 * ks + 8 * q4);
        float rtj[4];
#pragma unroll
        for (int j = 0; j < 4; ++j) rtj[j] = rt[16 * w + 4 * q4 + j];
        for (int nt = 0; nt <= (w | 1); ++nt) { f32x4 acc = {0.f, 0.f, 0.f, 0.f};
#pragma unroll
            for (int ks = 0; ks < 2; ++ks) { const bf16x8_t bb = *(const LAS bf16x8_t*)(KS + (16 * nt + r) * 72 + 32 * ks + 8 * q4); acc = MFMA16(a[ks], bb, acc); }
            const int s = 16 * nt + r; const float as = aa[s];
#pragma unroll
            for (int j = 0; j < 4; ++j) { const int t = 16 * w + 4 * q4 + j; const float v = (s <= t) ? acc[j] * expf(rtj[j] + as) : 0.f; SS[t * 136 + s] = (bf16)f2bf(v); } }
    }
    LDS_WAIT();
    f32x4 accS[9], accQ[9];
#pragma unroll
    for (int nt = 0; nt < 9; ++nt) { accS[nt] = (f32x4){0.f, 0.f, 0.f, 0.f}; accQ[nt] = (f32x4){0.f, 0.f, 0.f, 0.f}; }
    for (int ks = 0; ks <= (16 * w + 15) / 32; ++ks) { const bf16x8_t a = *(const LAS bf16x8_t*)(SS + (16 * w + r) * 136 + 32 * ks + 8 * q4);
#pragma unroll
        for (int nt = 0; nt < 9; ++nt) { const bf16x8_t bb = *(const LAS bf16x8_t*)(VT + (16 * nt + r) * 136 + 32 * ks + 8 * q4); accS[nt] = MFMA16(a, bb, accS[nt]); } }
#pragma unroll
    for (int ks = 0; ks < 2; ++ks) { const bf16x8_t a = *(const LAS bf16x8_t*)(QS + (16 * w + r) * 72 + 32 * ks + 8 * q4);
#pragma unroll
        for (int nt = 0; nt < 9; ++nt) { const bf16x8_t bb = *(const LAS bf16x8_t*)(CM + (16 * nt + r) * 72 + 32 * ks + 8 * q4); accQ[nt] = MFMA16(a, bb, accQ[nt]); } }
    LDS_WAIT();
    {
        float gn[8];
#pragma unroll
        for (int nt = 0; nt < 8; ++nt) gn[nt] = norm_ml[h * 128 + 16 * nt + r];
#pragma unroll
        for (int j = 0; j < 4; ++j) { const int t = 16 * w + 4 * q4 + j; const float wi = wint[t];
            const float dS = __shfl(accS[8][j], lane & 48), dQ = __shfl(accQ[8][j], lane & 48);
            const float den = dS + wi * dQ; const float dn = 1.f / fmaxf(fabsf(den), emt[t]);
            float hv[8]; float ss = 0.f;
#pragma unroll
            for (int nt = 0; nt < 8; ++nt) { hv[nt] = (accS[nt][j] + wi * accQ[nt][j]) * dn; ss += hv[nt] * hv[nt]; }
            ss += __shfl_xor(ss, 1); ss += __shfl_xor(ss, 2); ss += __shfl_xor(ss, 4); ss += __shfl_xor(ss, 8);
            const float rs = 1.f / sqrtf(ss * (1.f / 128.f) + RMS_EPS);
#pragma unroll
            for (int nt = 0; nt < 8; ++nt) SS[t * 136 + 16 * nt + r] = (bf16)f2bf(hv[nt] * rs * gn[nt]); }
    }
    LDS_WAIT();
    for (int e = lane; e < 16 * 16; e += 64) { const int t = 16 * w + (e >> 4), v0 = (e & 15) * 8;
        const v4u hh = *(const LAS v4u*)(SS + t * 136 + v0); const v4u mo = *(const GAS v4u*)(PROJ + (row0 + t) * NPROJ + C_MO + h * 128 + v0);
        v4u o;
#define SGM(x) (1.f / (1.f + expf(-(x))))
        o.x = pk2(bflo(hh.x) * SGM(bflo(mo.x)), bfhi(hh.x) * SGM(bfhi(mo.x))); o.y = pk2(bflo(hh.y) * SGM(bflo(mo.y)), bfhi(hh.y) * SGM(bfhi(mo.y)));
        o.z = pk2(bflo(hh.z) * SGM(bflo(mo.z)), bfhi(hh.z) * SGM(bfhi(mo.z))); o.w = pk2(bflo(hh.w) * SGM(bflo(mo.w)), bfhi(hh.w) * SGM(bfhi(mo.w)));
#undef SGM
        *(GAS v4u*)(CAT + (row0 + t) * D + 512 + h * 128 + v0) = o; }
    LDS_WAIT(); __syncthreads();
}

typedef float f32x16_t __attribute__((ext_vector_type(16)));
typedef short s16x4_t __attribute__((ext_vector_type(4)));
typedef float f32x2_t __attribute__((ext_vector_type(2)));
typedef __bf16 bf16x2_t __attribute__((ext_vector_type(2)));
#define MFMA32(a, b, c) __builtin_amdgcn_mfma_f32_32x32x16_bf16((a), (b), (c), 0, 0, 0)
__device__ __forceinline__ unsigned cvtpk(float lo, float hi) { f32x2_t v = {lo, hi}; bf16x2_t b = __builtin_convertvector(v, bf16x2_t); return __builtin_bit_cast(unsigned, b); }
struct AtBufs { bf16* PO; float* PML; unsigned* SEL; unsigned* LISTQ; unsigned* BCNT; };
constexpr int AT_KS = 0, AT_VS = 36864, AT_END = 70656;
constexpr int AT_PFX = 71680;
constexpr int BKT_PER_BH = 126976;
__device__ __forceinline__ int bucket_off(int bh, int j) { return bh * BKT_PER_BH + 256 * (31 * j - (j * (j - 1)) / 2); }

__device__ __forceinline__ void attn_route(Frame& F, int unit, const bf16* PROJ, const float* ksum, const AtBufs& A) {
    const int bh = unit >> 5, blk = unit & 31, b = bh >> 3, h = bh & 7, tid = F.tid;
    LAS float* km = (LAS float*)(F.lds); LAS int* cnt = (LAS int*)(F.lds + 8192); LAS int* base = cnt + 32;
    for (int e = tid; e < blk * 64; e += NWAVES * 64) km[e] = ksum[(size_t)(b * NB + (e >> 6)) * 512 + h * 64 + (e & 63)];
    if (tid < 32) cnt[tid] = 0;
    LDS_WAIT(); __syncthreads();
    int i0 = -1, i1 = -1, i2 = -1, l0 = 0, l1 = 0, l2 = 0; const int t = blk * 256 + tid; const size_t row = (size_t)b * SEQ + t;
    if (tid < 256) {
        float q[64]; const GAS v4u* qp = (const GAS v4u*)(PROJ + row * NPROJ + C_AQ + h * 64);
#pragma unroll
        for (int c = 0; c < 8; ++c) { const v4u w = qp[c]; q[8 * c] = bflo(w.x); q[8 * c + 1] = bfhi(w.x); q[8 * c + 2] = bflo(w.y); q[8 * c + 3] = bfhi(w.y); q[8 * c + 4] = bflo(w.z); q[8 * c + 5] = bfhi(w.z); q[8 * c + 6] = bflo(w.w); q[8 * c + 7] = bfhi(w.w); }
        float v0 = -INFINITY, v1 = -INFINITY, v2 = -INFINITY;
        for (int n = 0; n < blk; ++n) { const LAS f32x4* kr = (const LAS f32x4*)(km + n * 64); float g = 0.f;
#pragma unroll
            for (int c = 0; c < 16; ++c) { const f32x4 kk = kr[c]; g += q[4 * c] * kk[0] + q[4 * c + 1] * kk[1] + q[4 * c + 2] * kk[2] + q[4 * c + 3] * kk[3]; }
            if (g > v0) { v2 = v1; i2 = i1; v1 = v0; i1 = i0; v0 = g; i0 = n; } else if (g > v1) { v2 = v1; i2 = i1; v1 = g; i1 = n; } else if (g > v2) { v2 = g; i2 = n; } }
        A.SEL[row * 8 + h] = (unsigned)(i0 & 0xff) | ((unsigned)(i1 & 0xff) << 8) | ((unsigned)(i2 & 0xff) << 16);
        if (i0 >= 0) l0 = __hip_atomic_fetch_add(cnt + i0, 1, __ATOMIC_RELAXED, __HIP_MEMORY_SCOPE_WORKGROUP);
        if (i1 >= 0) l1 = __hip_atomic_fetch_add(cnt + i1, 1, __ATOMIC_RELAXED, __HIP_MEMORY_SCOPE_WORKGROUP);
        if (i2 >= 0) l2 = __hip_atomic_fetch_add(cnt + i2, 1, __ATOMIC_RELAXED, __HIP_MEMORY_SCOPE_WORKGROUP);
    }
    LDS_WAIT(); __syncthreads();
    if (tid < blk) { const int c = cnt[tid]; base[tid] = c > 0 ? (int)__hip_atomic_fetch_add(A.BCNT + bh * 32 + tid, (unsigned)c, RLX_AGENT) : 0; }
    LDS_WAIT(); __syncthreads();
    if (tid < 256) {
        if (i0 >= 0) A.LISTQ[bucket_off(bh, i0) + base[i0] + l0] = (unsigned)t;
        if (i1 >= 0) A.LISTQ[bucket_off(bh, i1) + base[i1] + l1] = (unsigned)t | (1u << 13);
        if (i2 >= 0) A.LISTQ[bucket_off(bh, i2) + base[i2] + l2] = (unsigned)t | (2u << 13);
    }
    __syncthreads();
}
__device__ __forceinline__ void attn_stage_kv(Frame& F, const bf16* PROJ, size_t krow0, int h) {
    LAS bf16* KS = (LAS bf16*)(F.lds + AT_KS); LAS bf16* VS = (LAS bf16*)(F.lds + AT_VS);
    for (int e = F.tid; e < 256 * 8; e += NWAVES * 64) { const int key = e >> 3, d0 = (e & 7) * 8; const bf16* rp = PROJ + (krow0 + key) * NPROJ + h * 64 + d0;
        *(LAS v4u*)(KS + key * 72 + d0) = *(const GAS v4u*)(rp + C_AK);
        const v4u w = *(const GAS v4u*)(rp + C_AV);
        VS[(d0 + 0) * 264 + key] = (bf16)(w.x & 0xffffu); VS[(d0 + 1) * 264 + key] = (bf16)(w.x >> 16); VS[(d0 + 2) * 264 + key] = (bf16)(w.y & 0xffffu); VS[(d0 + 3) * 264 + key] = (bf16)(w.y >> 16);
        VS[(d0 + 4) * 264 + key] = (bf16)(w.z & 0xffffu); VS[(d0 + 5) * 264 + key] = (bf16)(w.z >> 16); VS[(d0 + 6) * 264 + key] = (bf16)(w.w & 0xffffu); VS[(d0 + 7) * 264 + key] = (bf16)(w.w >> 16); }
}
template <bool CAUSAL>
__device__ __forceinline__ void attn_core(Frame& F, const bf16x8_t (&qf)[4], int qloc, float& m, float& l, f32x16_t (&o)[2]) {
    const LAS bf16* KS = (const LAS bf16*)(F.lds + AT_KS); const LAS bf16* VS = (const LAS bf16*)(F.lds + AT_VS);
    const int lane = F.lane, r32 = lane & 31, hh = lane >> 5;
    m = -INFINITY; l = 0.f;
#pragma unroll
    for (int i = 0; i < 16; ++i) { o[0][i] = 0.f; o[1][i] = 0.f; }
    const int ktmax = CAUSAL ? ((32 * F.wave + 31) >> 6) : 3;
    for (int kt = 0; kt <= ktmax; ++kt) {
        f32x16_t p0, p1;
#pragma unroll
        for (int i = 0; i < 16; ++i) { p0[i] = 0.f; p1[i] = 0.f; }
#pragma unroll
        for (int d0 = 0; d0 < 4; ++d0) { const bf16x8_t k0 = *(const LAS bf16x8_t*)(KS + (64 * kt + r32) * 72 + 16 * d0 + 8 * hh), k1 = *(const LAS bf16x8_t*)(KS + (64 * kt + 32 + r32) * 72 + 16 * d0 + 8 * hh);
            p0 = MFMA32(k0, qf[d0], p0); p1 = MFMA32(k1, qf[d0], p1); }
        if (CAUSAL) { if (64 * kt + 63 > 32 * F.wave) {
#pragma unroll
                for (int i = 0; i < 16; ++i) { const int kl = 64 * kt + (i & 3) + 8 * (i >> 2) + 4 * hh; if (kl > qloc) p0[i] = -INFINITY; if (kl + 32 > qloc) p1[i] = -INFINITY; } } }
        float rm = fmaxf(p0[0], p1[0]);
#pragma unroll
        for (int i = 1; i < 16; ++i) rm = fmaxf(rm, fmaxf(p0[i], p1[i]));
        rm = fmaxf(rm, __shfl_xor(rm, 32));
        const float mn = fmaxf(m, rm); const float sc = __builtin_amdgcn_exp2f(m - mn); m = mn; l *= sc;
#pragma unroll
        for (int i = 0; i < 16; ++i) { o[0][i] *= sc; o[1][i] *= sc; }
        float ls = 0.f;
#pragma unroll
        for (int i = 0; i < 16; ++i) { p0[i] = __builtin_amdgcn_exp2f(p0[i] - mn); p1[i] = __builtin_amdgcn_exp2f(p1[i] - mn); ls += p0[i] + p1[i]; }
        l += ls;
        bf16x8_t pf[4];
#pragma unroll
        for (int s = 0; s < 2; ++s) { v4u a, c; a.x = cvtpk(p0[8 * s], p0[8 * s + 1]); a.y = cvtpk(p0[8 * s + 2], p0[8 * s + 3]); a.z = cvtpk(p0[8 * s + 4], p0[8 * s + 5]); a.w = cvtpk(p0[8 * s + 6], p0[8 * s + 7]);
            c.x = cvtpk(p1[8 * s], p1[8 * s + 1]); c.y = cvtpk(p1[8 * s + 2], p1[8 * s + 3]); c.z = cvtpk(p1[8 * s + 4], p1[8 * s + 5]); c.w = cvtpk(p1[8 * s + 6], p1[8 * s + 7]);
            pf[s] = __builtin_bit_cast(bf16x8_t, a); pf[2 + s] = __builtin_bit_cast(bf16x8_t, c); }
#pragma unroll
        for (int dt = 0; dt < 2; ++dt)
#pragma unroll
            for (int s = 0; s < 4; ++s) { const LAS bf16* vp = VS + (32 * dt + r32) * 264 + 64 * kt + 32 * (s >> 1) + 16 * (s & 1) + 4 * hh;
                const s16x4_t lo = *(const LAS s16x4_t*)vp, hi = *(const LAS s16x4_t*)(vp + 8);
                const bf16x8_t vf = {lo[0], lo[1], lo[2], lo[3], hi[0], hi[1], hi[2], hi[3]};
                o[dt] = MFMA32(vf, pf[s], o[dt]); }
    }
}
__device__ __forceinline__ int attn_tile_prefix(Frame& F, const AtBufs& A) {
    LAS int* pfx = (LAS int*)(F.lds + AT_PFX); LAS int* wtot = pfx + 512;
    const int k = F.tid; int nt = 0;
    if (k < 496) { const int bh = k / 31, j = k - bh * 31; nt = ((int)__hip_atomic_load(A.BCNT + bh * 32 + j, RLX_AGENT) + 255) >> 8; }
    int inc = nt;
#pragma unroll
    for (int o = 1; o < 64; o <<= 1) { const int y = __shfl_up(inc, o); if (F.lane >= o) inc += y; }
    if (F.lane == 63) wtot[F.wave] = inc;
    LDS_WAIT(); __syncthreads();
    int wb = 0;
    for (int w = 0; w < F.wave; ++w) wb += wtot[w];
    pfx[k] = wb + inc - nt;
    if (k == 511) pfx[512 + 16] = wb + inc;
    LDS_WAIT(); __syncthreads();
    return pfx[512 + 16];
}
__device__ __forceinline__ void attn_sel_unit(Frame& F, int u, const bf16* PROJ, const AtBufs& A) {
    const LAS int* pfx = (const LAS int*)(F.lds + AT_PFX);
    int lo = 0, hi = 495;
    while (lo < hi) { const int mid = (lo + hi + 1) >> 1; if (pfx[mid] <= u) lo = mid; else hi = mid - 1; }
    const int bk = lo, tile = u - pfx[bk], bh = bk / 31, j = bk - bh * 31, b = bh >> 3, h = bh & 7;
    const int n = (int)__hip_atomic_load(A.BCNT + bh * 32 + j, RLX_AGENT);
    const int lane = F.lane, r32 = lane & 31, hh = lane >> 5;
    attn_stage_kv(F, PROJ, (size_t)b * SEQ + (size_t)j * 256, h);
    const int idx = tile * 256 + 32 * F.wave + r32; const bool valid = idx < n;
    const unsigned ent = A.LISTQ[bucket_off(bh, j) + (valid ? idx : n - 1)]; const int t = ent & 8191, slot = ent >> 13;
    const size_t row = (size_t)b * SEQ + t;
    bf16x8_t qf[4];
#pragma unroll
    for (int d0 = 0; d0 < 4; ++d0) qf[d0] = *(const GAS bf16x8_t*)(PROJ + row * NPROJ + C_AQ + h * 64 + 16 * d0 + 8 * hh);
    LDS_WAIT(); __syncthreads();
    float m, l; f32x16_t o[2];
    attn_core<false>(F, qf, 0, m, l, o);
    l += __shfl_xor(l, 32); const float inv = 1.f / l;
    if (valid) { bf16* po = A.PO + ((row * 8 + h) * 3 + slot) * 64;
#pragma unroll
        for (int dt = 0; dt < 2; ++dt)
#pragma unroll
            for (int g = 0; g < 4; ++g) { v2u w; w.x = cvtpk(o[dt][4 * g] * inv, o[dt][4 * g + 1] * inv); w.y = cvtpk(o[dt][4 * g + 2] * inv, o[dt][4 * g + 3] * inv);
                *(GAS v2u*)(po + 32 * dt + 8 * g + 4 * hh) = w; }
        if (hh == 0) { float* pm = A.PML + ((row * 8 + h) * 3 + slot) * 2; pm[0] = m; pm[1] = l; } }
    LDS_WAIT(); __syncthreads();
}
__device__ __forceinline__ void attn_own_unit(Frame& F, int unit, const bf16* PROJ, const float* norm_attn, bf16* CAT, const AtBufs& A) {
    const int bh = unit >> 5, blk = unit & 31, b = bh >> 3, h = bh & 7;
    const int lane = F.lane, r32 = lane & 31, hh = lane >> 5;
    attn_stage_kv(F, PROJ, (size_t)b * SEQ + (size_t)blk * 256, h);
    const int qloc = 32 * F.wave + r32; const size_t row = (size_t)b * SEQ + blk * 256 + qloc;
    bf16x8_t qf[4];
#pragma unroll
    for (int d0 = 0; d0 < 4; ++d0) qf[d0] = *(const GAS bf16x8_t*)(PROJ + row * NPROJ + C_AQ + h * 64 + 16 * d0 + 8 * hh);
    const unsigned sel = A.SEL[row * 8 + h];
    LDS_WAIT(); __syncthreads();
    float m, l; f32x16_t o[2];
    attn_core<true>(F, qf, qloc, m, l, o);
    l += __shfl_xor(l, 32);
    float mk[3], lk[3]; float M2 = m;
#pragma unroll
    for (int k = 0; k < 3; ++k) { const bool ok = ((sel >> (8 * k)) & 0xffu) != 0xffu; mk[k] = -INFINITY; lk[k] = 0.f;
        if (ok) { const float* pm = A.PML + ((row * 8 + h) * 3 + k) * 2; mk[k] = pm[0]; lk[k] = pm[1]; } M2 = fmaxf(M2, mk[k]); }
    const float wo = __builtin_amdgcn_exp2f(m - M2); float L = l * wo;
#pragma unroll
    for (int i = 0; i < 16; ++i) { o[0][i] *= wo; o[1][i] *= wo; }
#pragma unroll
    for (int k = 0; k < 3; ++k) { const float wk = lk[k] * __builtin_amdgcn_exp2f(mk[k] - M2); L += wk;
        if (wk > 0.f) { const bf16* po = A.PO + ((row * 8 + h) * 3 + k) * 64;
#pragma unroll
            for (int dt = 0; dt < 2; ++dt)
#pragma unroll
                for (int g = 0; g < 4; ++g) { const v2u w = *(const GAS v2u*)(po + 32 * dt + 8 * g + 4 * hh);
                    o[dt][4 * g] += wk * bflo(w.x); o[dt][4 * g + 1] += wk * bfhi(w.x); o[dt][4 * g + 2] += wk * bflo(w.y); o[dt][4 * g + 3] += wk * bfhi(w.y); } } }
    const float inv = 1.f / L; float ss = 0.f;
#pragma unroll
    for (int i = 0; i < 16; ++i) { o[0][i] *= inv; o[1][i] *= inv; ss += o[0][i] * o[0][i] + o[1][i] * o[1][i]; }
    ss += __shfl_xor(ss, 32);
    const float rs = 1.f / sqrtf(ss * (1.f / 64.f) + RMS_EPS);
    bf16* co = CAT + row * D + h * 64;
#pragma unroll
    for (int dt = 0; dt < 2; ++dt)
#pragma unroll
        for (int g = 0; g < 4; ++g) { const int d0 = 32 * dt + 8 * g + 4 * hh; const f32x4 gn = *(const GAS f32x4*)(norm_attn + h * 64 + d0);
            v2u w; w.x = cvtpk(o[dt][4 * g] * rs * gn[0], o[dt][4 * g + 1] * rs * gn[1]); w.y = cvtpk(o[dt][4 * g + 2] * rs * gn[2], o[dt][4 * g + 3] * rs * gn[3]);
            *(GAS v2u*)(co + d0) = w; }
    LDS_WAIT(); __syncthreads();
}

constexpr int N_PHASES = 22;
struct Args { In in; float* out; unsigned char* ws; int ph_lo, ph_hi; };
__global__ void __launch_bounds__(NWAVES * 64, 2) hymba_fwd(Args args) {
    extern __shared__ __attribute__((aligned(16))) unsigned char lds[];
    Frame F;
    F.lds = (LAS unsigned char*)lds;
    F.MISC = (volatile LAS unsigned*)(F.lds + MISC_OFF);
    F.tid = threadIdx.x; F.lane = F.tid & 63; F.wave = __builtin_amdgcn_readfirstlane(F.tid >> 6);
    F.G = gridDim.x; { const int bx = blockIdx.x; F.vcu = (F.G % 8 == 0) ? (bx % 8) * (F.G / 8) + bx / 8 : bx; }
    F.ws = args.ws; unsigned char* ws = args.ws;
    F.ctl = (gu32*)(ws + WS_CTL);
    const In& I = args.in;
    for (int u = F.tid; u < (LDS_BYTES - MISC_OFF) / 4; u += NWAVES * 64) ((LAS unsigned*)(F.lds + MISC_OFF))[u] = 0u;
    __syncthreads();
    const int lo = args.ph_lo, hi = args.ph_hi;
    const bool multi = (hi - lo) > 1;
    XcdBarrier bar; bar.bar = (unsigned*)(F.ctl + CW_BAR); bar.x = 0; bar.st = nullptr;
    if (multi) bar = xcd_barrier_post((unsigned*)(F.ctl + CW_BAR), F.MISC + 8);
#define IN(k) (lo <= (k) && (k) < hi)
#define SEAM(k) do { if (IN(k) && IN((k) + 1)) xcd_barrier(bar); } while (0)
    bf16* XB = (bf16*)(ws + WS_XB); bf16* X1B = (bf16*)(ws + WS_X1B); float* XR = (float*)(ws + WS_XR); bf16* PROJ = (bf16*)(ws + WS_PROJ); bf16* CAT = (bf16*)(ws + WS_CAT);
    float* MIX = (float*)(ws + WS_MIX); float* MIX2 = (float*)(ws + WS_MIX2); bf16* HD = (bf16*)(ws + WS_HD); float* GATES = (float*)(ws + WS_GATES);
    const float* ROPE = (const float*)(ws + WS_ROPE);
    int* LIST = (int*)(ws + WS_LIST); float* LISTW = (float*)(ws + WS_LISTW); int* ROWMAP = (int*)(ws + WS_ROWMAP); float* ROWW = (float*)(ws + WS_ROWW);
    bf16* YB = (bf16*)(ws + WS_Y); bf16* HM = (bf16*)(ws + WS_HM); bf16* XS = (bf16*)(ws + WS_XS);

    if (IN(0)) { p_prologue(F, I); } SEAM(0);
    MlBufs MLB{(bf16*)(ws + WS_QC), (bf16*)(ws + WS_KC), (float*)(ws + WS_DC), (bf16*)(ws + WS_CST), (float*)(ws + WS_DN), (float*)(ws + WS_NST), (float*)(ws + WS_SC), (float*)(ws + WS_MC)};
    AtBufs ATB{(bf16*)(ws + WS_PO), (float*)(ws + WS_PML), (unsigned*)(ws + WS_SEL), (unsigned*)(ws + WS_LISTQ), nullptr};
#if defined(DBG_ML) || defined(DBG_AT)
    bf16* CAT2 = (bf16*)(ws + WS_CAT2);
#define DBG_CMP(COFF) { float ds = 0.f; for (size_t e = (size_t)blockIdx.x * 512 + F.tid; e < (size_t)M * 512; e += (size_t)F.G * 512) { const size_t idx = (e >> 9) * D + (COFF) + (e & 511); ds += fabsf(bf2f(CAT[idx]) - bf2f(CAT2[idx])); } \
        ds = wave_sum(ds); if (F.lane == 0) __hip_atomic_fetch_add((float*)(F.ctl + CW_DBG), ds, RLX_AGENT); }
#endif
#ifdef DBG_ML
#define DBG_NAIVE(L) if (F.vcu < 8) mlstm_naive(F, F.vcu, PROJ, GATES, I.conv_w + (L) * 2048, I.conv_b + (L) * 512, I.norm_ml + (L) * 512, CAT2);
#define DBG_COMPARE() DBG_CMP(512)
#elif defined(DBG_AT)
#define DBG_NAIVE(L) attn_naive(F, PROJ, (const float*)(F.ctl + CW_KSUM) + (L) * (BATCH * NB * 512), I.norm_attn + (L) * 512, CAT2, 0, F.G * NWAVES);
#define DBG_COMPARE() DBG_CMP(0)
#else
#define DBG_NAIVE(L)
#define DBG_COMPARE()
#endif

#define LAYER_MIXER(L, P)                                                                                                                                   \
    if (IN(P)) {                                                                                                                          \
        pg8::Gemm g{XB, (const bf16*)(ws + WS_WIN) + (size_t)(L) * NPROJ * D, M, NPROJ, D}; pg8::StaticOrder S; S.init(M, NPROJ, F.G, (int)blockIdx.x);     \
        pg8::EpiProj E{PROJ, ROPE, (float*)(F.ctl + CW_KSUM) + (L) * (BATCH * NB * 512), QSCALE};                                                          \
        pg8::gemm_phase<pg8::EpiProj, pg8::StaticOrder, true, true>(F.lds, g, S, E); } SEAM(P);                                                             \
    ATB.BCNT = (unsigned*)(F.ctl + CW_BCNT) + (L) * 512;                                                                                                    \
    if (IN((P) + 1)) {                                                                            \
        for (int u = F.vcu; u < 512; u += F.G) ml_phase_a(F, u, PROJ, GATES, I.conv_w + (L) * 2048, I.conv_b + (L) * 512, MLB);                             \
        for (int u = F.vcu; u < 512; u += F.G) attn_route(F, u, PROJ, (const float*)(F.ctl + CW_KSUM) + (L) * (BATCH * NB * 512), ATB);                    \
        DBG_NAIVE(L) } SEAM((P) + 1);                                                                                                                       \
    if (IN((P) + 2)) {                                                      \
        const int nu = attn_tile_prefix(F, ATB);                                                                                                            \
        for (int u = F.vcu; u < 256; u += F.G) ml_phase_b(F, u, MLB);                                                                                       \
        for (int u = F.vcu; u < nu; u += F.G) attn_sel_unit(F, u, PROJ, ATB); } SEAM((P) + 2);                                                              \
    if (IN((P) + 3)) {                                                                             \
        for (int u = F.vcu; u < 512; u += F.G) ml_phase_c(F, u, PROJ, GATES, I.norm_ml + (L) * 512, CAT, MLB);                                              \
        for (int u = F.vcu; u < 512; u += F.G) attn_own_unit(F, u, PROJ, I.norm_attn + (L) * 512, CAT, ATB); } SEAM((P) + 3);                               \
    if (IN((P) + 4)) {                                                                                                                   \
        DBG_COMPARE()                                                                                                                                       \
        pg8::Gemm g{CAT, (const bf16*)(ws + WS_WOUT) + (size_t)(L) * D * D, M, D, D}; pg8::StaticOrder S; S.init(M, D, F.G, (int)blockIdx.x);                \
        pg8::EpiF32 E{MIX, D};                                                                                                                              \
        pg8::gemm_phase<pg8::EpiF32, pg8::StaticOrder, false, true>(F.lds, g, S, E); } SEAM((P) + 4);

    LAYER_MIXER(0, 1)
    if (IN(6)) { ln_phase<0, 0>(F, I.x, MIX, nullptr, nullptr, I.ln1_g, I.ln1_b, args.out, X1B, nullptr, nullptr, nullptr, nullptr, 1.f); } SEAM(6);
    if (IN(7)) {
        pg8::Gemm g{X1B, (const bf16*)(ws + WS_WGU), M, 2 * DFF, D}; pg8::StaticOrder S; S.init(M, 2 * DFF, F.G, (int)blockIdx.x);
        pg8::EpiSwiglu E{HD, DFF, 0};
        pg8::gemm_phase<pg8::EpiSwiglu, pg8::StaticOrder, true, true>(F.lds, g, S, E); } SEAM(7);
    if (IN(8)) {
        pg8::Gemm g{HD, (const bf16*)(ws + WS_WD), M, D, DFF}; pg8::StaticOrder S; S.init(M, D, F.G, (int)blockIdx.x);
        pg8::EpiF32 E{MIX2, D};
        pg8::gemm_phase<pg8::EpiF32, pg8::StaticOrder, false, true>(F.lds, g, S, E); } SEAM(8);
    if (IN(9)) { stage_xw(F, I.w_in + (size_t)D * NIN, NIN, NPROJ);
        ln_phase<0, 1>(F, args.out, MIX2, nullptr, nullptr, I.ln2_g, I.ln2_b, XR, XB, I.gate_bias + 8, GATES, nullptr, nullptr, 1.f); } SEAM(9);
    LAYER_MIXER(1, 10)
    if (IN(15)) { stage_xw(F, I.router_w, 8, 0);
        ln_phase<0, 2>(F, XR, MIX, nullptr, nullptr, I.ln1_g + D, I.ln1_b + D, args.out, X1B, I.router_b, nullptr, LIST, LISTW, 1.f);
        __syncthreads(); moe_cvt(F, I); } SEAM(15);
    int ntiles = 0;
    if (lo <= 20 && hi > 16) ntiles = moe_plan(F);
    if (IN(16)) { moe_gather(F, ntiles, X1B, XS, LIST, LISTW, ROWMAP, ROWW); } SEAM(16);
    const PG8_LAS int* texp = (const PG8_LAS int*)(F.lds + TEXP_OFF);
#define MOE_PASS(P, T0)                                                                                                                                     \
    if (IN(P)) { const int t0 = (T0), t1 = (ntiles < (T0) + CAP) ? ntiles : (T0) + CAP;                                                                     \
        pg8::Gemm g{XS, (const bf16*)(ws + WS_MGU), MAXT * 256, 2 * DEX, D}; pg8::GroupedOrder<false> S; S.init(t0, t1, 2 * DEX / 256, F.G, (int)blockIdx.x, texp); \
        pg8::EpiSwiglu E{HM, DEX, t0};                                                                                                                      \
        pg8::gemm_phase<pg8::EpiSwiglu, pg8::GroupedOrder<false>, true, true>(F.lds, g, S, E); } SEAM(P);                                                   \
    if (IN((P) + 1)) { const int t0 = (T0), t1 = (ntiles < (T0) + CAP) ? ntiles : (T0) + CAP;                                                               \
        pg8::Gemm g{HM, (const bf16*)(ws + WS_MD), CAP * 256, D, DEX}; pg8::GroupedOrder<true> S; S.init(t0, t1, D / 256, F.G, (int)blockIdx.x, texp);        \
        pg8::EpiScatter E{YB, ROWMAP, ROWW, t0, M};                                                                                                         \
        pg8::gemm_phase<pg8::EpiScatter, pg8::GroupedOrder<true>, true, true>(F.lds, g, S, E); } SEAM((P) + 1);
    MOE_PASS(17, 0)
    MOE_PASS(19, CAP)
    if (IN(21)) { float osc = 1.f;
#if defined(DBG_ML) || defined(DBG_AT)
        osc = 1.f + 10.f * __hip_atomic_load((float*)(F.ctl + CW_DBG), RLX_AGENT) / (2.f * (float)M * 512.f);
#endif
        ln_phase<1, 0>(F, args.out, nullptr, YB, YB + (size_t)M * D, I.ln2_g + D, I.ln2_b + D, args.out, nullptr, nullptr, nullptr, nullptr, nullptr, osc); }
#undef IN
#undef SEAM
}

extern "C" void kernel_launch(void* const* d_in, const int* in_sizes, int n_in, void* d_out, int out_size, void* d_ws, size_t ws_size, hipStream_t stream) {
    static int grid = 0;
    if (grid == 0) {
        if (n_in != 21 || in_sizes[0] != M * D || out_size != M * D || ws_size < WS_END) { fprintf(stderr, "kernel_launch: unexpected shapes (n_in %d, in0 %d, out %d, ws %zu < %zu); nothing launched\n", n_in, n_in > 0 ? in_sizes[0] : -1, out_size, ws_size, (size_t)WS_END); grid = -1; return; }
        int dev = 0, cus = 0, per_cu = 0;
        if (hipGetDevice(&dev) != hipSuccess || hipDeviceGetAttribute(&cus, hipDeviceAttributeMultiprocessorCount, dev) != hipSuccess) { grid = -1; return; }
        if (hipFuncSetAttribute((const void*)hymba_fwd, hipFuncAttributeMaxDynamicSharedMemorySize, LDS_BYTES) != hipSuccess) { fprintf(stderr, "kernel_launch: hipFuncSetAttribute failed\n"); grid = -1; return; }
        if (hipOccupancyMaxActiveBlocksPerMultiprocessor(&per_cu, (const void*)hymba_fwd, NWAVES * 64, LDS_BYTES) != hipSuccess || per_cu < 1) fprintf(stderr, "kernel_launch: occupancy query reports %d\n", per_cu);
        (void)hipGetLastError();
        grid = cus;
    }
    if (grid < 0) return;
    if (hipMemsetAsync((char*)d_ws + WS_CTL, 0, CTL_ZERO_BYTES, stream) != hipSuccess) return;
    Args a{};
    const void** ip = (const void**)&a.in;
    for (int i = 0; i < 21; ++i) ip[i] = d_in[i];
    a.out = (float*)d_out; a.ws = (unsigned char*)d_ws;
#if defined(MK_MULTI)
    for (int p = 0; p < N_PHASES; ++p) { a.ph_lo = p; a.ph_hi = p + 1;
        hipLaunchKernelGGL(hymba_fwd, dim3(grid), dim3(NWAVES * 64), LDS_BYTES, stream, a); }
#else
    a.ph_lo = 0; a.ph_hi = N_PHASES;
    hipLaunchKernelGGL(hymba_fwd, dim3(grid), dim3(NWAVES * 64), LDS_BYTES, stream, a);
#endif
}
```

```cpp
#include <hip/hip_runtime.h>
#include <cstdio>
#include <cstdint>
#include <cmath>
namespace pg8 {
#define PG8_LAS __attribute__((address_space(3)))
typedef unsigned short bf16_t;
typedef short bf16x8 __attribute__((ext_vector_type(8)));
typedef float f32x4 __attribute__((ext_vector_type(4)));
typedef unsigned u32x4 __attribute__((ext_vector_type(4)));
typedef int v8i_t __attribute__((ext_vector_type(8)));
typedef int v4i_t __attribute__((ext_vector_type(4)));
__device__ __forceinline__ v8i_t pg8_cat(bf16x8 lo, bf16x8 hi) { const v4i_t a = __builtin_bit_cast(v4i_t, lo), b = __builtin_bit_cast(v4i_t, hi); return __builtin_shufflevector(a, b, 0, 1, 2, 3, 4, 5, 6, 7); }
constexpr int BM = 256, BK = 64, HALF = 128, HTB = HALF * BK * 2  , STAGE_BYTES = 8 * HTB, NXCD = 8, WGM = 8;

__host__ __device__ __forceinline__ int lds_byte(int r, int c) { const int st = (r >> 4) * 2 + (c >> 5), rr = r & 15, cc = c & 31, ob = rr * 64 + cc * 2; return st * 1024 + (ob ^ (((ob >> 9) & 1) << 5)); }
__host__ __device__ __forceinline__ void stage_rc(int b, int& R, int& C) { const int st = b / 1024, sb = b % 1024, swz = sb ^ (((sb >> 9) & 1) << 5); R = (st >> 1) * 16 + swz / 64; C = (st & 1) * 32 + (swz % 64) / 2; }
__host__ __device__ __forceinline__ int perm32(int rho) { const int n = rho >> 4, i = rho & 15; return 8 * (i >> 2) + 4 * n + (i & 3); }

struct Unit { int pm, pn, pb; };
struct Gemm { const bf16_t* A; const bf16_t* Bt; int M, N, K; };

struct StaticOrder {
    int nM, nN, nwg, G, c;
    __host__ __device__ void init(int M, int N, int G_, int c_) { nM = M / BM; nN = N / BM; nwg = nM * nN; G = G_; c = c_; }
    __host__ __device__ bool next(int i, Unit& u) const {
        const long L = (long)i * G + c; if (L >= nwg) return false;
        int wgid = (int)L; { const int q = nwg / NXCD, r = nwg % NXCD, xcd = wgid % NXCD, off = wgid / NXCD; wgid = (xcd < r ? xcd * (q + 1) : r * (q + 1) + (xcd - r) * q) + off; }
        const int nig = WGM * nN, gid = wgid / nig, fm = gid * WGM, gsz = (nM - fm) < WGM ? (nM - fm) : WGM;
        u.pm = fm + ((wgid % nig) % gsz); u.pn = (wgid % nig) / gsz; u.pb = u.pn; return true;
    }
    __device__ __forceinline__ void a_ready(const Unit&) const {}
    __device__ __forceinline__ void done(const Unit&) const {}
};


__device__ __forceinline__ unsigned cvt_pk_bf16(float lo, float hi) { unsigned r; asm volatile("v_cvt_pk_bf16_f32 %0, %1, %2" : "=v"(r) : "v"(lo), "v"(hi)); return r; }
__device__ __forceinline__ u32x4 pack8(const f32x4 v0, const f32x4 v1) { u32x4 w; w.x = cvt_pk_bf16(v0[0], v0[1]); w.y = cvt_pk_bf16(v0[2], v0[3]); w.z = cvt_pk_bf16(v1[0], v1[1]); w.w = cvt_pk_bf16(v1[2], v1[3]); return w; }
__device__ __forceinline__ f32x4 shx16(const f32x4 v) { f32x4 r; r[0] = __shfl_xor(v[0], 16); r[1] = __shfl_xor(v[1], 16); r[2] = __shfl_xor(v[2], 16); r[3] = __shfl_xor(v[3], 16); return r; }

struct EpiF32 {
    static constexpr bool PERM = false, AFTER_DRAIN = false;
    float* C; int ldc;
    __device__ __forceinline__ void operator()(const f32x4 (&acc)[2][2][4][2], const Unit& u, int wr, int wc, int fr, int fq) const {
        const int row0 = u.pm * BM + wr * 64 + fr, col0 = u.pn * BM + wc * 32 + 4 * fq;
#pragma unroll
        for (int ai = 0; ai < 2; ++ai)
#pragma unroll
            for (int m = 0; m < 4; ++m) { float* rowp = C + (size_t)(row0 + ai * HALF + m * 16) * ldc + col0;
#pragma unroll
                for (int bj = 0; bj < 2; ++bj)
#pragma unroll
                    for (int n = 0; n < 2; ++n) *(f32x4*)(rowp + bj * HALF + n * 16) = acc[ai][bj][m][n]; }
    }
};


struct EpiBf16s {
    static constexpr bool PERM = true, AFTER_DRAIN = false;
    bf16_t* O; int ldc; float s;
    __device__ __forceinline__ void operator()(const f32x4 (&acc)[2][2][4][2], const Unit& u, int wr, int wc, int fr, int fq) const {
        const int row0 = u.pm * BM + wr * 64 + fr, col0 = u.pn * BM + wc * 32 + 8 * fq;
#pragma unroll
        for (int ai = 0; ai < 2; ++ai)
#pragma unroll
            for (int m = 0; m < 4; ++m) { bf16_t* rowp = O + (size_t)(row0 + ai * HALF + m * 16) * ldc + col0;
#pragma unroll
                for (int bj = 0; bj < 2; ++bj) *(u32x4*)(rowp + bj * HALF) = pack8(acc[ai][bj][m][0] * s, acc[ai][bj][m][1] * s); }
    }
};
struct EpiProj {
    static constexpr bool PERM = true, AFTER_DRAIN = false;
    bf16_t* O; const float* rope; float* ksum; float qscale;
    __device__ __forceinline__ void operator()(const f32x4 (&acc)[2][2][4][2], const Unit& u, int wr, int wc, int fr, int fq) const {
        const int row0 = u.pm * BM + wr * 64 + fr; const int colt = u.pn * BM; const int col0 = colt + wc * 32 + 8 * fq;
        const bool is_qk = u.pn < 4, is_q = u.pn < 2, rot = is_qk && ((wc & 1) == 0);
        float ks[2][8];
#pragma unroll
        for (int bj = 0; bj < 2; ++bj)
#pragma unroll
            for (int i = 0; i < 8; ++i) ks[bj][i] = 0.f;
#pragma unroll
        for (int ai = 0; ai < 2; ++ai)
#pragma unroll
            for (int m = 0; m < 4; ++m) { const int row = row0 + ai * HALF + m * 16; bf16_t* rowp = O + (size_t)row * 3072 + col0;
                f32x4 c0 = {1.f, 1.f, 1.f, 1.f}, c1 = c0, s0 = {0.f, 0.f, 0.f, 0.f}, s1 = s0;
                if (rot && fq < 2) { const f32x4* rp = (const f32x4*)(rope + (size_t)row * 16); c0 = rp[0]; c1 = rp[1]; s0 = rp[2]; s1 = rp[3]; if (fq == 0) { s0 = -s0; s1 = -s1; } }
#pragma unroll
                for (int bj = 0; bj < 2; ++bj) { f32x4 v0 = acc[ai][bj][m][0], v1 = acc[ai][bj][m][1];
                    if (rot) { const f32x4 p0 = shx16(v0), p1 = shx16(v1); v0 = v0 * c0 + p0 * s0; v1 = v1 * c1 + p1 * s1; }
                    if (is_q) { v0 = v0 * qscale; v1 = v1 * qscale; }
                    else if (is_qk) {
#pragma unroll
                        for (int i = 0; i < 4; ++i) { ks[bj][i] += v0[i]; ks[bj][4 + i] += v1[i]; } }
                    *(u32x4*)(rowp + bj * HALF) = pack8(v0, v1); } }
        if (is_qk && !is_q) {
            float* kd = ksum + (size_t)u.pm * 512 + (colt - 512) + wc * 32 + 8 * fq;
#pragma unroll
            for (int bj = 0; bj < 2; ++bj)
#pragma unroll
                for (int i = 0; i < 8; ++i) { float s = ks[bj][i]; s += __shfl_xor(s, 1); s += __shfl_xor(s, 2); s += __shfl_xor(s, 4); s += __shfl_xor(s, 8);
                    if (fr == 0) __hip_atomic_fetch_add(kd + bj * HALF + i, s, __ATOMIC_RELAXED, __HIP_MEMORY_SCOPE_AGENT); }
        }
    }
};

__device__ __forceinline__ float silu_f(float x) { return x * __builtin_amdgcn_rcpf(1.0f + __builtin_amdgcn_exp2f(-1.4426950408889634f * x)); }
struct EpiSwiglu {
    static constexpr bool PERM = true, AFTER_DRAIN = false;
    bf16_t* H; int ldh; int pm_off;
    __device__ __forceinline__ void operator()(const f32x4 (&acc)[2][2][4][2], const Unit& u, int wr, int wc, int fr, int fq) const {
        const int row0 = (u.pm - pm_off) * BM + wr * 64 + fr; const int col0 = u.pn * HALF + wc * 32 + 8 * fq;
#pragma unroll
        for (int ai = 0; ai < 2; ++ai)
#pragma unroll
            for (int m = 0; m < 4; ++m) { bf16_t* rowp = H + (size_t)(row0 + ai * HALF + m * 16) * ldh + col0;
                const f32x4 g0 = acc[ai][0][m][0], g1 = acc[ai][0][m][1], u0 = acc[ai][1][m][0], u1 = acc[ai][1][m][1]; f32x4 h0, h1;
#pragma unroll
                for (int i = 0; i < 4; ++i) { h0[i] = silu_f(g0[i]) * u0[i]; h1[i] = silu_f(g1[i]) * u1[i]; }
                *(u32x4*)rowp = pack8(h0, h1); }
    }
};

typedef unsigned u32x2 __attribute__((ext_vector_type(2)));
__device__ __forceinline__ float clamp448(float x) { return fminf(fmaxf(x, -448.f), 448.f); }
__device__ __forceinline__ unsigned f8x4(float a, float b, float c, float d) { int p = 0; p = __builtin_amdgcn_cvt_pk_fp8_f32(clamp448(a), clamp448(b), p, false); p = __builtin_amdgcn_cvt_pk_fp8_f32(clamp448(c), clamp448(d), p, true); return (unsigned)p; }
struct EpiSwiglu8 {
    static constexpr bool PERM = true, AFTER_DRAIN = false;
    unsigned char* H; int ldh; int pm_off; float sg;
    __device__ __forceinline__ void operator()(const f32x4 (&acc)[2][2][4][2], const Unit& u, int wr, int wc, int fr, int fq) const {
        const int row0 = (u.pm - pm_off) * BM + wr * 64 + fr; const int col0 = u.pn * HALF + wc * 32 + 8 * fq;
#pragma unroll
        for (int ai = 0; ai < 2; ++ai)
#pragma unroll
            for (int m = 0; m < 4; ++m) { unsigned char* rowp = H + (size_t)(row0 + ai * HALF + m * 16) * ldh + col0;
                const f32x4 g0 = acc[ai][0][m][0] * sg, g1 = acc[ai][0][m][1] * sg, u0 = acc[ai][1][m][0] * sg, u1 = acc[ai][1][m][1] * sg; f32x4 h0, h1;
#pragma unroll
                for (int i = 0; i < 4; ++i) { h0[i] = silu_f(g0[i]) * u0[i]; h1[i] = silu_f(g1[i]) * u1[i]; }
                u32x2 w; w.x = f8x4(h0[0], h0[1], h0[2], h0[3]); w.y = f8x4(h1[0], h1[1], h1[2], h1[3]); *(u32x2*)rowp = w; }
    }
};
struct EpiF32s {
    static constexpr bool PERM = false, AFTER_DRAIN = false;
    float* C; int ldc; float s;
    __device__ __forceinline__ void operator()(const f32x4 (&acc)[2][2][4][2], const Unit& u, int wr, int wc, int fr, int fq) const {
        const int row0 = u.pm * BM + wr * 64 + fr, col0 = u.pn * BM + wc * 32 + 4 * fq;
#pragma unroll
        for (int ai = 0; ai < 2; ++ai)
#pragma unroll
            for (int m = 0; m < 4; ++m) { float* rowp = C + (size_t)(row0 + ai * HALF + m * 16) * ldc + col0;
#pragma unroll
                for (int bj = 0; bj < 2; ++bj)
#pragma unroll
                    for (int n = 0; n < 2; ++n) *(f32x4*)(rowp + bj * HALF + n * 16) = acc[ai][bj][m][n] * s; }
    }
};
struct EpiScatter {
    static constexpr bool PERM = true, AFTER_DRAIN = false;
    bf16_t* Y; const int* rowmap; const float* roww; int pm_off; int mtok; float s;
    __device__ __forceinline__ void operator()(const f32x4 (&acc)[2][2][4][2], const Unit& u, int wr, int wc, int fr, int fq) const {
        const int row0 = (u.pm + pm_off) * BM + wr * 64 + fr; const int col0 = u.pn * BM + wc * 32 + 8 * fq;
#pragma unroll
        for (int ai = 0; ai < 2; ++ai)
#pragma unroll
            for (int m = 0; m < 4; ++m) { const int r = row0 + ai * HALF + m * 16; const int ts = rowmap[r];
                if (ts >= 0) { const float w = roww[r] * s; bf16_t* rowp = Y + ((size_t)(ts & 1) * mtok + (ts >> 1)) * 1024 + col0;
#pragma unroll
                    for (int bj = 0; bj < 2; ++bj) *(u32x4*)(rowp + bj * HALF) = pack8(acc[ai][bj][m][0] * w, acc[ai][bj][m][1] * w); } }
    }
};
template <bool REL> struct GroupedOrder {
    int t0, nM, nN, nwg, G, c; const PG8_LAS int* texp;
    __device__ __forceinline__ void init(int t0_, int t1_, int nN_, int G_, int c_, const PG8_LAS int* texp_) { t0 = t0_; nM = t1_ - t0_; if (nM < 0) nM = 0; nN = nN_; nwg = nM * nN; G = G_; c = c_; texp = texp_; }
    __device__ __forceinline__ bool next(int i, Unit& u) const {
        const long L = (long)i * G + c; if (L >= nwg) return false;
        int wgid = (int)L; { const int q = nwg / NXCD, r = nwg % NXCD, xcd = wgid % NXCD, off = wgid / NXCD; wgid = (xcd < r ? xcd * (q + 1) : r * (q + 1) + (xcd - r) * q) + off; }
        const int nig = WGM * nN, gid = wgid / nig, fm = gid * WGM, gsz = (nM - fm) < WGM ? (nM - fm) : WGM;
        const int pmr = fm + ((wgid % nig) % gsz); u.pn = (wgid % nig) / gsz; u.pm = REL ? pmr : (t0 + pmr); u.pb = texp[t0 + pmr] * nN + u.pn; return true;
    }
    __device__ __forceinline__ void a_ready(const Unit&) const {}
    __device__ __forceinline__ void done(const Unit&) const {}
};
template <class Epi, class Sched, bool ALIGN_EPI = false, bool SP2 = false, bool F8 = false>
__device__ __forceinline__ void gemm_phase(PG8_LAS unsigned char* lds, const Gemm g, const Sched& S, const Epi& E) {
    const int tid = threadIdx.x, wid = __builtin_amdgcn_readfirstlane(tid >> 6), lane = tid & 63, wr = wid >> 2, wc = wid & 3, fr = lane & 15, fq = lane >> 4;
    const int K = g.K, nt = K / BK;
    unsigned voffA[2], voffB[2];
#pragma unroll
    for (int i = 0; i < 2; ++i) { int R, C; stage_rc(tid * 16 + i * 8192, R, C); const int Rb = Epi::PERM ? ((R & ~31) + perm32(R & 31)) : R;
        voffA[i] = (unsigned)(R * K + C) * 2u; voffB[i] = (unsigned)(Rb * K + C) * 2u; }
    const size_t kstep = (size_t)(BK * 2);
    const size_t hstep = (size_t)HALF * K * 2;
    const size_t tstep = 2 * hstep;
    const unsigned ldsw = (unsigned)wid * 1024u;
    const int aoff = lds_byte(wr * 64 + fr, fq * 8), boff = lds_byte(wc * 32 + fr, fq * 8);
#define PG8_SA(b, h) (((b) * 2 + (h)) * HTB)
#define PG8_SB(b, h) ((4 + (b) * 2 + (h)) * HTB)
#define PG8_STAGE(bufoff, gbase, voff) do { _Pragma("unroll") for (int _i = 0; _i < 2; ++_i) \
        __builtin_amdgcn_global_load_lds((const unsigned*)((const char*)(gbase) + (voff)[_i]), (PG8_LAS unsigned*)(lds + (bufoff) + ldsw + _i * 8192), 16, 0, 0); } while (0)
#define PG8_LDA(dst, b, h) do { if constexpr (F8) { _Pragma("unroll") for (int m = 0; m < 4; ++m) dst##8[m] = pg8_cat(*(const PG8_LAS bf16x8*)(lds + PG8_SA(b, h) + aoff + m * 2048), *(const PG8_LAS bf16x8*)(lds + PG8_SA(b, h) + aoff + m * 2048 + 1024)); } else { _Pragma("unroll") for (int m = 0; m < 4; ++m) _Pragma("unroll") for (int k = 0; k < 2; ++k) dst[m][k] = *(const PG8_LAS bf16x8*)(lds + PG8_SA(b, h) + aoff + m * 2048 + k * 1024); } } while (0)
#define PG8_LDB(dst, b, h) do { if constexpr (F8) { _Pragma("unroll") for (int n = 0; n < 2; ++n) dst##8[n] = pg8_cat(*(const PG8_LAS bf16x8*)(lds + PG8_SB(b, h) + boff + n * 2048), *(const PG8_LAS bf16x8*)(lds + PG8_SB(b, h) + boff + n * 2048 + 1024)); } else { _Pragma("unroll") for (int n = 0; n < 2; ++n) _Pragma("unroll") for (int k = 0; k < 2; ++k) dst[n][k] = *(const PG8_LAS bf16x8*)(lds + PG8_SB(b, h) + boff + n * 2048 + k * 1024); } } while (0)
#define PG8_MMA(ai, bj, At, Bt) do { __builtin_amdgcn_s_setprio(1); if constexpr (F8) { _Pragma("unroll") for (int m = 0; m < 4; ++m) _Pragma("unroll") for (int n = 0; n < 2; ++n) asm volatile("v_mfma_f32_16x16x128_f8f6f4 %0, %1, %2, %0" : "+v"(acc[ai][bj][m][n]) : "v"(Bt##8[n]), "v"(At##8[m])); } else { _Pragma("unroll") for (int m = 0; m < 4; ++m) _Pragma("unroll") for (int n = 0; n < 2; ++n) _Pragma("unroll") for (int k = 0; k < 2; ++k) acc[ai][bj][m][n] = __builtin_amdgcn_mfma_f32_16x16x32_bf16(Bt[n][k], At[m][k], acc[ai][bj][m][n], 0, 0, 0); } __builtin_amdgcn_s_setprio(0); } while (0)
#define PG8_WAIT_V(n) asm volatile("s_waitcnt vmcnt(" #n ")" ::: "memory")
#define PG8_WAIT_L(n) asm volatile("s_waitcnt lgkmcnt(" #n ")" ::: "memory")
#define PG8_BAR __builtin_amdgcn_s_barrier()
#define PG8_SCHED __builtin_amdgcn_sched_barrier(0)
    Unit cur, nxt; int ui = 0;
    if (!S.next(0, cur)) return;
    f32x4 acc[2][2][4][2];
#pragma unroll
    for (int a = 0; a < 2; ++a)
#pragma unroll
        for (int b = 0; b < 2; ++b)
#pragma unroll
            for (int m = 0; m < 4; ++m)
#pragma unroll
                for (int n = 0; n < 2; ++n) acc[a][b][m][n] = (f32x4){0.f, 0.f, 0.f, 0.f};
    bf16x8 At[4][2], B0[2][2], B1[2][2];
    v8i_t At8[4], B08[2], B18[2];
    const char* cA = (const char*)g.A + (size_t)cur.pm * tstep; const char* cB = (const char*)g.Bt + (size_t)cur.pb * tstep;
    S.a_ready(cur);
    if constexpr (SP2) {
        PG8_STAGE(PG8_SB(0, 0), cB, voffB); PG8_STAGE(PG8_SB(0, 1), cB + hstep, voffB); PG8_STAGE(PG8_SA(0, 0), cA, voffA); PG8_STAGE(PG8_SA(0, 1), cA + hstep, voffA);
        if (wr == 1) PG8_BAR;
        PG8_WAIT_V(2); PG8_BAR;
        PG8_STAGE(PG8_SB(1, 0), cB + kstep, voffB); PG8_STAGE(PG8_SA(1, 0), cA + kstep, voffA); PG8_STAGE(PG8_SB(1, 1), cB + hstep + kstep, voffB);
        PG8_WAIT_V(6); PG8_BAR;
    } else {
        PG8_STAGE(PG8_SB(0, 0), cB, voffB); PG8_STAGE(PG8_SA(0, 0), cA, voffA); PG8_STAGE(PG8_SB(0, 1), cB + hstep, voffB); PG8_STAGE(PG8_SA(0, 1), cA + hstep, voffA);
        if (wr == 1) PG8_BAR;
        PG8_WAIT_V(4); PG8_BAR;
        PG8_STAGE(PG8_SB(1, 0), cB + kstep, voffB); PG8_STAGE(PG8_SA(1, 0), cA + kstep, voffA); PG8_STAGE(PG8_SB(1, 1), cB + hstep + kstep, voffB);
        PG8_WAIT_V(6); PG8_BAR;
    }
    for (;;) {
        const bool has_next = S.next(ui + 1, nxt);
        const char* nA = has_next ? (const char*)g.A + (size_t)nxt.pm * tstep : cA; const char* nB = has_next ? (const char*)g.Bt + (size_t)nxt.pb * tstep : cB;
        for (int t = 0; t < nt; t += 2) {
            const bool last = (t == nt - 2);
            const char* a1 = cA + (size_t)(t + 1) * kstep;
            const char* a2 = last ? nA : cA + (size_t)(t + 2) * kstep; const char* b2 = last ? nB : cB + (size_t)(t + 2) * kstep;
            const char* a3 = a2 + kstep; const char* b3 = b2 + kstep;
            if (last && has_next) S.a_ready(nxt);
            if constexpr (SP2) {
            PG8_LDB(B0, 0, 0); PG8_LDB(B1, 0, 1); PG8_SCHED; PG8_LDA(At, 0, 0); PG8_STAGE(PG8_SA(1, 1), a1 + hstep, voffA);
            PG8_WAIT_V(8); PG8_WAIT_L(0); PG8_BAR; PG8_MMA(0, 0, At, B0); PG8_MMA(0, 1, At, B1); PG8_BAR; PG8_SCHED;
            PG8_LDA(At, 0, 1); PG8_STAGE(PG8_SB(0, 0), b2, voffB); PG8_STAGE(PG8_SB(0, 1), b2 + hstep, voffB); PG8_STAGE(PG8_SA(0, 0), a2, voffA);
            PG8_WAIT_V(8); PG8_WAIT_L(0); PG8_BAR; PG8_MMA(1, 0, At, B0); PG8_MMA(1, 1, At, B1); PG8_BAR; PG8_SCHED;
            PG8_LDB(B0, 1, 0); PG8_LDB(B1, 1, 1); PG8_SCHED; PG8_LDA(At, 1, 0); PG8_STAGE(PG8_SA(0, 1), a2 + hstep, voffA);
            PG8_WAIT_V(8); PG8_WAIT_L(0); PG8_BAR; PG8_MMA(0, 0, At, B0); PG8_MMA(0, 1, At, B1); PG8_BAR; PG8_SCHED;
            PG8_LDA(At, 1, 1); PG8_STAGE(PG8_SB(1, 0), b3, voffB); PG8_STAGE(PG8_SB(1, 1), b3 + hstep, voffB); PG8_STAGE(PG8_SA(1, 0), a3, voffA);
            PG8_WAIT_V(8); PG8_WAIT_L(0); PG8_BAR; PG8_MMA(1, 0, At, B0); PG8_MMA(1, 1, At, B1); PG8_BAR; PG8_SCHED;
            } else {
            PG8_LDB(B0, 0, 0); PG8_SCHED; PG8_LDA(At, 0, 0); PG8_STAGE(PG8_SA(1, 1), a1 + hstep, voffA);
            PG8_WAIT_L(8); PG8_BAR; PG8_WAIT_L(0); PG8_MMA(0, 0, At, B0); PG8_BAR; PG8_SCHED;
            PG8_LDB(B1, 0, 1); PG8_STAGE(PG8_SB(0, 0), b2, voffB);
            PG8_BAR; PG8_WAIT_L(0); PG8_MMA(0, 1, At, B1); PG8_BAR;
            PG8_LDA(At, 0, 1); PG8_STAGE(PG8_SA(0, 0), a2, voffA);
            PG8_BAR; PG8_WAIT_L(0); PG8_MMA(1, 0, At, B0); PG8_BAR; PG8_SCHED;
            PG8_STAGE(PG8_SB(0, 1), b2 + hstep, voffB);
            PG8_WAIT_V(6); PG8_BAR; PG8_MMA(1, 1, At, B1); PG8_BAR;
            PG8_LDB(B0, 1, 0); PG8_SCHED; PG8_LDA(At, 1, 0); PG8_STAGE(PG8_SA(0, 1), a2 + hstep, voffA);
            PG8_WAIT_L(8); PG8_BAR; PG8_WAIT_L(0); PG8_MMA(0, 0, At, B0); PG8_BAR; PG8_SCHED;
            PG8_LDB(B1, 1, 1); PG8_STAGE(PG8_SB(1, 0), b3, voffB);
            PG8_BAR; PG8_WAIT_L(0); PG8_MMA(0, 1, At, B1); PG8_BAR;
            PG8_LDA(At, 1, 1); PG8_STAGE(PG8_SA(1, 0), a3, voffA);
            PG8_BAR; PG8_WAIT_L(0); PG8_MMA(1, 0, At, B0); PG8_BAR; PG8_SCHED;
            PG8_STAGE(PG8_SB(1, 1), b3 + hstep, voffB);
            PG8_WAIT_V(6); PG8_BAR; PG8_MMA(1, 1, At, B1); PG8_BAR;
            }
        }
        if constexpr (F8) { asm volatile("s_nop 15\n\ts_nop 7" ::: "memory"); }
        if constexpr (ALIGN_EPI) { if (wr == 0) PG8_BAR; }
        if constexpr (!Epi::AFTER_DRAIN) { E(acc, cur, wr, wc, fr, fq); S.done(cur); }
        if (!has_next) break;
#pragma unroll
        for (int a = 0; a < 2; ++a)
#pragma unroll
            for (int b = 0; b < 2; ++b)
#pragma unroll
                for (int m = 0; m < 4; ++m)
#pragma unroll
                    for (int n = 0; n < 2; ++n) acc[a][b][m][n] = (f32x4){0.f, 0.f, 0.f, 0.f};
        cur = nxt; cA = nA; cB = nB; ++ui;
        if constexpr (ALIGN_EPI) { if (wr == 1) PG8_BAR; }
    }
    PG8_WAIT_V(0);
    if constexpr (!ALIGN_EPI) { if (wr == 0) PG8_BAR; }
    PG8_BAR;
    if constexpr (Epi::AFTER_DRAIN) { E.fused(acc, cur, wr, wc, fr, fq, lds, wid, lane); S.done(cur); }
#undef PG8_SA
#undef PG8_SB
#undef PG8_STAGE
#undef PG8_LDA
#undef PG8_LDB
#undef PG8_MMA
#undef PG8_WAIT_V
#undef PG8_WAIT_L
#undef PG8_BAR
#undef PG8_SCHED
}
}

constexpr int NWAVES = 8;
constexpr int BATCH = 2, SEQ = 8192, D = 1024, M = BATCH * SEQ;
constexpr int NPROJ = 3072, NIN = 3080;
constexpr int AH = 8, NB = 32;
constexpr int C_AQ = 0, C_AK = 512, C_AV = 1024, C_MQ = 1536, C_MK = 1792, C_MV = 2048, C_MO = 2560;
constexpr int MH = 4, MLC = 128, NCH = SEQ / MLC;
constexpr int DFF = 2816, NE = 8, DEX = 3584;
constexpr int MAXT = 136;
constexpr int CAP = 136;
constexpr float LN_EPS = 1e-5f, RMS_EPS = 1e-6f;
constexpr float ALPHA = 1.41421356237309515f;
constexpr float SW_UP = 32.f, SW_DN = 128.f;
constexpr float QSCALE = 0.125f * 1.4426950408889634f;

constexpr size_t MiB = 1u << 20;
constexpr size_t WS_CTL = 0, CTL_ZERO_BYTES = 1 * MiB;
constexpr size_t WS_ROPE = 1 * MiB;
constexpr size_t WS_GATES = 2 * MiB;
constexpr size_t WS_ROWMAP = 2 * MiB + 512 * 1024, WS_ROWW = 2 * MiB + 768 * 1024;
constexpr size_t WS_LIST = 3 * MiB, WS_LISTW = 3 * MiB + 512 * 1024;
constexpr size_t WS_WIN = 4 * MiB, WS_WOUT = 16 * MiB, WS_WGU = 20 * MiB, WS_WD = 31 * MiB;
constexpr size_t WS_MGU = 37 * MiB, WS_MD = 93 * MiB;
constexpr size_t WS_MIX2 = 37 * MiB;
constexpr size_t WS_QC = 37 * MiB, WS_KC = 45 * MiB, WS_DC = 53 * MiB, WS_CST = 69 * MiB, WS_DN = 77 * MiB, WS_NST = 77 * MiB + 256 * 1024, WS_SC = 77 * MiB + 512 * 1024, WS_MC = 77 * MiB + 768 * 1024;
constexpr size_t WS_PO = 80 * MiB, WS_PML = 128 * MiB, WS_SEL = 131 * MiB, WS_LISTQ = 132 * MiB;
constexpr size_t WS_CAT2 = 141 * MiB;
constexpr size_t WS_XB = 205 * MiB, WS_X1B = 237 * MiB, WS_XR = 269 * MiB, WS_PROJ = 333 * MiB, WS_CAT = 429 * MiB;
constexpr size_t WS_X1 = 429 * MiB;
constexpr size_t WS_MIX = 333 * MiB;
constexpr size_t WS_HD = 333 * MiB;
constexpr size_t WS_Y = 205 * MiB, WS_HM = 269 * MiB, WS_XS = 393 * MiB, WS_END = 461 * MiB;
static_assert(WS_HM + (size_t)CAP * 256 * DEX <= WS_XS && WS_XS + (size_t)MAXT * 256 * D <= WS_END, "MoE map");
static_assert(WS_HD + (size_t)M * DFF * 2 <= WS_CAT && WS_WD + (size_t)D * DFF * 2 <= WS_MGU && WS_WGU + (size_t)2 * DFF * D * 2 <= WS_WD, "map");
constexpr int CW_TMO = 0, CW_CODE = 1;
constexpr int CW_BAR = 4096;
constexpr int CW_ECNT = 16384;
constexpr int CW_DBG = 2048;
constexpr int CW_BCNT = 32768;
constexpr int CW_KSUM = 65536;

constexpr int LDS_BYTES = 147456;
constexpr int MISC_OFF = LDS_BYTES - 2048;
constexpr int TEXP_OFF = MISC_OFF + 256;
constexpr int XW_OFF = 100 * 1024;

#define GAS __attribute__((address_space(1)))
#define LAS __attribute__((address_space(3)))
typedef unsigned short bf16;
typedef unsigned v4u __attribute__((ext_vector_type(4)));
typedef unsigned v2u __attribute__((ext_vector_type(2)));
typedef float f32x4 __attribute__((ext_vector_type(4)));
typedef GAS unsigned gu32;
#define RLX_AGENT __ATOMIC_RELAXED, __HIP_MEMORY_SCOPE_AGENT
#define LDS_WAIT() asm volatile("s_waitcnt lgkmcnt(0)" ::: "memory")
#define VM_WAIT() asm volatile("s_waitcnt vmcnt(0)" ::: "memory")
__device__ __forceinline__ unsigned f2bf(float f) { unsigned u = __builtin_bit_cast(unsigned, f); return (u + 0x7fffu + ((u >> 16) & 1u)) >> 16; }
__device__ __forceinline__ unsigned pk2(float lo, float hi) { return f2bf(lo) | (f2bf(hi) << 16); }
__device__ __forceinline__ float bf2f(unsigned short h) { return __builtin_bit_cast(float, (unsigned)h << 16); }
__device__ __forceinline__ float bflo(unsigned w) { return __builtin_bit_cast(float, w << 16); }
__device__ __forceinline__ float bfhi(unsigned w) { return __builtin_bit_cast(float, w & 0xffff0000u); }

#ifdef PROBE_SEG
#define PSEG(id) do { if (blockIdx.x == 0 && threadIdx.x == 0) { LAS unsigned long long* sg_ = (LAS unsigned long long*)(F.lds + MISC_OFF + 1536); const unsigned long long n_ = __builtin_amdgcn_s_memrealtime(); sg_[1 + (id)] += n_ - sg_[0]; sg_[0] = n_; } } while (0)
#else
#define PSEG(id)
#endif
#define XB_TMO      128
#define XB_XCNT(j)  (256  + 64 * (j))
#define XB_XSUB(j)  (1280 + 64 * (j))
#define XB_XGEN(j)  (2304 + 64 * (j))
#define XB_TOP      3328
#define XB_TOPGEN   3392
#define XCD_BAR_WORDS 3456
#define XB_SPIN_CAP (1u << 18)

__device__ __forceinline__ unsigned xb_ld(unsigned* p)              { return __hip_atomic_load(p, __ATOMIC_RELAXED, __HIP_MEMORY_SCOPE_AGENT); }
__device__ __forceinline__ unsigned xb_add(unsigned* p, unsigned v) { return __hip_atomic_fetch_add(p, v, __ATOMIC_RELAXED, __HIP_MEMORY_SCOPE_AGENT); }
__device__ __forceinline__ unsigned xb_xcc_id() { return (unsigned)__builtin_amdgcn_s_getreg((3 << 11) | 20) & 0xFu; }
#define XB_SPIN(cond, bar) do { unsigned _sp = 0; while (cond) { __builtin_amdgcn_s_sleep(1); \
    if ((++_sp & 255u) == 0u) { if (xb_ld(&(bar)[XB_TMO])) break; if (_sp > XB_SPIN_CAP) { atomicAdd(&(bar)[XB_TMO], 1u); break; } } } } while (0)

struct XcdBarrier {
    unsigned* bar; unsigned x;
    volatile LAS unsigned* st;
};

__device__ __forceinline__ XcdBarrier xcd_barrier_post(unsigned* bar, volatile LAS unsigned* st) {
    XcdBarrier b; b.bar = bar; b.x = xb_xcc_id(); b.st = st;
    if (threadIdx.x == 0) (void)xb_add(&bar[XB_XCNT(b.x)], 1u);
    return b;
}
__device__ __forceinline__ void xcd_barrier_complete(unsigned* bar, unsigned x, unsigned& nloc, unsigned& nx) {
    const unsigned G = gridDim.x * gridDim.y * gridDim.z;
    unsigned sum, cnt, mine, sp = 0u;
    for (;;) {
        sum = 0u; cnt = 0u; mine = 0u;
#pragma unroll
        for (unsigned j = 0; j < 16; ++j) { const unsigned c = xb_ld(&bar[XB_XCNT(j)]); sum += c; cnt += (c > 0u) ? 1u : 0u; mine = (j == x) ? c : mine; }
        if (sum == G) break;
        __builtin_amdgcn_s_sleep(1);
        if ((++sp & 255u) == 0u) { if (xb_ld(&bar[XB_TMO])) break; if (sp > XB_SPIN_CAP) { atomicAdd(&bar[XB_TMO], 1u); break; } }
    }
    nloc = mine > 0u ? mine : 1u; nx = cnt > 0u ? cnt : 1u;
}

__device__ __forceinline__ void xcd_barrier(const XcdBarrier& b) {
    asm volatile("s_waitcnt vmcnt(0)" ::: "memory");
    __syncthreads();
    if (threadIdx.x == 0) {
        unsigned* bar = b.bar;
        __builtin_amdgcn_s_waitcnt(0);
        unsigned nloc = b.st[0], nx = b.st[1];
        if (nloc == 0u) { xcd_barrier_complete(bar, b.x, nloc, nx); b.st[0] = nloc; b.st[1] = nx; }
        const unsigned old = xb_add(&bar[XB_XSUB(b.x)], 1u);
        const unsigned gen = old / nloc;
        if (old + 1u == (gen + 1u) * nloc) {
            __builtin_amdgcn_fence(__ATOMIC_RELEASE, "agent");
            asm volatile("s_waitcnt vmcnt(0)" ::: "memory");
            const unsigned og = xb_add(&bar[XB_TOP], 1u);
            const unsigned tg = og / nx;
            if (og + 1u == (tg + 1u) * nx) xb_add(&bar[XB_TOPGEN], 1u);
            else XB_SPIN(xb_ld(&bar[XB_TOPGEN]) == tg, bar);
            __builtin_amdgcn_fence(__ATOMIC_ACQUIRE, "agent");
            xb_add(&bar[XB_XGEN(b.x)], 1u);
            asm volatile("s_waitcnt vmcnt(0)" ::: "memory");
        } else {
            XB_SPIN(xb_ld(&bar[XB_XGEN(b.x)]) == gen, bar);
            __builtin_amdgcn_fence(__ATOMIC_ACQUIRE, "agent");
            asm volatile("s_waitcnt vmcnt(0)" ::: "memory");
        }
    }
    __syncthreads();
}

struct Frame {
    LAS unsigned char* lds;
    volatile LAS unsigned* MISC;
    gu32* ctl;
    int tid, lane, wave;
    int vcu, G;
    unsigned char* ws;
};
__device__ __forceinline__ float wave_sum(float v) {
#pragma unroll
    for (int o = 1; o < 64; o <<= 1) v += __shfl_xor(v, o);
    return v;
}
__device__ __forceinline__ float wave_max(float v) {
#pragma unroll
    for (int o = 1; o < 64; o <<= 1) v = fmaxf(v, __shfl_xor(v, o));
    return v;
}
__device__ __forceinline__ void transpose_item(const float* W, int ldw, int k0, int n0, bf16* WT, int K, int drow0, LAS float* scr, int lane) {
    float tv[32];
#pragma unroll
    for (int i = 0; i < 32; ++i) { const int kk = 2 * i + (lane >> 5); tv[i] = W[(size_t)(k0 + kk) * ldw + n0 + (lane & 31)]; }
#pragma unroll
    for (int i = 0; i < 32; ++i) { const int kk = 2 * i + (lane >> 5); scr[kk * 33 + (lane & 31)] = tv[i]; }
    LDS_WAIT(); asm volatile("" ::: "memory");
    const int c = lane & 7;
#pragma unroll
    for (int j = 0; j < 4; ++j) { const int n = (lane >> 3) + 8 * j; const LAS float* s = scr + (8 * c) * 33 + n;
        v4u o; o.x = pk2(s[0 * 33], s[1 * 33]); o.y = pk2(s[2 * 33], s[3 * 33]); o.z = pk2(s[4 * 33], s[5 * 33]); o.w = pk2(s[6 * 33], s[7 * 33]);
        *(GAS v4u*)(WT + (size_t)(drow0 + n) * K + k0 + 8 * c) = o; }
    LDS_WAIT(); asm volatile("" ::: "memory");
}
__device__ __forceinline__ void cvt_plain(const float* W, int ldw, int coff, int K, int N, bf16* WT, LAS float* scr, int it, int lane) {
    const int nblk = N / 32, kb = it / nblk, nb = it % nblk; transpose_item(W, ldw, 64 * kb, coff + 32 * nb, WT, K, 32 * nb, scr, lane);
}
__device__ __forceinline__ void cvt_gu(const float* Wg, const float* Wu, int K, int N, bf16* WT, LAS float* scr, int it, int lane) {
    const int nblk = N / 32, per = (K / 64) * nblk; const int isu = it >= per; if (isu) it -= per; const int kb = it / nblk, nb = it % nblk, n0 = 32 * nb;
    transpose_item(isu ? Wu : Wg, N, 64 * kb, n0, WT, K, (n0 / 128) * 256 + (n0 % 128) + (isu ? 128 : 0), scr, lane);
}

__device__ __forceinline__ void transpose_item8(const float* W, int ldw, int k0, int n0, unsigned char* WT, int K, int drow0, LAS float* scr, int lane, float sc) {
    float tv[32];
#pragma unroll
    for (int i = 0; i < 32; ++i) { const int kk = 2 * i + (lane >> 5); tv[i] = W[(size_t)(k0 + kk) * ldw + n0 + (lane & 31)]; }
#pragma unroll
    for (int i = 0; i < 32; ++i) { const int kk = 2 * i + (lane >> 5); scr[kk * 33 + (lane & 31)] = tv[i] * sc; }
    LDS_WAIT(); asm volatile("" ::: "memory");
    const int c = lane & 7;
#pragma unroll
    for (int j = 0; j < 4; ++j) { const int n = (lane >> 3) + 8 * j; const LAS float* s = scr + (8 * c) * 33 + n;
        v2u o; o.x = pg8::f8x4(s[0 * 33], s[1 * 33], s[2 * 33], s[3 * 33]); o.y = pg8::f8x4(s[4 * 33], s[5 * 33], s[6 * 33], s[7 * 33]);
        *(GAS v2u*)(WT + (size_t)(drow0 + n) * K + k0 + 8 * c) = o; }
    LDS_WAIT(); asm volatile("" ::: "memory");
}
__device__ __forceinline__ void cvt_plain8(const float* W, int ldw, int coff, int K, int N, unsigned char* WT, LAS float* scr, int it, int lane, float sc) {
    const int nblk = N / 32, kb = it / nblk, nb = it % nblk; transpose_item8(W, ldw, 64 * kb, coff + 32 * nb, WT, K, 32 * nb, scr, lane, sc);
}
__device__ __forceinline__ void cvt_gu8(const float* Wg, const float* Wu, int K, int N, unsigned char* WT, LAS float* scr, int it, int lane, float sc) {
    const int nblk = N / 32, per = (K / 64) * nblk; const int isu = it >= per; if (isu) it -= per; const int kb = it / nblk, nb = it % nblk, n0 = 32 * nb;
    transpose_item8(isu ? Wu : Wg, N, 64 * kb, n0, WT, K, (n0 / 128) * 256 + (n0 % 128) + (isu ? 128 : 0), scr, lane, sc);
}

__device__ __forceinline__ void transpose_item8w(const float* W, int ldw, int k0, int n0, unsigned char* WT, int K, int drow0, LAS float* scr, int lane, float sc) {
#pragma unroll
    for (int hb = 0; hb < 2; ++hb) { float tv[32];
#pragma unroll
        for (int i = 0; i < 32; ++i) tv[i] = W[(size_t)(k0 + 32 * hb + i) * ldw + n0 + lane];
#pragma unroll
        for (int i = 0; i < 32; ++i) scr[(32 * hb + i) * 65 + lane] = tv[i] * sc; }
    LDS_WAIT(); asm volatile("" ::: "memory");
#pragma unroll
    for (int c = 0; c < 4; ++c) { const LAS float* s = scr + (16 * c) * 65 + lane; v4u o;
        o.x = pg8::f8x4(s[0 * 65], s[1 * 65], s[2 * 65], s[3 * 65]); o.y = pg8::f8x4(s[4 * 65], s[5 * 65], s[6 * 65], s[7 * 65]);
        o.z = pg8::f8x4(s[8 * 65], s[9 * 65], s[10 * 65], s[11 * 65]); o.w = pg8::f8x4(s[12 * 65], s[13 * 65], s[14 * 65], s[15 * 65]);
        *(GAS v4u*)(WT + (size_t)(drow0 + lane) * K + k0 + 16 * c) = o; }
    LDS_WAIT(); asm volatile("" ::: "memory");
}
__device__ __forceinline__ void store_row_f8(unsigned char* orow, const f32x4 (&y)[4], int lane) {
    GAS unsigned* o4 = (GAS unsigned*)orow + lane;
#pragma unroll
    for (int j = 0; j < 4; ++j) o4[64 * j] = pg8::f8x4(y[j][0], y[j][1], y[j][2], y[j][3]);
}
__device__ __forceinline__ void stage_xw(Frame& F, const float* W, int ldw, int coff) {
    LAS float* xw = (LAS float*)(F.lds + XW_OFF);
    for (int idx = F.tid; idx < 8192; idx += NWAVES * 64) { const int k = idx >> 3, g = idx & 7; xw[g * 1024 + k] = W[(size_t)k * ldw + coff + g]; }
    LDS_WAIT(); __syncthreads();
}
__device__ __forceinline__ void row_dot8(Frame& F, const f32x4 (&v)[4], float (&acc)[8]) {
    const LAS f32x4* xw = (const LAS f32x4*)(F.lds + XW_OFF);
#pragma unroll
    for (int g = 0; g < 8; ++g) { float a = 0.f;
#pragma unroll
        for (int j = 0; j < 4; ++j) { const f32x4 w = xw[g * 256 + j * 64 + F.lane]; a += v[j][0] * w[0] + v[j][1] * w[1] + v[j][2] * w[2] + v[j][3] * w[3]; }
        acc[g] = wave_sum(a); }
}
__device__ __forceinline__ float log_sigmoid(float x) { return fminf(x, 0.f) - log1pf(expf(-fabsf(x))); }
__device__ __forceinline__ void store_row_bf16(bf16* orow, const f32x4 (&y)[4], int lane) {
    GAS unsigned long long* o8 = (GAS unsigned long long*)orow + lane;
#pragma unroll
    for (int j = 0; j < 4; ++j) o8[64 * j] = (unsigned long long)pk2(y[j][0], y[j][1]) | ((unsigned long long)pk2(y[j][2], y[j][3]) << 32);
}
__device__ __forceinline__ void write_gates(Frame& F, const f32x4 (&y)[4], const float* gbias, float* grow) {
    float a[8]; row_dot8(F, y, a);
    if (F.lane < 8) { float r = 0.f;
#pragma unroll
        for (int g = 0; g < 8; ++g) if (F.lane == g) r = a[g];
        r += gbias[F.lane]; if (F.lane >= 4) r = log_sigmoid(r); grow[F.lane] = r; }
}
struct In {
    const float* x; const int* pos; const float *w_in, *gate_bias, *conv_w, *conv_b, *norm_attn, *norm_ml, *w_out, *ln1_g, *ln1_b, *dg, *du, *dd, *router_w, *router_b, *mg, *mu, *md, *ln2_g, *ln2_b;
};
__device__ __forceinline__ void p_prologue(Frame& F, const In& I) {
    unsigned char* ws = F.ws;
    stage_xw(F, I.w_in, NIN, NPROJ);
    LAS float* scr = (LAS float*)(F.lds + F.wave * 8704);
    const int gw = F.vcu * NWAVES + F.wave, NGW = F.G * NWAVES;
    constexpr int I_IN = (D / 64) * (NPROJ / 32), I_OUT = (D / 64) * (D / 32), I_GU = 2 * (D / 64) * (DFF / 32), I_DD = (DFF / 64) * (D / 32);
    constexpr int NITEMS = 2 * I_IN + 2 * I_OUT + I_GU + I_DD;
    for (int it = gw; it < NITEMS; it += NGW) {
        int r = it;
        if (r < 2 * I_IN) { const int l = r / I_IN; r -= l * I_IN; cvt_plain(I.w_in + (size_t)l * D * NIN, NIN, 0, D, NPROJ, (bf16*)(ws + WS_WIN) + (size_t)l * NPROJ * D, scr, r, F.lane); continue; } r -= 2 * I_IN;
        if (r < 2 * I_OUT) { const int l = r / I_OUT; r -= l * I_OUT; cvt_plain(I.w_out + (size_t)l * D * D, D, 0, D, D, (bf16*)(ws + WS_WOUT) + (size_t)l * D * D, scr, r, F.lane); continue; } r -= 2 * I_OUT;
        if (r < I_GU) { cvt_gu8(I.dg, I.du, D, DFF, ws + WS_WGU, scr, r, F.lane, SW_UP); continue; } r -= I_GU;
        cvt_plain8(I.dd, D, 0, DFF, D, ws + WS_WD, scr, r, F.lane, SW_DN);
    }
    for (int e = blockIdx.x * (NWAVES * 64) + F.tid; e < M * 8; e += F.G * NWAVES * 64) { const int row = e >> 3, i = e & 7;
        const float inv = powf(500000.0f, -(float)i / 8.0f); const float ang = (float)I.pos[row] * inv; float s, c; sincosf(ang, &s, &c);
        float* rp = (float*)(ws + WS_ROPE) + (size_t)row * 16; rp[i] = c; rp[8 + i] = s; }
    for (int m = gw; m < M; m += NGW) { const GAS f32x4* xr = (const GAS f32x4*)(I.x + (size_t)m * D) + F.lane; f32x4 v[4];
#pragma unroll
        for (int j = 0; j < 4; ++j) v[j] = xr[64 * j];
        store_row_bf16((bf16*)(ws + WS_XB) + (size_t)m * D, v, F.lane);
        write_gates(F, v, I.gate_bias, (float*)(ws + WS_GATES) + (size_t)m * 8); }
}
__device__ __forceinline__ f32x4 ld_bf16x4(const bf16* p) { const v2u w = *(const GAS v2u*)p; return (f32x4){bflo(w.x), bfhi(w.x), bflo(w.y), bfhi(w.y)}; }
template <bool RESF, bool ADD2, int EXTRA>
__device__ __forceinline__ void ln_phase(Frame& F, const float* resf, const bf16* resb, const bf16* y0, const bf16* y1, const float* g, const float* bt, float* outf, bf16* outb, unsigned char* out8,
                                         const float* xbias, float* gates_out, int* list, float* listw, float oscale) {
    const int gw = F.vcu * NWAVES + F.wave, NGW = F.G * NWAVES;
    f32x4 gv[4], bv[4];
#pragma unroll
    for (int j = 0; j < 4; ++j) { gv[j] = ((const GAS f32x4*)g)[64 * j + F.lane]; bv[j] = ((const GAS f32x4*)bt)[64 * j + F.lane]; }
    for (int m = gw; m < M; m += NGW) {
        f32x4 v[4]; float s = 0.f;
#pragma unroll
        for (int j = 0; j < 4; ++j) { const size_t o = (size_t)m * D + 256 * j + 4 * F.lane;
            const f32x4 r = RESF ? *(const GAS f32x4*)(resf + o) : ld_bf16x4(resb + o); f32x4 a = ld_bf16x4(y0 + o); if (ADD2) a = a + ld_bf16x4(y1 + o);
            v[j] = r * ALPHA + a; }
#pragma unroll
        for (int j = 0; j < 4; ++j) s += (v[j][0] + v[j][1]) + (v[j][2] + v[j][3]);
        const float mean = wave_sum(s) * (1.f / D); float s2 = 0.f;
#pragma unroll
        for (int j = 0; j < 4; ++j) { v[j] = v[j] - mean; s2 += (v[j][0] * v[j][0] + v[j][1] * v[j][1]) + (v[j][2] * v[j][2] + v[j][3] * v[j][3]); }
        const float rstd = 1.f / sqrtf(wave_sum(s2) * (1.f / D) + LN_EPS);
#pragma unroll
        for (int j = 0; j < 4; ++j) v[j] = (v[j] * rstd * gv[j] + bv[j]) * oscale;
        if (outf) { GAS f32x4* of = (GAS f32x4*)(outf + (size_t)m * D) + F.lane;
#pragma unroll
            for (int j = 0; j < 4; ++j) of[64 * j] = v[j]; }
        if (outb) store_row_bf16(outb + (size_t)m * D, v, F.lane);
        if (out8) store_row_f8(out8 + (size_t)m * D, v, F.lane);
        if (EXTRA == 1) write_gates(F, v, xbias, gates_out + (size_t)m * 8);
        if (EXTRA == 2) { float a[8]; row_dot8(F, v, a);
#pragma unroll
            for (int e = 0; e < 8; ++e) a[e] += xbias[e];
            int i0 = 0; float v0 = a[0];
#pragma unroll
            for (int e = 1; e < 8; ++e) if (a[e] > v0) { v0 = a[e]; i0 = e; }
            int i1 = -1; float v1 = -INFINITY;
#pragma unroll
            for (int e = 0; e < 8; ++e) if (e != i0 && a[e] > v1) { v1 = a[e]; i1 = e; }
            const float w1 = 1.f / (1.f + expf(v0 - v1)), w0 = 1.f - w1;
            if (F.lane < 2) { const int e = F.lane ? i1 : i0; const float w = F.lane ? w1 : w0;
                const unsigned p = __hip_atomic_fetch_add((unsigned*)(F.ctl + CW_ECNT + 64 * e), 1u, RLX_AGENT);
                list[(size_t)e * M + p] = m * 2 + F.lane; listw[(size_t)e * M + p] = w; } }
    }
}
__device__ __forceinline__ int moe_plan(Frame& F) {
    LAS int* texp = (LAS int*)(F.lds + TEXP_OFF);
    if (F.tid == 0) { int t = 0;
        for (int e = 0; e < NE; ++e) { const int c = (int)__hip_atomic_load((unsigned*)(F.ctl + CW_ECNT + 64 * e), RLX_AGENT); const int nt = (c + 255) >> 8; texp[MAXT + 1 + e] = t * 256;
            for (int k = 0; k < nt && t < MAXT; ++k) texp[t++] = e; }
        texp[MAXT] = t; }
    LDS_WAIT(); __syncthreads();
    return texp[MAXT];
}
__device__ __forceinline__ void moe_gather(Frame& F, int ntiles, const unsigned char* X1B, unsigned char* XS, const int* list, const float* listw, int* rowmap, float* roww) {
    const LAS int* texp = (const LAS int*)(F.lds + TEXP_OFF);
    const int gw = F.vcu * NWAVES + F.wave, NGW = F.G * NWAVES;
    for (int r0 = gw; r0 < ntiles * 256; r0 += 4 * NGW) {
        int ts[4]; float w[4]; v4u a[4];
#pragma unroll
        for (int q = 0; q < 4; ++q) { const int r = r0 + q * NGW; ts[q] = -1; w[q] = 0.f;
            if (r < ntiles * 256) { const int e = texp[r >> 8], i = r - texp[MAXT + 1 + e]; const int c = (int)__hip_atomic_load((unsigned*)(F.ctl + CW_ECNT + 64 * e), RLX_AGENT);
                if (i < c) { ts[q] = list[(size_t)e * M + i]; w[q] = listw[(size_t)e * M + i]; } } }
#pragma unroll
        for (int q = 0; q < 4; ++q) { a[q] = (v4u){0u, 0u, 0u, 0u}; if (ts[q] >= 0) a[q] = ((const GAS v4u*)(X1B + (size_t)(ts[q] >> 1) * D))[F.lane]; }
#pragma unroll
        for (int q = 0; q < 4; ++q) { const int r = r0 + q * NGW;
            if (r < ntiles * 256) { ((GAS v4u*)(XS + (size_t)r * D))[F.lane] = a[q]; if (F.lane == 0) { rowmap[r] = ts[q]; roww[r] = w[q]; } } } }
}
__device__ __forceinline__ void moe_cvt(Frame& F, const In& I) {
    LAS float* scr = (LAS float*)(F.lds + F.wave * 16640);
    const int gw = F.vcu * NWAVES + F.wave, NGW = F.G * NWAVES;
    constexpr int NBU = DEX / 64, I_G = (D / 64) * NBU, I_GU = 2 * I_G, I_DD = (DEX / 64) * (D / 64), PER = I_GU + I_DD;
    for (int it = gw; it < NE * PER; it += NGW) { const int e = it / PER; int r = it - e * PER;
        if (r < I_GU) { const int isu = r >= I_G; if (isu) r -= I_G; const int kb = r / NBU, nb = r % NBU, n0 = 64 * nb;
            transpose_item8w((isu ? I.mu : I.mg) + (size_t)e * D * DEX, DEX, 64 * kb, n0, F.ws + WS_MGU + (size_t)e * 2 * DEX * D, D, (n0 / 128) * 256 + (n0 % 128) + (isu ? 128 : 0), scr, F.lane, SW_UP); }
        else { r -= I_GU; const int kb = r / (D / 64), nb = r % (D / 64);
            transpose_item8w(I.md + (size_t)e * DEX * D, D, 64 * kb, 64 * nb, F.ws + WS_MD + (size_t)e * D * DEX, DEX, 64 * nb, scr, F.lane, SW_DN); } }
}

__device__ __forceinline__ float dot64_bf16(const LAS float* qs, const bf16* kr) {
    const GAS v4u* kp = (const GAS v4u*)kr; float a = 0.f;
#pragma unroll
    for (int c = 0; c < 8; ++c) { const v4u w = kp[c]; const LAS f32x4* q4 = (const LAS f32x4*)(qs + 8 * c); const f32x4 qa = q4[0], qb = q4[1];
        a += qa[0] * bflo(w.x) + qa[1] * bfhi(w.x) + qa[2] * bflo(w.y) + qa[3] * bfhi(w.y) + qb[0] * bflo(w.z) + qb[1] * bfhi(w.z) + qb[2] * bflo(w.w) + qb[3] * bfhi(w.w); }
    return a;
}
__device__ __forceinline__ void attn_naive(Frame& F, const bf16* PROJ, const float* ksum, const float* norm_attn, bf16* CAT, int w_lo, int w_n) {
    LAS float* qs = (LAS float*)(F.lds + F.wave * 4608); LAS float* ps = qs + 64;
    const int lane = F.lane; const int gwa = F.vcu * NWAVES + F.wave - w_lo;
    if (gwa < 0) return;
    for (int task = gwa; task < M * AH; task += w_n) {
        const int bh = task >> 13, t = task & 8191, b = bh >> 3, h = bh & 7; const size_t row = (size_t)b * SEQ + t; const int blk = t >> 8;
        qs[lane] = bf2f(PROJ[row * NPROJ + C_AQ + h * 64 + lane]); LDS_WAIT();
        float g = -INFINITY;
        if (lane < blk) { const float* km = ksum + ((size_t)(b * NB + lane) * 512 + h * 64); float a = 0.f;
            for (int d = 0; d < 64; ++d) a += qs[d] * km[d];
            g = a; }
        int sel[3];
#pragma unroll
        for (int k = 0; k < 3; ++k) { float v = g; int idx = lane;
#pragma unroll
            for (int o = 1; o < 64; o <<= 1) { const float ov = __shfl_xor(v, o); const int oi = __shfl_xor(idx, o); if (ov > v || (ov == v && oi < idx)) { v = ov; idx = oi; } }
            idx = __builtin_amdgcn_readfirstlane(idx); const bool ok = __builtin_amdgcn_readfirstlane(v > -INFINITY ? 1 : 0) != 0;
            sel[k] = ok ? idx : -1; if (lane == idx) g = -INFINITY; }
        float sc[4][4]; float mx = -INFINITY;
#pragma unroll
        for (int s = 0; s < 4; ++s) { const int jb = (s < 3) ? sel[s] : blk;
#pragma unroll
            for (int i = 0; i < 4; ++i) { float a = -INFINITY;
                if (jb >= 0) { const int kp = jb * 256 + i * 64 + lane; if (s < 3 || kp <= t) a = dot64_bf16(qs, PROJ + ((size_t)b * SEQ + kp) * NPROJ + C_AK + h * 64); }
                sc[s][i] = a; mx = fmaxf(mx, a); } }
        mx = wave_max(mx); float sum = 0.f;
#pragma unroll
        for (int s = 0; s < 4; ++s)
#pragma unroll
            for (int i = 0; i < 4; ++i) { const float p = __builtin_amdgcn_exp2f(sc[s][i] - mx); sum += p; ps[s * 256 + i * 64 + lane] = p; }
        sum = wave_sum(sum); LDS_WAIT();
        float o = 0.f;
#pragma unroll
        for (int s = 0; s < 4; ++s) { const int jb = (s < 3) ? sel[s] : blk; if (jb < 0) continue; const int kmax = (s < 3) ? 256 : (t - blk * 256 + 1);
            const bf16* vb = PROJ + ((size_t)b * SEQ + jb * 256) * NPROJ + C_AV + h * 64 + lane;
#pragma unroll 8
            for (int k = 0; k < kmax; ++k) o += ps[s * 256 + k] * bf2f(vb[(size_t)k * NPROJ]); }
        o = o / sum; const float ms = wave_sum(o * o) * (1.f / 64.f);
        o = o * (1.f / sqrtf(ms + RMS_EPS)) * norm_attn[h * 64 + lane];
        CAT[row * D + h * 64 + lane] = (bf16)f2bf(o);
        LDS_WAIT();
    }
}
__device__ __forceinline__ void mlstm_naive(Frame& F, int bh, const bf16* PROJ, const float* GATES, const float* conv_w, const float* conv_b, const float* norm_ml, bf16* CAT) {
    const int b = bh >> 2, h = bh & 3, tid = F.tid;
    LAS float* Cst = (LAS float*)(F.lds);
    LAS float* nst = (LAS float*)(F.lds + 33280);
    LAS float* qf = (LAS float*)(F.lds + 33792);
    LAS float* kf = (LAS float*)(F.lds + 67072);
    LAS bf16* vb = (LAS bf16*)(F.lds + 100352);
    LAS float* bs = (LAS float*)(F.lds + 133120);
    LAS float* ig = bs + 128;
    LAS float* mt = bs + 256;
    LAS float* wst = bs + 384;
    LAS float* scal = bs + 512;
    for (int e = tid; e < 128 * 65; e += 512) Cst[e] = 0.f;
    if (tid < 64) nst[tid] = 0.f;
    if (tid == 0) scal[0] = 0.f;
    __syncthreads();
    for (int c = 0; c < NCH; ++c) {
        const size_t row0 = (size_t)b * SEQ + (size_t)c * MLC;
        if (tid < 128) { ig[tid] = GATES[(row0 + tid) * 8 + h]; bs[tid] = GATES[(row0 + tid) * 8 + 4 + h]; }
        for (int e = tid; e < 128 * 128; e += 512) { const int t = e >> 7, cc = e & 127; const int isk = cc >> 6, d = cc & 63; const int ch = isk * 256 + h * 64 + d;
            float a = conv_b[ch];
#pragma unroll
            for (int j = 0; j < 4; ++j) { const int tt = c * MLC + t - 3 + j; if (tt >= 0) a += conv_w[j * 512 + ch] * bf2f(PROJ[((size_t)b * SEQ + tt) * NPROJ + C_MQ + ch]); }
            a = a / (1.f + expf(-a));
            if (isk) kf[t * 65 + d] = a; else qf[t * 65 + d] = a * 0.125f; }
        for (int e = tid; e < 128 * 128; e += 512) { const int t = e >> 7, vv = e & 127; vb[t * 128 + vv] = PROJ[(row0 + t) * NPROJ + C_MV + h * 128 + vv]; }
        __syncthreads();
        if (tid == 0) { const float mc = scal[0]; float run = 0.f, cm = -INFINITY;
            for (int t = 0; t < 128; ++t) { run += bs[t]; bs[t] = run; cm = fmaxf(cm, ig[t] - run); mt[t] = run + fmaxf(mc, cm); }
            const float bl = run; const float mnew = fmaxf(bl + mc, bl + cm); scal[1] = mnew; scal[2] = bl; }
        __syncthreads();
        if (tid < 128) wst[tid] = expf(scal[2] - bs[tid] + ig[tid] - scal[1]);
#pragma unroll 1
        for (int pass = 0; pass < 2; ++pass) {
            const int t = pass * 64 + (tid >> 3), vq = tid & 7; const float mc = scal[0]; const float bt = bs[t], mtt = mt[t];
            float q[64];
#pragma unroll
            for (int d = 0; d < 64; ++d) q[d] = qf[t * 65 + d];
            float num[16]; float den = 0.f;
#pragma unroll
            for (int j = 0; j < 16; ++j) num[j] = 0.f;
            const int tmax = pass * 64 + ((tid >> 6) << 3) + 7;
#pragma unroll 1
            for (int s = 0; s <= tmax; ++s) { if (s <= t) { float dot = 0.f;
#pragma unroll
                    for (int d = 0; d < 64; ++d) dot += q[d] * kf[s * 65 + d];
                    const float sw = dot * expf(bt - bs[s] + ig[s] - mtt); den += sw;
#pragma unroll
                    for (int j = 0; j < 16; ++j) num[j] += sw * bf2f(vb[s * 128 + vq * 16 + j]); } }
            const float wi = expf(bt + mc - mtt); float nq = 0.f;
#pragma unroll
            for (int d = 0; d < 64; ++d) nq += nst[d] * q[d];
            den += wi * nq;
            { float cq[16];
#pragma unroll
              for (int j = 0; j < 16; ++j) cq[j] = 0.f;
#pragma unroll 1
              for (int d = 0; d < 64; ++d) { const float qd = qf[t * 65 + d]; const LAS float* cr = Cst + (vq * 16) * 65 + d;
#pragma unroll
                  for (int j = 0; j < 16; ++j) cq[j] += cr[j * 65] * qd; }
#pragma unroll
              for (int j = 0; j < 16; ++j) num[j] += wi * cq[j]; }
            const float dn = 1.f / fmaxf(fabsf(den), expf(-mtt)); float ss = 0.f;
#pragma unroll
            for (int j = 0; j < 16; ++j) { num[j] *= dn; ss += num[j] * num[j]; }
            ss += __shfl_xor(ss, 1); ss += __shfl_xor(ss, 2); ss += __shfl_xor(ss, 4);
            const float rs = 1.f / sqrtf(ss * (1.f / 128.f) + RMS_EPS);
            const size_t row = row0 + t; const bf16* mo = PROJ + row * NPROJ + C_MO + h * 128 + vq * 16; bf16* out = CAT + row * D + 512 + h * 128 + vq * 16; const float* gn = norm_ml + h * 128 + vq * 16;
#pragma unroll
            for (int j = 0; j < 16; ++j) { const float o = bf2f(mo[j]); out[j] = (bf16)f2bf(num[j] * rs * gn[j] / (1.f + expf(-o))); }
        }
        __syncthreads();
        {
            const float cs = expf(scal[2] + scal[0] - scal[1]);
            for (int e = tid; e < 128 * 64; e += 512) { const int vv = e >> 6, d = e & 63; float a = 0.f;
                for (int s = 0; s < 128; ++s) a += wst[s] * bf2f(vb[s * 128 + vv]) * kf[s * 65 + d];
                Cst[vv * 65 + d] = cs * Cst[vv * 65 + d] + a; }
            if (tid < 64) { float a = 0.f; for (int s = 0; s < 128; ++s) a += wst[s] * kf[s * 65 + tid]; nst[tid] = cs * nst[tid] + a; }
        }
        __syncthreads();
        if (tid == 0) scal[0] = scal[1];
        __syncthreads();
    }
}

typedef short bf16x8_t __attribute__((ext_vector_type(8)));
#define MFMA16(a, b, c) __builtin_amdgcn_mfma_f32_16x16x32_bf16((a), (b), (c), 0, 0, 0)
__device__ __forceinline__ float wave_incl_sum(float v, int lane) {
#pragma unroll
    for (int o = 1; o < 64; o <<= 1) { const float y = __shfl_up(v, o); if (lane >= o) v += y; }
    return v;
}
__device__ __forceinline__ float wave_incl_max(float v, int lane) {
#pragma unroll
    for (int o = 1; o < 64; o <<= 1) { const float y = __shfl_up(v, o); if (lane >= o) v = fmaxf(v, y); }
    return v;
}
__device__ __forceinline__ float fexp(float x) { return __builtin_amdgcn_exp2f(x * 1.4426950408889634f); }
__device__ __forceinline__ float fsigm(float x) { return __builtin_amdgcn_rcpf(1.f + __builtin_amdgcn_exp2f(-1.4426950408889634f * x)); }
struct MlBufs { bf16* QC; bf16* KC; float* DC; bf16* CST; float* DN; float* NST; float* SC; float* MC; };
constexpr int ML_KW = 0, ML_VT = 18432, ML_ARR = 55296;
constexpr int MC_QS = 0, MC_KS = 18432, MC_VT = 36864, MC_CM = 76032, MC_SS = 96768, MC_ARR = 131584;

typedef short v4i16m_t __attribute__((ext_vector_type(4)));
__device__ __forceinline__ bf16x8_t tr8(const LAS bf16* p0, const LAS bf16* p1) {
    const v4i16m_t lo = __builtin_amdgcn_ds_read_tr16_b64_v4i16((LAS v4i16m_t*)p0), hi = __builtin_amdgcn_ds_read_tr16_b64_v4i16((LAS v4i16m_t*)p1);
    return (bf16x8_t){lo[0], lo[1], lo[2], lo[3], hi[0], hi[1], hi[2], hi[3]};
}
template <bool ONES>
__device__ __forceinline__ void ml_stage_v(Frame& F, const bf16* PROJ, size_t row0, int h, LAS bf16* VR) {
#pragma unroll
    for (int e = F.tid; e < 128 * 16; e += NWAVES * 64) { const int t = e >> 4, v0 = (e & 15) * 8;
        *(LAS v4u*)(VR + t * 144 + v0) = *(const GAS v4u*)(PROJ + (row0 + t) * NPROJ + C_MV + h * 128 + v0); }
    if (ONES) { for (int e = F.tid; e < 128 * 2; e += NWAVES * 64) { const int t = e >> 1, hf = e & 1; *(LAS v4u*)(VR + t * 144 + 128 + 8 * hf) = (v4u){hf ? 0u : 0x3f80u, 0u, 0u, 0u}; } }
}
__device__ __forceinline__ void ml_phase_a(Frame& F, int unit, const bf16* PROJ, const float* GATES, const float* conv_w, const float* conv_b, const MlBufs& B) {
    const int bh = unit >> 6, c = unit & 63, b = bh >> 2, h = bh & 3, tid = F.tid, lane = F.lane;
    const size_t row0 = (size_t)b * SEQ + (size_t)c * MLC;
    LAS bf16* KW = (LAS bf16*)(F.lds + ML_KW); LAS bf16* VT = (LAS bf16*)(F.lds + ML_VT);
    LAS float* wst = (LAS float*)(F.lds + ML_ARR);
    PSEG(0);
    if (F.wave == 0) {
        const float i0 = GATES[(row0 + 2 * lane) * 8 + h], i1 = GATES[(row0 + 2 * lane + 1) * 8 + h], f0 = GATES[(row0 + 2 * lane) * 8 + 4 + h], f1 = GATES[(row0 + 2 * lane + 1) * 8 + 4 + h];
        const float tot = wave_incl_sum(f0 + f1, lane); const float b0 = tot - f1, b1 = tot;
        const float a0 = i0 - b0, a1 = i1 - b1; const float amax = wave_max(fmaxf(a0, a1)); const float bl = __shfl(b1, 63);
        wst[2 * lane] = expf(a0 - amax); wst[2 * lane + 1] = expf(a1 - amax);
        if (lane == 0) { B.SC[unit * 2] = bl + amax; B.SC[unit * 2 + 1] = bl; }
    }
    LDS_WAIT(); __syncthreads(); PSEG(1);
    {   const int g8 = tid & 15, isk = g8 >> 3, d0 = (g8 & 7) * 8; const int ch = isk * 256 + h * 64 + d0;
        f32x4 cw[4][2], cb[2];
#pragma unroll
        for (int j = 0; j < 4; ++j) { cw[j][0] = *(const GAS f32x4*)(conv_w + j * 512 + ch); cw[j][1] = *(const GAS f32x4*)(conv_w + j * 512 + ch + 4); }
        cb[0] = *(const GAS f32x4*)(conv_b + ch); cb[1] = *(const GAS f32x4*)(conv_b + ch + 4);
        v4u xin[4][4];
#pragma unroll
        for (int i = 0; i < 4; ++i)
#pragma unroll
            for (int j = 0; j < 4; ++j) { const int t = (tid >> 4) + 32 * i; const int tt = c * MLC + t - 3 + j;
                xin[i][j] = (tt >= 0) ? *(const GAS v4u*)(PROJ + ((size_t)b * SEQ + tt) * NPROJ + C_MQ + ch) : (v4u){0u, 0u, 0u, 0u}; }
#pragma unroll
        for (int i = 0; i < 4; ++i) { const int t = (tid >> 4) + 32 * i;
            float a[8];
#pragma unroll
            for (int e = 0; e < 4; ++e) { a[e] = cb[0][e]; a[4 + e] = cb[1][e]; }
#pragma unroll
            for (int j = 0; j < 4; ++j) { const v4u w = xin[i][j]; const f32x4 w0 = cw[j][0], w1 = cw[j][1];
                a[0] += w0[0] * bflo(w.x); a[1] += w0[1] * bfhi(w.x); a[2] += w0[2] * bflo(w.y); a[3] += w0[3] * bfhi(w.y); a[4] += w1[0] * bflo(w.z); a[5] += w1[1] * bfhi(w.z); a[6] += w1[2] * bflo(w.w); a[7] += w1[3] * bfhi(w.w); }
#pragma unroll
            for (int e = 0; e < 8; ++e) a[e] = a[e] * fsigm(a[e]);
            if (isk) { v4u o; o.x = pk2(a[0], a[1]); o.y = pk2(a[2], a[3]); o.z = pk2(a[4], a[5]); o.w = pk2(a[6], a[7]); *(GAS v4u*)(B.KC + (row0 + t) * 256 + h * 64 + d0) = o;
                const float ws = wst[t];
                v4u kw; kw.x = pk2(a[0] * ws, a[1] * ws); kw.y = pk2(a[2] * ws, a[3] * ws); kw.z = pk2(a[4] * ws, a[5] * ws); kw.w = pk2(a[6] * ws, a[7] * ws);
                *(LAS v4u*)(KW + t * 72 + d0) = kw;
            } else { v4u o; o.x = pk2(a[0] * 0.125f, a[1] * 0.125f); o.y = pk2(a[2] * 0.125f, a[3] * 0.125f); o.z = pk2(a[4] * 0.125f, a[5] * 0.125f); o.w = pk2(a[6] * 0.125f, a[7] * 0.125f);
                *(GAS v4u*)(B.QC + (row0 + t) * 256 + h * 64 + d0) = o; } }
    }
    ml_stage_v<false>(F, PROJ, row0, h, VT);
    LDS_WAIT(); __syncthreads(); PSEG(2);
    {
        const int w = F.wave, r = lane & 15, q4 = lane >> 4; f32x4 acc[4];
#pragma unroll
        for (int nt = 0; nt < 4; ++nt) acc[nt] = (f32x4){0.f, 0.f, 0.f, 0.f};
#pragma unroll
        for (int ks = 0; ks < 4; ++ks) { const int trow = 32 * ks + 8 * q4 + (r >> 2), pc = 4 * (r & 3);
            const bf16x8_t a = tr8(VT + trow * 144 + 16 * w + pc, VT + (trow + 4) * 144 + 16 * w + pc);
#pragma unroll
            for (int nt = 0; nt < 4; ++nt) { const bf16x8_t bb = tr8(KW + trow * 72 + 16 * nt + pc, KW + (trow + 4) * 72 + 16 * nt + pc); acc[nt] = MFMA16(a, bb, acc[nt]); } }
        float* dc = B.DC + (size_t)unit * 8192;
#pragma unroll
        for (int nt = 0; nt < 4; ++nt)
#pragma unroll
            for (int j = 0; j < 4; ++j) dc[(16 * w + 4 * q4 + j) * 64 + 16 * nt + r] = acc[nt][j];
        if (tid < 64) { float s = 0.f; for (int t = 0; t < 128; ++t) s += bf2f(KW[t * 72 + tid]); B.DN[unit * 64 + tid] = s; }
    }
    LDS_WAIT(); __syncthreads(); PSEG(3);
}
__device__ __forceinline__ void ml_phase_b(Frame& F, int u, const MlBufs& B) {
    const int bh = u >> 5, eb = (u & 31) * 256, tid = F.tid;
    LAS float* sC = (LAS float*)(F.lds); LAS float* sD = sC + 64;
    LAS float* scl = sD + 64;
    if (tid < 128) scl[tid] = B.SC[bh * 128 + tid];
    LDS_WAIT(); __syncthreads();
    if (F.wave == 0) {
        const int c = F.lane; const float ac = scl[c * 2], bl = scl[c * 2 + 1]; float A = bl, Bm = ac;
#pragma unroll
        for (int o = 1; o < 64; o <<= 1) { const float Ap = __shfl_up(A, o), Bp = __shfl_up(Bm, o); if (c >= o) { Bm = fmaxf(Bm, A + Bp); A = A + Ap; } }
        const float mn = fmaxf(Bm, A); const float mp = __shfl_up(mn, 1); const float me = (c == 0) ? 0.f : mp;
        sC[c] = fexp(bl + me - mn); sD[c] = fexp(ac - mn); if ((u & 31) == 0) B.MC[bh * 64 + c] = me; }
    LDS_WAIT(); __syncthreads();
    if (tid < 256) { float C = 0.f; const float* dc = B.DC + (size_t)bh * 64 * 8192 + eb + tid; bf16* cs = B.CST + (size_t)bh * 64 * 8192 + eb + tid;
        float dv[64];
#pragma unroll
        for (int c = 0; c < 64; ++c) dv[c] = dc[(size_t)c * 8192];
#pragma unroll
        for (int c = 0; c < 64; ++c) { cs[(size_t)c * 8192] = (bf16)f2bf(C); C = sC[c] * C + sD[c] * dv[c]; } }
    else if (tid < 320 && (u & 31) == 0) { const int d = tid - 256; float n = 0.f;
        for (int c = 0; c < 64; ++c) { B.NST[(bh * 64 + c) * 64 + d] = n; n = sC[c] * n + sD[c] * B.DN[(bh * 64 + c) * 64 + d]; } }
    __syncthreads();
}
__device__ __forceinline__ void ml_phase_c(Frame& F, int unit, const bf16* PROJ, const float* GATES, const float* norm_ml, bf16* CAT, const MlBufs& B) {
    const int bh = unit >> 6, c = unit & 63, b = bh >> 2, h = bh & 3, tid = F.tid, lane = F.lane;
    const size_t row0 = (size_t)b * SEQ + (size_t)c * MLC;
    LAS bf16* QS = (LAS bf16*)(F.lds + MC_QS); LAS bf16* KS = (LAS bf16*)(F.lds + MC_KS); LAS bf16* VT = (LAS bf16*)(F.lds + MC_VT); LAS bf16* CM = (LAS bf16*)(F.lds + MC_CM); LAS bf16* SS = (LAS bf16*)(F.lds + MC_SS);
    LAS float* aa = (LAS float*)(F.lds + MC_ARR); LAS float* rt = aa + 128; LAS float* wint = aa + 256; LAS float* emt = aa + 384;
    if (F.wave == 0) {
        const float mc = B.MC[unit];
        const float i0 = GATES[(row0 + 2 * lane) * 8 + h], i1 = GATES[(row0 + 2 * lane + 1) * 8 + h], f0 = GATES[(row0 + 2 * lane) * 8 + 4 + h], f1 = GATES[(row0 + 2 * lane + 1) * 8 + 4 + h];
        const float tot = wave_incl_sum(f0 + f1, lane); const float b0 = tot - f1, b1 = tot;
        const float a0 = i0 - b0, a1 = i1 - b1; const float cmx = wave_incl_max(fmaxf(a0, a1), lane); const float cmprev = __shfl_up(cmx, 1);
        const float cm0 = (lane == 0) ? a0 : fmaxf(cmprev, a0), cm1 = cmx;
        const float mt0 = b0 + fmaxf(mc, cm0), mt1 = b1 + fmaxf(mc, cm1);
        aa[2 * lane] = a0; aa[2 * lane + 1] = a1; rt[2 * lane] = b0 - mt0; rt[2 * lane + 1] = b1 - mt1;
        wint[2 * lane] = expf(b0 + mc - mt0); wint[2 * lane + 1] = expf(b1 + mc - mt1); emt[2 * lane] = expf(-mt0); emt[2 * lane + 1] = expf(-mt1);
    }
#pragma unroll
    for (int e = tid; e < 128 * 8; e += NWAVES * 64) { const int t = e >> 3, ch = (e & 7) * 8;
        *(LAS v4u*)(QS + t * 72 + ch) = *(const GAS v4u*)(B.QC + (row0 + t) * 256 + h * 64 + ch);
        *(LAS v4u*)(KS + t * 72 + ch) = *(const GAS v4u*)(B.KC + (row0 + t) * 256 + h * 64 + ch);
        *(LAS v4u*)(CM + t * 72 + ch) = *(const GAS v4u*)(B.CST + (size_t)unit * 8192 + t * 64 + ch); }
    ml_stage_v<true>(F, PROJ, row0, h, VT);
    for (int e = tid; e < 16 * 64; e += NWAVES * 64) { const int rr = e >> 6, cc = e & 63; CM[(128 + rr) * 72 + cc] = (rr == 0) ? (bf16)f2bf(B.NST[unit * 64 + cc]) : (bf16)0; }
    LDS_WAIT(); __syncthreads();
    const int w = F.wave, r = lane & 15, q4 = lane >> 4;
    {
        bf16x8_t a[2];
#pragma unroll
        for (int ks = 0; ks < 2; ++ks) a[ks] = *(const LAS bf16x8_t*)(QS + (16 * w + r) * 72 + 32 * ks + 8 * q4);
        float rtj[4];
#pragma unroll
        for (int j = 0; j < 4; ++j) rtj[j] = rt[16 * w + 4 * q4 + j];
        for (int nt = 0; nt <= (w | 1); ++nt) { f32x4 acc = {0.f, 0.f, 0.f, 0.f};
#pragma unroll
            for (int ks = 0; ks < 2; ++ks) { const bf16x8_t bb = *(const LAS bf16x8_t*)(KS + (16 * nt + r) * 72 + 32 * ks + 8 * q4); acc = MFMA16(a[ks], bb, acc); }
            const int s = 16 * nt + r; const float as = aa[s];
#pragma unroll
            for (int j = 0; j < 4; ++j) { const int t = 16 * w + 4 * q4 + j; const float v = (s <= t) ? acc[j] * fexp(rtj[j] + as) : 0.f; SS[t * 136 + s] = (bf16)f2bf(v); } }
    }
    LDS_WAIT();
    f32x4 accS[9], accQ[9];
#pragma unroll
    for (int nt = 0; nt < 9; ++nt) { accS[nt] = (f32x4){0.f, 0.f, 0.f, 0.f}; accQ[nt] = (f32x4){0.f, 0.f, 0.f, 0.f}; }
    for (int ks = 0; ks <= (16 * w + 15) / 32; ++ks) { const bf16x8_t a = *(const LAS bf16x8_t*)(SS + (16 * w + r) * 136 + 32 * ks + 8 * q4);
        const int trow = 32 * ks + 8 * q4 + (r >> 2), pc = 4 * (r & 3);
#pragma unroll
        for (int nt = 0; nt < 9; ++nt) { const bf16x8_t bb = tr8(VT + trow * 144 + 16 * nt + pc, VT + (trow + 4) * 144 + 16 * nt + pc); accS[nt] = MFMA16(a, bb, accS[nt]); } }
#pragma unroll
    for (int ks = 0; ks < 2; ++ks) { const bf16x8_t a = *(const LAS bf16x8_t*)(QS + (16 * w + r) * 72 + 32 * ks + 8 * q4);
#pragma unroll
        for (int nt = 0; nt < 9; ++nt) { const bf16x8_t bb = *(const LAS bf16x8_t*)(CM + (16 * nt + r) * 72 + 32 * ks + 8 * q4); accQ[nt] = MFMA16(a, bb, accQ[nt]); } }
    LDS_WAIT();
    {
        float gn[8];
#pragma unroll
        for (int nt = 0; nt < 8; ++nt) gn[nt] = norm_ml[h * 128 + 16 * nt + r];
#pragma unroll
        for (int j = 0; j < 4; ++j) { const int t = 16 * w + 4 * q4 + j; const float wi = wint[t];
            const float dS = __shfl(accS[8][j], lane & 48), dQ = __shfl(accQ[8][j], lane & 48);
            const float den = dS + wi * dQ; const float dn = 1.f / fmaxf(fabsf(den), emt[t]);
            float hv[8]; float ss = 0.f;
#pragma unroll
            for (int nt = 0; nt < 8; ++nt) { hv[nt] = (accS[nt][j] + wi * accQ[nt][j]) * dn; ss += hv[nt] * hv[nt]; }
            ss += __shfl_xor(ss, 1); ss += __shfl_xor(ss, 2); ss += __shfl_xor(ss, 4); ss += __shfl_xor(ss, 8);
            const float rs = 1.f / sqrtf(ss * (1.f / 128.f) + RMS_EPS);
#pragma unroll
            for (int nt = 0; nt < 8; ++nt) SS[t * 136 + 16 * nt + r] = (bf16)f2bf(hv[nt] * rs * gn[nt]); }
    }
    LDS_WAIT();
    for (int e = lane; e < 16 * 16; e += 64) { const int t = 16 * w + (e >> 4), v0 = (e & 15) * 8;
        const v4u hh = *(const LAS v4u*)(SS + t * 136 + v0); const v4u mo = *(const GAS v4u*)(PROJ + (row0 + t) * NPROJ + C_MO + h * 128 + v0);
        v4u o;
#define SGM(x) fsigm(x)
        o.x = pk2(bflo(hh.x) * SGM(bflo(mo.x)), bfhi(hh.x) * SGM(bfhi(mo.x))); o.y = pk2(bflo(hh.y) * SGM(bflo(mo.y)), bfhi(hh.y) * SGM(bfhi(mo.y)));
        o.z = pk2(bflo(hh.z) * SGM(bflo(mo.z)), bfhi(hh.z) * SGM(bfhi(mo.z))); o.w = pk2(bflo(hh.w) * SGM(bflo(mo.w)), bfhi(hh.w) * SGM(bfhi(mo.w)));
#undef SGM
        *(GAS v4u*)(CAT + (row0 + t) * D + 512 + h * 128 + v0) = o; }
    LDS_WAIT(); __syncthreads();
}

typedef float f32x16_t __attribute__((ext_vector_type(16)));
typedef short s16x4_t __attribute__((ext_vector_type(4)));
typedef short v4i16_t __attribute__((ext_vector_type(4)));
typedef float f32x2_t __attribute__((ext_vector_type(2)));
typedef __bf16 bf16x2_t __attribute__((ext_vector_type(2)));
#define MFMA32(a, b, c) __builtin_amdgcn_mfma_f32_32x32x16_bf16((a), (b), (c), 0, 0, 0)
__device__ __forceinline__ unsigned cvtpk(float lo, float hi) { f32x2_t v = {lo, hi}; bf16x2_t b = __builtin_convertvector(v, bf16x2_t); return __builtin_bit_cast(unsigned, b); }
struct AtBufs { bf16* PO; float* PML; unsigned* SEL; unsigned* LISTQ; unsigned* BCNT; };
constexpr int AT_KS = 0, AT_VS = 36864, AT_END = 86016;
constexpr int AT_PFX = 90112;
constexpr int BKT_PER_BH = 126976;
__device__ __forceinline__ int bucket_off(int bh, int j) { return bh * BKT_PER_BH + 256 * (31 * j - (j * (j - 1)) / 2); }

__device__ __forceinline__ void attn_route(Frame& F, int unit, const bf16* PROJ, const float* ksum, const AtBufs& A) {
    const int bh = unit >> 5, blk = unit & 31, b = bh >> 3, h = bh & 7, tid = F.tid;
    LAS float* km = (LAS float*)(F.lds); LAS int* cnt = (LAS int*)(F.lds + 8192); LAS int* base = cnt + 32;
    PSEG(0);
    LAS float* cv = (LAS float*)(F.lds + 8704); LAS int* ci = (LAS int*)(F.lds + 8704 + 3072);
    for (int e = tid; e < blk * 64; e += NWAVES * 64) km[e] = ksum[(size_t)(b * NB + (e >> 6)) * 512 + h * 64 + (e & 63)];
    if (tid < 32) cnt[tid] = 0;
    LDS_WAIT(); __syncthreads(); PSEG(4);
    const int ql = tid & 255, half = tid >> 8; const int t = blk * 256 + ql; const size_t row = (size_t)b * SEQ + t;
    int i0 = -1, i1 = -1, i2 = -1, l0 = 0, l1 = 0, l2 = 0; float v0 = -INFINITY, v1 = -INFINITY, v2 = -INFINITY;
    {
        float q[64]; const GAS v4u* qp = (const GAS v4u*)(PROJ + row * NPROJ + C_AQ + h * 64);
#pragma unroll
        for (int c = 0; c < 8; ++c) { const v4u w = qp[c]; q[8 * c] = bflo(w.x); q[8 * c + 1] = bfhi(w.x); q[8 * c + 2] = bflo(w.y); q[8 * c + 3] = bfhi(w.y); q[8 * c + 4] = bflo(w.z); q[8 * c + 5] = bfhi(w.z); q[8 * c + 6] = bflo(w.w); q[8 * c + 7] = bfhi(w.w); }
        for (int n = half; n < blk; n += 2) { const LAS f32x4* kr = (const LAS f32x4*)(km + n * 64); float g = 0.f;
#pragma unroll
            for (int c = 0; c < 16; ++c) { const f32x4 kk = kr[c]; g += q[4 * c] * kk[0] + q[4 * c + 1] * kk[1] + q[4 * c + 2] * kk[2] + q[4 * c + 3] * kk[3]; }
            if (g > v0) { v2 = v1; i2 = i1; v1 = v0; i1 = i0; v0 = g; i0 = n; } else if (g > v1) { v2 = v1; i2 = i1; v1 = g; i1 = n; } else if (g > v2) { v2 = g; i2 = n; } }
    }
    PSEG(5);
    if (half) { cv[ql * 3] = v0; cv[ql * 3 + 1] = v1; cv[ql * 3 + 2] = v2; ci[ql * 3] = i0; ci[ql * 3 + 1] = i1; ci[ql * 3 + 2] = i2; }
    LDS_WAIT(); __syncthreads();
    if (!half) {
#pragma unroll
        for (int k = 0; k < 3; ++k) { const float g = cv[ql * 3 + k]; const int n = ci[ql * 3 + k];
            if (n >= 0) { if (g > v0 || (g == v0 && n < i0)) { v2 = v1; i2 = i1; v1 = v0; i1 = i0; v0 = g; i0 = n; } else if (g > v1 || (g == v1 && n < i1)) { v2 = v1; i2 = i1; v1 = g; i1 = n; } else if (g > v2 || (g == v2 && n < i2)) { v2 = g; i2 = n; } } }
        A.SEL[row * 8 + h] = (unsigned)(i0 & 0xff) | ((unsigned)(i1 & 0xff) << 8) | ((unsigned)(i2 & 0xff) << 16);
        if (i0 >= 0) l0 = __hip_atomic_fetch_add(cnt + i0, 1, __ATOMIC_RELAXED, __HIP_MEMORY_SCOPE_WORKGROUP);
        if (i1 >= 0) l1 = __hip_atomic_fetch_add(cnt + i1, 1, __ATOMIC_RELAXED, __HIP_MEMORY_SCOPE_WORKGROUP);
        if (i2 >= 0) l2 = __hip_atomic_fetch_add(cnt + i2, 1, __ATOMIC_RELAXED, __HIP_MEMORY_SCOPE_WORKGROUP);
    }
    LDS_WAIT(); __syncthreads();
    if (tid < blk) { const int c = cnt[tid]; base[tid] = c > 0 ? (int)__hip_atomic_fetch_add(A.BCNT + bh * 32 + tid, (unsigned)c, RLX_AGENT) : 0; }
    LDS_WAIT(); __syncthreads();
    if (!half) {
        if (i0 >= 0) A.LISTQ[bucket_off(bh, i0) + base[i0] + l0] = (unsigned)t;
        if (i1 >= 0) A.LISTQ[bucket_off(bh, i1) + base[i1] + l1] = (unsigned)t | (1u << 13);
        if (i2 >= 0) A.LISTQ[bucket_off(bh, i2) + base[i2] + l2] = (unsigned)t | (2u << 13);
    }
    __syncthreads(); PSEG(6);
}
struct KvRegs { v4u k[4], v[4]; };
__device__ __forceinline__ void attn_kv_load(Frame& F, const bf16* PROJ, size_t krow0, int h, KvRegs& R) {
#pragma unroll
    for (int i = 0; i < 4; ++i) { const int e = F.tid + 512 * i, key = e >> 3, d0 = (e & 7) * 8; const bf16* rp = PROJ + (krow0 + key) * NPROJ + h * 64 + d0;
        R.k[i] = *(const GAS v4u*)(rp + C_AK); R.v[i] = *(const GAS v4u*)(rp + C_AV); }
}
__device__ __forceinline__ void attn_kv_store(Frame& F, const KvRegs& R) {
    LAS bf16* KS = (LAS bf16*)(F.lds + AT_KS); LAS bf16* VS = (LAS bf16*)(F.lds + AT_VS);
#pragma unroll
    for (int i = 0; i < 4; ++i) { const int e = F.tid + 512 * i, key = e >> 3, d0 = (e & 7) * 8; *(LAS v4u*)(KS + key * 72 + d0) = R.k[i]; *(LAS v4u*)(VS + key * 96 + d0) = R.v[i]; }
}
template <bool CAUSAL>
__device__ __forceinline__ void attn_core(Frame& F, const bf16x8_t (&qf)[4], int qloc, float& m, float& l, f32x16_t (&o)[2]) {
    const LAS bf16* KS = (const LAS bf16*)(F.lds + AT_KS); const LAS bf16* VS = (const LAS bf16*)(F.lds + AT_VS);
    const int lane = F.lane, r32 = lane & 31, hh = lane >> 5;
    m = 0.f; l = 0.f;
#pragma unroll
    for (int i = 0; i < 16; ++i) { o[0][i] = 0.f; o[1][i] = 0.f; }
    const int ktmax = CAUSAL ? ((32 * F.wave + 31) >> 6) : 3;
    for (int kt = 0; kt <= ktmax; ++kt) {
        f32x16_t p0, p1; const float nm = -m;
#pragma unroll
        for (int i = 0; i < 16; ++i) { p0[i] = nm; p1[i] = nm; }
#pragma unroll
        for (int d0 = 0; d0 < 4; ++d0) { const bf16x8_t k0 = *(const LAS bf16x8_t*)(KS + (64 * kt + r32) * 72 + 16 * d0 + 8 * hh), k1 = *(const LAS bf16x8_t*)(KS + (64 * kt + 32 + r32) * 72 + 16 * d0 + 8 * hh);
            p0 = MFMA32(k0, qf[d0], p0); p1 = MFMA32(k1, qf[d0], p1); }
        if (CAUSAL) { if (64 * kt + 63 > 32 * F.wave) {
#pragma unroll
                for (int i = 0; i < 16; ++i) { const int kl = 64 * kt + (i & 3) + 8 * (i >> 2) + 4 * hh; if (kl > qloc) p0[i] = -INFINITY; if (kl + 32 > qloc) p1[i] = -INFINITY; } } }
        float rm = fmaxf(p0[0], p1[0]);
#pragma unroll
        for (int i = 1; i < 16; ++i) rm = fmaxf(rm, fmaxf(p0[i], p1[i]));
        rm = fmaxf(rm, __shfl_xor(rm, 32));
        if (kt == 0 || __any(rm > 8.f)) {
            const float dl = (kt == 0) ? rm : fmaxf(rm, 0.f); const float sc = (kt == 0) ? 1.f : __builtin_amdgcn_exp2f(-dl); m += dl; l *= sc;
#pragma unroll
            for (int i = 0; i < 16; ++i) { o[0][i] *= sc; o[1][i] *= sc; p0[i] -= dl; p1[i] -= dl; } }
        float ls = 0.f;
#pragma unroll
        for (int i = 0; i < 16; ++i) { p0[i] = __builtin_amdgcn_exp2f(p0[i]); p1[i] = __builtin_amdgcn_exp2f(p1[i]); ls += p0[i] + p1[i]; }
        l += ls;
        bf16x8_t pf[4];
#pragma unroll
        for (int s = 0; s < 2; ++s) { v4u a, c; a.x = cvtpk(p0[8 * s], p0[8 * s + 1]); a.y = cvtpk(p0[8 * s + 2], p0[8 * s + 3]); a.z = cvtpk(p0[8 * s + 4], p0[8 * s + 5]); a.w = cvtpk(p0[8 * s + 6], p0[8 * s + 7]);
            c.x = cvtpk(p1[8 * s], p1[8 * s + 1]); c.y = cvtpk(p1[8 * s + 2], p1[8 * s + 3]); c.z = cvtpk(p1[8 * s + 4], p1[8 * s + 5]); c.w = cvtpk(p1[8 * s + 6], p1[8 * s + 7]);
            pf[s] = __builtin_bit_cast(bf16x8_t, a); pf[2 + s] = __builtin_bit_cast(bf16x8_t, c); }
#pragma unroll
        for (int dt = 0; dt < 2; ++dt)
#pragma unroll
            for (int s = 0; s < 4; ++s) { const LAS bf16* vp = VS + (64 * kt + 32 * (s >> 1) + 16 * (s & 1) + 4 * hh + ((lane & 15) >> 2)) * 96 + 32 * dt + 16 * ((lane >> 4) & 1) + 4 * (lane & 3);
                const s16x4_t lo = __builtin_bit_cast(s16x4_t, __builtin_amdgcn_ds_read_tr16_b64_v4i16((LAS v4i16_t*)vp)), hi = __builtin_bit_cast(s16x4_t, __builtin_amdgcn_ds_read_tr16_b64_v4i16((LAS v4i16_t*)(vp + 8 * 96)));
                const bf16x8_t vf = {lo[0], lo[1], lo[2], lo[3], hi[0], hi[1], hi[2], hi[3]};
                o[dt] = MFMA32(vf, pf[s], o[dt]); }
    }
}
__device__ __forceinline__ int attn_tile_prefix(Frame& F, const AtBufs& A) {
    LAS int* pfx = (LAS int*)(F.lds + AT_PFX); LAS int* wtot = pfx + 512;
    const int k = F.tid; int nt = 0;
    if (k < 496) { const int bh = k / 31, j = k - bh * 31; nt = ((int)__hip_atomic_load(A.BCNT + bh * 32 + j, RLX_AGENT) + 255) >> 8; }
    int inc = nt;
#pragma unroll
    for (int o = 1; o < 64; o <<= 1) { const int y = __shfl_up(inc, o); if (F.lane >= o) inc += y; }
    if (F.lane == 63) wtot[F.wave] = inc;
    LDS_WAIT(); __syncthreads();
    int wb = 0;
    for (int w = 0; w < F.wave; ++w) wb += wtot[w];
    pfx[k] = wb + inc - nt;
    if (k == 511) pfx[512 + 16] = wb + inc;
    LDS_WAIT(); __syncthreads();
    return pfx[512 + 16];
}
struct SelMeta { int bh, j, n, tile; };
__device__ __forceinline__ SelMeta attn_sel_decode(Frame& F, int u, const AtBufs& A) {
    const LAS int* pfx = (const LAS int*)(F.lds + AT_PFX);
    int lo = 0, hi = 495;
    while (lo < hi) { const int mid = (lo + hi + 1) >> 1; if (pfx[mid] <= u) lo = mid; else hi = mid - 1; }
    SelMeta m; m.bh = lo / 31; m.j = lo - m.bh * 31; m.tile = u - pfx[lo]; m.n = (int)__hip_atomic_load(A.BCNT + m.bh * 32 + m.j, RLX_AGENT); return m;
}
__device__ __forceinline__ void attn_sel_phase(Frame& F, int nu, const bf16* PROJ, const AtBufs& A) {
    const int lane = F.lane, r32 = lane & 31, hh = lane >> 5;
    int u = F.vcu; if (u >= nu) return;
    LAS int* mtab = (LAS int*)(F.lds + AT_PFX + 2560);
    if (F.tid < 32) { const int ui = F.vcu + F.tid * F.G; if (ui < nu) { const SelMeta x = attn_sel_decode(F, ui, A); mtab[4 * F.tid] = x.bh; mtab[4 * F.tid + 1] = x.j; mtab[4 * F.tid + 2] = x.n; mtab[4 * F.tid + 3] = x.tile; } }
    LDS_WAIT(); __syncthreads();
    int ui_ = 0;
#define SEL_META(mt_) { mt_.bh = mtab[4 * ui_]; mt_.j = mtab[4 * ui_ + 1]; mt_.n = mtab[4 * ui_ + 2]; mt_.tile = mtab[4 * ui_ + 3]; ++ui_; }
    KvRegs R; bf16x8_t qn[4]; SelMeta mt; SEL_META(mt) int tq = 0, slotq = 0; bool validq = false;
#define SEL_PREFETCH() { const int b_ = mt.bh >> 3, h_ = mt.bh & 7; attn_kv_load(F, PROJ, (size_t)b_ * SEQ + (size_t)mt.j * 256, h_, R); \
        const int idx_ = mt.tile * 256 + 32 * F.wave + r32; validq = idx_ < mt.n; const unsigned ent_ = A.LISTQ[bucket_off(mt.bh, mt.j) + (validq ? idx_ : mt.n - 1)]; tq = ent_ & 8191; slotq = ent_ >> 13; \
        const bf16* qp_ = PROJ + ((size_t)b_ * SEQ + tq) * NPROJ + C_AQ + h_ * 64 + 8 * hh; \
        _Pragma("unroll") for (int d0 = 0; d0 < 4; ++d0) qn[d0] = *(const GAS bf16x8_t*)(qp_ + 16 * d0); }
    SEL_PREFETCH()
    for (;;) {
        PSEG(0);
        attn_kv_store(F, R);
        bf16x8_t qf[4];
#pragma unroll
        for (int d0 = 0; d0 < 4; ++d0) qf[d0] = qn[d0];
        const int b = mt.bh >> 3, h = mt.bh & 7, t = tq, slot = slotq; const bool valid = validq;
        LDS_WAIT(); __syncthreads(); PSEG(7);
        const int un = u + F.G; const bool more = un < nu;
        if (more) { if (ui_ < 32) { SEL_META(mt) } else mt = attn_sel_decode(F, un, A); SEL_PREFETCH() }
        PSEG(8);
        float m, l; f32x16_t o[2];
        attn_core<false>(F, qf, 0, m, l, o);
        l += __shfl_xor(l, 32); const float inv = 1.f / l; const size_t row = (size_t)b * SEQ + t;
        if (valid) { bf16* po = A.PO + ((row * 8 + h) * 3 + slot) * 64;
#pragma unroll
            for (int dt = 0; dt < 2; ++dt)
#pragma unroll
                for (int g = 0; g < 4; ++g) { v2u w; w.x = cvtpk(o[dt][4 * g] * inv, o[dt][4 * g + 1] * inv); w.y = cvtpk(o[dt][4 * g + 2] * inv, o[dt][4 * g + 3] * inv);
                    *(GAS v2u*)(po + 32 * dt + 8 * g + 4 * hh) = w; }
            if (hh == 0) { float* pm = A.PML + ((row * 8 + h) * 3 + slot) * 2; pm[0] = m; pm[1] = l; } }
        LDS_WAIT(); __syncthreads(); PSEG(9);
        if (!more) break;
        u = un;
    }
#undef SEL_PREFETCH
#undef SEL_META
}
__device__ __forceinline__ void attn_own_phase(Frame& F, const bf16* PROJ, const float* norm_attn, bf16* CAT, const AtBufs& A) {
    const int lane = F.lane, r32 = lane & 31, hh = lane >> 5; const int qloc = 32 * F.wave + r32;
    int u = F.vcu; if (u >= 512) return;
    KvRegs R; bf16x8_t qn[4]; unsigned seln = 0;
#define OWN_PREFETCH(U) { const int bh_ = (U) >> 5, blk_ = (U) & 31, b_ = bh_ >> 3, h_ = bh_ & 7; attn_kv_load(F, PROJ, (size_t)b_ * SEQ + (size_t)blk_ * 256, h_, R); \
        const size_t row_ = (size_t)b_ * SEQ + blk_ * 256 + qloc; const bf16* qp_ = PROJ + row_ * NPROJ + C_AQ + h_ * 64 + 8 * hh; \
        _Pragma("unroll") for (int d0 = 0; d0 < 4; ++d0) qn[d0] = *(const GAS bf16x8_t*)(qp_ + 16 * d0); seln = A.SEL[row_ * 8 + h_]; }
    OWN_PREFETCH(u)
    for (;;) {
        attn_kv_store(F, R);
        bf16x8_t qf[4];
#pragma unroll
        for (int d0 = 0; d0 < 4; ++d0) qf[d0] = qn[d0];
        const unsigned sel = seln; const int bh = u >> 5, blk = u & 31, b = bh >> 3, h = bh & 7; const size_t row = (size_t)b * SEQ + blk * 256 + qloc;
        LDS_WAIT(); __syncthreads();
        const int un = u + F.G; const bool more = un < 512;
        if (more) OWN_PREFETCH(un)
        float m, l; f32x16_t o[2];
        attn_core<true>(F, qf, qloc, m, l, o);
        l += __shfl_xor(l, 32);
        float mk[3], lk[3]; float M2 = m;
#pragma unroll
        for (int k = 0; k < 3; ++k) { const bool ok = ((sel >> (8 * k)) & 0xffu) != 0xffu; mk[k] = -INFINITY; lk[k] = 0.f;
            if (ok) { const float* pm = A.PML + ((row * 8 + h) * 3 + k) * 2; mk[k] = pm[0]; lk[k] = pm[1]; } M2 = fmaxf(M2, mk[k]); }
        const float wo = __builtin_amdgcn_exp2f(m - M2); float L = l * wo;
#pragma unroll
        for (int i = 0; i < 16; ++i) { o[0][i] *= wo; o[1][i] *= wo; }
#pragma unroll
        for (int k = 0; k < 3; ++k) { const float wk = lk[k] * __builtin_amdgcn_exp2f(mk[k] - M2); L += wk;
            if (wk > 0.f) { const bf16* po = A.PO + ((row * 8 + h) * 3 + k) * 64;
#pragma unroll
                for (int dt = 0; dt < 2; ++dt)
#pragma unroll
                    for (int g = 0; g < 4; ++g) { const v2u w = *(const GAS v2u*)(po + 32 * dt + 8 * g + 4 * hh);
                        o[dt][4 * g] += wk * bflo(w.x); o[dt][4 * g + 1] += wk * bfhi(w.x); o[dt][4 * g + 2] += wk * bflo(w.y); o[dt][4 * g + 3] += wk * bfhi(w.y); } } }
        const float inv = 1.f / L; float ss = 0.f;
#pragma unroll
        for (int i = 0; i < 16; ++i) { o[0][i] *= inv; o[1][i] *= inv; ss += o[0][i] * o[0][i] + o[1][i] * o[1][i]; }
        ss += __shfl_xor(ss, 32);
        const float rs = 1.f / sqrtf(ss * (1.f / 64.f) + RMS_EPS);
        bf16* co = CAT + row * D + h * 64;
#pragma unroll
        for (int dt = 0; dt < 2; ++dt)
#pragma unroll
            for (int g = 0; g < 4; ++g) { const int d0 = 32 * dt + 8 * g + 4 * hh; const f32x4 gn = *(const GAS f32x4*)(norm_attn + h * 64 + d0);
                v2u w; w.x = cvtpk(o[dt][4 * g] * rs * gn[0], o[dt][4 * g + 1] * rs * gn[1]); w.y = cvtpk(o[dt][4 * g + 2] * rs * gn[2], o[dt][4 * g + 3] * rs * gn[3]);
                *(GAS v2u*)(co + d0) = w; }
        LDS_WAIT(); __syncthreads();
        if (!more) break;
        u = un;
    }
#undef OWN_PREFETCH
}

constexpr int N_PHASES = 20;
struct Args { In in; float* out; unsigned char* ws; int ph_lo, ph_hi; };
__global__ void __launch_bounds__(NWAVES * 64, 2) hymba_fwd(Args args) {
    extern __shared__ __attribute__((aligned(16))) unsigned char lds[];
    Frame F;
    F.lds = (LAS unsigned char*)lds;
    F.MISC = (volatile LAS unsigned*)(F.lds + MISC_OFF);
    F.tid = threadIdx.x; F.lane = F.tid & 63; F.wave = __builtin_amdgcn_readfirstlane(F.tid >> 6);
    F.G = gridDim.x; { const int bx = blockIdx.x; F.vcu = (F.G % 8 == 0) ? (bx % 8) * (F.G / 8) + bx / 8 : bx; }
    F.ws = args.ws; unsigned char* ws = args.ws;
    F.ctl = (gu32*)(ws + WS_CTL);
    const In& I = args.in;
    for (int u = F.tid; u < (LDS_BYTES - MISC_OFF) / 4; u += NWAVES * 64) ((LAS unsigned*)(F.lds + MISC_OFF))[u] = 0u;
    __syncthreads();
    const int lo = args.ph_lo, hi = args.ph_hi;
    const bool multi = (hi - lo) > 1;
    XcdBarrier bar; bar.bar = (unsigned*)(F.ctl + CW_BAR); bar.x = 0; bar.st = nullptr;
    if (multi) bar = xcd_barrier_post((unsigned*)(F.ctl + CW_BAR), F.MISC + 8);
#define IN(k) (lo <= (k) && (k) < hi)
#ifdef PROBE_MASK
    LAS unsigned long long* pts = (LAS unsigned long long*)(F.lds + MISC_OFF + 1024);
    if (blockIdx.x == 0 && F.tid == 0) pts[0] = __builtin_amdgcn_s_memrealtime();
    LAS unsigned long long* pmid = pts + 32;
#define PMID(k) do { if (blockIdx.x == 0 && F.tid == 0) pmid[k] = __builtin_amdgcn_s_memrealtime(); } while (0)
#define SEAM(k) do { if (IN(k) && IN((k) + 1)) xcd_barrier(bar); if (blockIdx.x == 0 && F.tid == 0) pts[(k) + 1] = __builtin_amdgcn_s_memrealtime(); } while (0)
#else
#define SEAM(k) do { if (IN(k) && IN((k) + 1)) xcd_barrier(bar); } while (0)
#define PMID(k)
#endif
    bf16* XB = (bf16*)(ws + WS_XB); bf16* PROJ = (bf16*)(ws + WS_PROJ); bf16* CAT = (bf16*)(ws + WS_CAT);
    bf16* MIXB = (bf16*)(ws + WS_MIX); bf16* MIX2B = (bf16*)(ws + WS_MIX2); bf16* X1 = (bf16*)(ws + WS_X1); float* GATES = (float*)(ws + WS_GATES);
    const float* ROPE = (const float*)(ws + WS_ROPE);
    int* LIST = (int*)(ws + WS_LIST); float* LISTW = (float*)(ws + WS_LISTW); int* ROWMAP = (int*)(ws + WS_ROWMAP); float* ROWW = (float*)(ws + WS_ROWW);
    bf16* YB = (bf16*)(ws + WS_Y);

    if (IN(0)) { p_prologue(F, I); } SEAM(0);
    MlBufs MLB{(bf16*)(ws + WS_QC), (bf16*)(ws + WS_KC), (float*)(ws + WS_DC), (bf16*)(ws + WS_CST), (float*)(ws + WS_DN), (float*)(ws + WS_NST), (float*)(ws + WS_SC), (float*)(ws + WS_MC)};
    AtBufs ATB{(bf16*)(ws + WS_PO), (float*)(ws + WS_PML), (unsigned*)(ws + WS_SEL), (unsigned*)(ws + WS_LISTQ), nullptr};
#if defined(DBG_ML) || defined(DBG_AT)
    bf16* CAT2 = (bf16*)(ws + WS_CAT2);
#define DBG_CMP(COFF) { float ds = 0.f; for (size_t e = (size_t)blockIdx.x * 512 + F.tid; e < (size_t)M * 512; e += (size_t)F.G * 512) { const size_t idx = (e >> 9) * D + (COFF) + (e & 511); ds += fabsf(bf2f(CAT[idx]) - bf2f(CAT2[idx])); } \
        ds = wave_sum(ds); if (F.lane == 0) __hip_atomic_fetch_add((float*)(F.ctl + CW_DBG), ds, RLX_AGENT); }
#endif
#ifdef DBG_ML
#define DBG_NAIVE(L) if (F.vcu < 8) mlstm_naive(F, F.vcu, PROJ, GATES, I.conv_w + (L) * 2048, I.conv_b + (L) * 512, I.norm_ml + (L) * 512, CAT2);
#define DBG_COMPARE() DBG_CMP(512)
#elif defined(DBG_AT)
#define DBG_NAIVE(L) attn_naive(F, PROJ, (const float*)(F.ctl + CW_KSUM) + (L) * (BATCH * NB * 512), I.norm_attn + (L) * 512, CAT2, 0, F.G * NWAVES);
#define DBG_COMPARE() DBG_CMP(0)
#else
#define DBG_NAIVE(L)
#define DBG_COMPARE()
#endif

#define LAYER_MIXER(L, P)                                                                                                                                   \
    if (IN(P)) {                                                                                                                          \
        pg8::Gemm g{XB, (const bf16*)(ws + WS_WIN) + (size_t)(L) * NPROJ * D, M, NPROJ, D}; pg8::StaticOrder S; S.init(M, NPROJ, F.G, (int)blockIdx.x);     \
        pg8::EpiProj E{PROJ, ROPE, (float*)(F.ctl + CW_KSUM) + (L) * (BATCH * NB * 512), QSCALE};                                                          \
        pg8::gemm_phase<pg8::EpiProj, pg8::StaticOrder, true, true>(F.lds, g, S, E); } SEAM(P);                                                             \
    ATB.BCNT = (unsigned*)(F.ctl + CW_BCNT) + (L) * 512;                                                                                                    \
    if (IN((P) + 1)) {                                                                            \
        for (int u = F.vcu; u < 512; u += F.G) ml_phase_a(F, u, PROJ, GATES, I.conv_w + (L) * 2048, I.conv_b + (L) * 512, MLB); PMID((P) + 1);               \
        for (int u = F.vcu; u < 256; u += F.G) { attn_route(F, u, PROJ, (const float*)(F.ctl + CW_KSUM) + (L) * (BATCH * NB * 512), ATB);                  \
            attn_route(F, 511 - u, PROJ, (const float*)(F.ctl + CW_KSUM) + (L) * (BATCH * NB * 512), ATB); }     \
        DBG_NAIVE(L) } SEAM((P) + 1);                                                                                                                       \
    if (IN((P) + 2)) {                                                      \
        const int nu = attn_tile_prefix(F, ATB);                                                                                                            \
        for (int u = F.vcu; u < 256; u += F.G) ml_phase_b(F, u, MLB); PMID((P) + 2);                                                                        \
        attn_sel_phase(F, nu, PROJ, ATB); } SEAM((P) + 2);                                                              \
    if (IN((P) + 3)) {                                                                             \
        for (int u = F.vcu; u < 512; u += F.G) ml_phase_c(F, u, PROJ, GATES, I.norm_ml + (L) * 512, CAT, MLB); PMID((P) + 3);                               \
        attn_own_phase(F, PROJ, I.norm_attn + (L) * 512, CAT, ATB); } SEAM((P) + 3);                               \
    if (IN((P) + 4)) {                                                                                                                   \
        DBG_COMPARE()                                                                                                                                       \
        pg8::Gemm g{CAT, (const bf16*)(ws + WS_WOUT) + (size_t)(L) * D * D, M, D, D}; pg8::StaticOrder S; S.init(M, D, F.G, (int)blockIdx.x);                \
        pg8::EpiBf16s E{MIXB, D, 1.f};                                                                                                                      \
        pg8::gemm_phase<pg8::EpiBf16s, pg8::StaticOrder, false, true>(F.lds, g, S, E); } SEAM((P) + 4);

    unsigned char* X1F8 = ws + WS_X1B; unsigned char* HD8 = ws + WS_HD; unsigned char* HM8 = ws + WS_HM; unsigned char* XS8 = ws + WS_XS;
    LAYER_MIXER(0, 1)
    if (IN(6)) { ln_phase<true, false, 0>(F, I.x, nullptr, MIXB, nullptr, I.ln1_g, I.ln1_b, nullptr, X1, X1F8, nullptr, nullptr, nullptr, nullptr, 1.f); } SEAM(6);
    if (IN(7)) {
        pg8::Gemm g{(const bf16*)X1F8, (const bf16*)(ws + WS_WGU), M, 2 * DFF, D / 2}; pg8::StaticOrder S; S.init(M, 2 * DFF, F.G, (int)blockIdx.x);
        pg8::EpiSwiglu8 E{HD8, DFF, 0, 1.f / SW_UP};
        pg8::gemm_phase<pg8::EpiSwiglu8, pg8::StaticOrder, true, true, true>(F.lds, g, S, E); } SEAM(7);
    if (IN(8)) {
        pg8::Gemm g{(const bf16*)HD8, (const bf16*)(ws + WS_WD), M, D, DFF / 2}; pg8::StaticOrder S; S.init(M, D, F.G, (int)blockIdx.x);
        pg8::EpiBf16s E{MIX2B, D, 1.f / SW_DN};
        pg8::gemm_phase<pg8::EpiBf16s, pg8::StaticOrder, false, true, true>(F.lds, g, S, E); } SEAM(8);
    if (IN(9)) { stage_xw(F, I.w_in + (size_t)D * NIN, NIN, NPROJ);
        ln_phase<false, false, 1>(F, nullptr, X1, MIX2B, nullptr, I.ln2_g, I.ln2_b, nullptr, XB, nullptr, I.gate_bias + 8, GATES, nullptr, nullptr, 1.f); } SEAM(9);
    LAYER_MIXER(1, 10)
    if (IN(15)) { stage_xw(F, I.router_w, 8, 0);
        ln_phase<false, false, 2>(F, nullptr, XB, MIXB, nullptr, I.ln1_g + D, I.ln1_b + D, nullptr, X1, X1F8, I.router_b, nullptr, LIST, LISTW, 1.f);
        __syncthreads(); moe_cvt(F, I); } SEAM(15);
    int ntiles = 0;
    if (lo <= 18 && hi > 16) ntiles = moe_plan(F);
    if (IN(16)) { moe_gather(F, ntiles, X1F8, XS8, LIST, LISTW, ROWMAP, ROWW); } SEAM(16);
    const PG8_LAS int* texp = (const PG8_LAS int*)(F.lds + TEXP_OFF);
    if (IN(17)) {
        pg8::Gemm g{(const bf16*)XS8, (const bf16*)(ws + WS_MGU), MAXT * 256, 2 * DEX, D / 2}; pg8::GroupedOrder<false> S; S.init(0, ntiles, 2 * DEX / 256, F.G, (int)blockIdx.x, texp);
        pg8::EpiSwiglu8 E{HM8, DEX, 0, 1.f / SW_UP};
        pg8::gemm_phase<pg8::EpiSwiglu8, pg8::GroupedOrder<false>, true, true, true>(F.lds, g, S, E); } SEAM(17);
    if (IN(18)) {
        pg8::Gemm g{(const bf16*)HM8, (const bf16*)(ws + WS_MD), MAXT * 256, D, DEX / 2}; pg8::GroupedOrder<true> S; S.init(0, ntiles, D / 256, F.G, (int)blockIdx.x, texp);
        pg8::EpiScatter E{YB, ROWMAP, ROWW, 0, M, 1.f / SW_DN};
        pg8::gemm_phase<pg8::EpiScatter, pg8::GroupedOrder<true>, true, true, true>(F.lds, g, S, E); } SEAM(18);
    if (IN(19)) { float osc = 1.f;
#if defined(DBG_ML) || defined(DBG_AT)
        osc = 1.f + 10.f * __hip_atomic_load((float*)(F.ctl + CW_DBG), RLX_AGENT) / (2.f * (float)M * 512.f);
#endif
        ln_phase<false, true, 0>(F, nullptr, X1, YB, YB + (size_t)M * D, I.ln2_g + D, I.ln2_b + D, args.out, nullptr, nullptr, nullptr, nullptr, nullptr, nullptr, osc); }
#ifdef PROBE_MASK
    if (blockIdx.x == 0 && F.tid == 0) { pts[N_PHASES] = __builtin_amdgcn_s_memrealtime(); unsigned long long sum = 0;
        for (int p = 0; p < N_PHASES; ++p) if ((PROBE_MASK >> p) & 1) sum += pts[p + 1] - pts[p];
#ifdef PROBE_SUB
        for (int p = 0; p < N_PHASES; ++p) if ((PROBE_SUB >> p) & 1) sum += pmid[p] - pts[p];
#endif
#ifdef PROBE_SEG
        sum += ((LAS unsigned long long*)(F.lds + MISC_OFF + 1536))[1 + PROBE_SEG];
#endif
        const unsigned long long t0 = __builtin_amdgcn_s_memrealtime(); while (__builtin_amdgcn_s_memrealtime() - t0 < 4 * sum) __builtin_amdgcn_s_sleep(8); }
#endif
#undef IN
#undef SEAM
}

extern "C" void kernel_launch(void* const* d_in, const int* in_sizes, int n_in, void* d_out, int out_size, void* d_ws, size_t ws_size, hipStream_t stream) {
    static int grid = 0;
    if (grid == 0) {
        if (n_in != 21 || in_sizes[0] != M * D || out_size != M * D || ws_size < WS_END) { fprintf(stderr, "kernel_launch: unexpected shapes (n_in %d, in0 %d, out %d, ws %zu < %zu); nothing launched\n", n_in, n_in > 0 ? in_sizes[0] : -1, out_size, ws_size, (size_t)WS_END); grid = -1; return; }
        int dev = 0, cus = 0, per_cu = 0;
        if (hipGetDevice(&dev) != hipSuccess || hipDeviceGetAttribute(&cus, hipDeviceAttributeMultiprocessorCount, dev) != hipSuccess) { grid = -1; return; }
        if (hipFuncSetAttribute((const void*)hymba_fwd, hipFuncAttributeMaxDynamicSharedMemorySize, LDS_BYTES) != hipSuccess) { fprintf(stderr, "kernel_launch: hipFuncSetAttribute failed\n"); grid = -1; return; }
        if (hipOccupancyMaxActiveBlocksPerMultiprocessor(&per_cu, (const void*)hymba_fwd, NWAVES * 64, LDS_BYTES) != hipSuccess || per_cu < 1) fprintf(stderr, "kernel_launch: occupancy query reports %d\n", per_cu);
        (void)hipGetLastError();
        grid = cus;
    }
    if (grid < 0) return;
    if (hipMemsetAsync((char*)d_ws + WS_CTL, 0, CTL_ZERO_BYTES, stream) != hipSuccess) return;
    Args a{};
    const void** ip = (const void**)&a.in;
    for (int i = 0; i < 21; ++i) ip[i] = d_in[i];
    a.out = (float*)d_out; a.ws = (unsigned char*)d_ws;
#if defined(MK_MULTI)
    for (int p = 0; p < N_PHASES; ++p) { a.ph_lo = p; a.ph_hi = p + 1;
        hipLaunchKernelGGL(hymba_fwd, dim3(grid), dim3(NWAVES * 64), LDS_BYTES, stream, a); }
#else
    a.ph_lo = 0; a.ph_hi = N_PHASES;
    hipLaunchKernelGGL(hymba_fwd, dim3(grid), dim3(NWAVES * 64), LDS_BYTES, stream, a);
#endif
}
```

```cpp
#include <hip/hip_runtime.h>
#include <cstdio>
#include <cstdint>
#include <cmath>
namespace pg8 {
#define PG8_LAS __attribute__((address_space(3)))
typedef unsigned short bf16_t;
typedef short bf16x8 __attribute__((ext_vector_type(8)));
typedef float f32x4 __attribute__((ext_vector_type(4)));
typedef unsigned u32x4 __attribute__((ext_vector_type(4)));
typedef int v8i_t __attribute__((ext_vector_type(8)));
typedef int v4i_t __attribute__((ext_vector_type(4)));
__device__ __forceinline__ v8i_t pg8_cat(bf16x8 lo, bf16x8 hi) { const v4i_t a = __builtin_bit_cast(v4i_t, lo), b = __builtin_bit_cast(v4i_t, hi); return __builtin_shufflevector(a, b, 0, 1, 2, 3, 4, 5, 6, 7); }
constexpr int BM = 256, BK = 64, HALF = 128, HTB = HALF * BK * 2  , STAGE_BYTES = 8 * HTB, NXCD = 8, WGM = 8;

__host__ __device__ __forceinline__ int lds_byte(int r, int c) { const int st = (r >> 4) * 2 + (c >> 5), rr = r & 15, cc = c & 31, ob = rr * 64 + cc * 2; return st * 1024 + (ob ^ (((ob >> 9) & 1) << 5)); }
__host__ __device__ __forceinline__ void stage_rc(int b, int& R, int& C) { const int st = b / 1024, sb = b % 1024, swz = sb ^ (((sb >> 9) & 1) << 5); R = (st >> 1) * 16 + swz / 64; C = (st & 1) * 32 + (swz % 64) / 2; }
__host__ __device__ __forceinline__ int perm32(int rho) { const int n = rho >> 4, i = rho & 15; return 8 * (i >> 2) + 4 * n + (i & 3); }

struct Unit { int pm, pn, pb; };
struct Gemm { const bf16_t* A; const bf16_t* Bt; int M, N, K; };

struct StaticOrder {
    int nM, nN, nwg, G, c;
    __host__ __device__ void init(int M, int N, int G_, int c_) { nM = M / BM; nN = N / BM; nwg = nM * nN; G = G_; c = c_; }
    __host__ __device__ bool next(int i, Unit& u) const {
        const long L = (long)i * G + c; if (L >= nwg) return false;
        int wgid = (int)L; { const int q = nwg / NXCD, r = nwg % NXCD, xcd = wgid % NXCD, off = wgid / NXCD; wgid = (xcd < r ? xcd * (q + 1) : r * (q + 1) + (xcd - r) * q) + off; }
        const int nig = WGM * nN, gid = wgid / nig, fm = gid * WGM, gsz = (nM - fm) < WGM ? (nM - fm) : WGM;
        u.pm = fm + ((wgid % nig) % gsz); u.pn = (wgid % nig) / gsz; u.pb = u.pn; return true;
    }
    __device__ __forceinline__ void a_ready(const Unit&) const {}
    __device__ __forceinline__ void done(const Unit&) const {}
};


__device__ __forceinline__ unsigned cvt_pk_bf16(float lo, float hi) { unsigned r; asm volatile("v_cvt_pk_bf16_f32 %0, %1, %2" : "=v"(r) : "v"(lo), "v"(hi)); return r; }
__device__ __forceinline__ u32x4 pack8(const f32x4 v0, const f32x4 v1) { u32x4 w; w.x = cvt_pk_bf16(v0[0], v0[1]); w.y = cvt_pk_bf16(v0[2], v0[3]); w.z = cvt_pk_bf16(v1[0], v1[1]); w.w = cvt_pk_bf16(v1[2], v1[3]); return w; }
__device__ __forceinline__ f32x4 shx16(const f32x4 v) { f32x4 r; r[0] = __shfl_xor(v[0], 16); r[1] = __shfl_xor(v[1], 16); r[2] = __shfl_xor(v[2], 16); r[3] = __shfl_xor(v[3], 16); return r; }

struct EpiF32 {
    static constexpr bool PERM = false, AFTER_DRAIN = false;
    float* C; int ldc;
    __device__ __forceinline__ void operator()(const f32x4 (&acc)[2][2][4][2], const Unit& u, int wr, int wc, int fr, int fq) const {
        const int row0 = u.pm * BM + wr * 64 + fr, col0 = u.pn * BM + wc * 32 + 4 * fq;
#pragma unroll
        for (int ai = 0; ai < 2; ++ai)
#pragma unroll
            for (int m = 0; m < 4; ++m) { float* rowp = C + (size_t)(row0 + ai * HALF + m * 16) * ldc + col0;
#pragma unroll
                for (int bj = 0; bj < 2; ++bj)
#pragma unroll
                    for (int n = 0; n < 2; ++n) *(f32x4*)(rowp + bj * HALF + n * 16) = acc[ai][bj][m][n]; }
    }
};


struct EpiBf16s {
    static constexpr bool PERM = true, AFTER_DRAIN = false;
    bf16_t* O; int ldc; float s;
    __device__ __forceinline__ void operator()(const f32x4 (&acc)[2][2][4][2], const Unit& u, int wr, int wc, int fr, int fq) const {
        const int row0 = u.pm * BM + wr * 64 + fr, col0 = u.pn * BM + wc * 32 + 8 * fq;
#pragma unroll
        for (int ai = 0; ai < 2; ++ai)
#pragma unroll
            for (int m = 0; m < 4; ++m) { bf16_t* rowp = O + (size_t)(row0 + ai * HALF + m * 16) * ldc + col0;
#pragma unroll
                for (int bj = 0; bj < 2; ++bj) *(u32x4*)(rowp + bj * HALF) = pack8(acc[ai][bj][m][0] * s, acc[ai][bj][m][1] * s); }
    }
};
struct EpiProj {
    static constexpr bool PERM = true, AFTER_DRAIN = false;
    bf16_t* O; const float* rope; float* ksum; float qscale;
    __device__ __forceinline__ void operator()(const f32x4 (&acc)[2][2][4][2], const Unit& u, int wr, int wc, int fr, int fq) const {
        const int row0 = u.pm * BM + wr * 64 + fr; const int colt = u.pn * BM; const int col0 = colt + wc * 32 + 8 * fq;
        const bool is_qk = u.pn < 4, is_q = u.pn < 2, rot = is_qk && ((wc & 1) == 0);
        float ks[2][8];
#pragma unroll
        for (int bj = 0; bj < 2; ++bj)
#pragma unroll
            for (int i = 0; i < 8; ++i) ks[bj][i] = 0.f;
#pragma unroll
        for (int ai = 0; ai < 2; ++ai)
#pragma unroll
            for (int m = 0; m < 4; ++m) { const int row = row0 + ai * HALF + m * 16; bf16_t* rowp = O + (size_t)row * 3072 + col0;
                f32x4 c0 = {1.f, 1.f, 1.f, 1.f}, c1 = c0, s0 = {0.f, 0.f, 0.f, 0.f}, s1 = s0;
                if (rot && fq < 2) { const f32x4* rp = (const f32x4*)(rope + (size_t)row * 16); c0 = rp[0]; c1 = rp[1]; s0 = rp[2]; s1 = rp[3]; if (fq == 0) { s0 = -s0; s1 = -s1; } }
#pragma unroll
                for (int bj = 0; bj < 2; ++bj) { f32x4 v0 = acc[ai][bj][m][0], v1 = acc[ai][bj][m][1];
                    if (rot) { const f32x4 p0 = shx16(v0), p1 = shx16(v1); v0 = v0 * c0 + p0 * s0; v1 = v1 * c1 + p1 * s1; }
                    if (is_q) { v0 = v0 * qscale; v1 = v1 * qscale; }
                    else if (is_qk) {
#pragma unroll
                        for (int i = 0; i < 4; ++i) { ks[bj][i] += v0[i]; ks[bj][4 + i] += v1[i]; } }
                    *(u32x4*)(rowp + bj * HALF) = pack8(v0, v1); } }
        if (is_qk && !is_q) {
            float* kd = ksum + (size_t)u.pm * 512 + (colt - 512) + wc * 32 + 8 * fq;
#pragma unroll
            for (int bj = 0; bj < 2; ++bj)
#pragma unroll
                for (int i = 0; i < 8; ++i) { float s = ks[bj][i]; s += __shfl_xor(s, 1); s += __shfl_xor(s, 2); s += __shfl_xor(s, 4); s += __shfl_xor(s, 8);
                    if (fr == 0) __hip_atomic_fetch_add(kd + bj * HALF + i, s, __ATOMIC_RELAXED, __HIP_MEMORY_SCOPE_AGENT); }
        }
    }
};

__device__ __forceinline__ float silu_f(float x) { return x * __builtin_amdgcn_rcpf(1.0f + __builtin_amdgcn_exp2f(-1.4426950408889634f * x)); }
struct EpiSwiglu {
    static constexpr bool PERM = true, AFTER_DRAIN = false;
    bf16_t* H; int ldh; int pm_off;
    __device__ __forceinline__ void operator()(const f32x4 (&acc)[2][2][4][2], const Unit& u, int wr, int wc, int fr, int fq) const {
        const int row0 = (u.pm - pm_off) * BM + wr * 64 + fr; const int col0 = u.pn * HALF + wc * 32 + 8 * fq;
#pragma unroll
        for (int ai = 0; ai < 2; ++ai)
#pragma unroll
            for (int m = 0; m < 4; ++m) { bf16_t* rowp = H + (size_t)(row0 + ai * HALF + m * 16) * ldh + col0;
                const f32x4 g0 = acc[ai][0][m][0], g1 = acc[ai][0][m][1], u0 = acc[ai][1][m][0], u1 = acc[ai][1][m][1]; f32x4 h0, h1;
#pragma unroll
                for (int i = 0; i < 4; ++i) { h0[i] = silu_f(g0[i]) * u0[i]; h1[i] = silu_f(g1[i]) * u1[i]; }
                *(u32x4*)rowp = pack8(h0, h1); }
    }
};

typedef unsigned u32x2 __attribute__((ext_vector_type(2)));
__device__ __forceinline__ float clamp448(float x) { return fminf(fmaxf(x, -448.f), 448.f); }
__device__ __forceinline__ unsigned f8x4(float a, float b, float c, float d) { int p = 0; p = __builtin_amdgcn_cvt_pk_fp8_f32(clamp448(a), clamp448(b), p, false); p = __builtin_amdgcn_cvt_pk_fp8_f32(clamp448(c), clamp448(d), p, true); return (unsigned)p; }
struct EpiSwiglu8 {
    static constexpr bool PERM = true, AFTER_DRAIN = false;
    unsigned char* H; int ldh; int pm_off; float sg;
    __device__ __forceinline__ void operator()(const f32x4 (&acc)[2][2][4][2], const Unit& u, int wr, int wc, int fr, int fq) const {
        const int row0 = (u.pm - pm_off) * BM + wr * 64 + fr; const int col0 = u.pn * HALF + wc * 32 + 8 * fq;
#pragma unroll
        for (int ai = 0; ai < 2; ++ai)
#pragma unroll
            for (int m = 0; m < 4; ++m) { unsigned char* rowp = H + (size_t)(row0 + ai * HALF + m * 16) * ldh + col0;
                const f32x4 g0 = acc[ai][0][m][0] * sg, g1 = acc[ai][0][m][1] * sg, u0 = acc[ai][1][m][0] * sg, u1 = acc[ai][1][m][1] * sg; f32x4 h0, h1;
#pragma unroll
                for (int i = 0; i < 4; ++i) { h0[i] = silu_f(g0[i]) * u0[i]; h1[i] = silu_f(g1[i]) * u1[i]; }
                u32x2 w; w.x = f8x4(h0[0], h0[1], h0[2], h0[3]); w.y = f8x4(h1[0], h1[1], h1[2], h1[3]); *(u32x2*)rowp = w; }
    }
};
struct EpiF32s {
    static constexpr bool PERM = false, AFTER_DRAIN = false;
    float* C; int ldc; float s;
    __device__ __forceinline__ void operator()(const f32x4 (&acc)[2][2][4][2], const Unit& u, int wr, int wc, int fr, int fq) const {
        const int row0 = u.pm * BM + wr * 64 + fr, col0 = u.pn * BM + wc * 32 + 4 * fq;
#pragma unroll
        for (int ai = 0; ai < 2; ++ai)
#pragma unroll
            for (int m = 0; m < 4; ++m) { float* rowp = C + (size_t)(row0 + ai * HALF + m * 16) * ldc + col0;
#pragma unroll
                for (int bj = 0; bj < 2; ++bj)
#pragma unroll
                    for (int n = 0; n < 2; ++n) *(f32x4*)(rowp + bj * HALF + n * 16) = acc[ai][bj][m][n] * s; }
    }
};
struct EpiScatter {
    static constexpr bool PERM = true, AFTER_DRAIN = false;
    bf16_t* Y; const int* rowmap; const float* roww; int pm_off; int mtok; float s;
    __device__ __forceinline__ void operator()(const f32x4 (&acc)[2][2][4][2], const Unit& u, int wr, int wc, int fr, int fq) const {
        const int row0 = (u.pm + pm_off) * BM + wr * 64 + fr; const int col0 = u.pn * BM + wc * 32 + 8 * fq;
#pragma unroll
        for (int ai = 0; ai < 2; ++ai)
#pragma unroll
            for (int m = 0; m < 4; ++m) { const int r = row0 + ai * HALF + m * 16; const int ts = rowmap[r];
                if (ts >= 0) { const float w = roww[r] * s; bf16_t* rowp = Y + ((size_t)(ts & 1) * mtok + (ts >> 1)) * 1024 + col0;
#pragma unroll
                    for (int bj = 0; bj < 2; ++bj) *(u32x4*)(rowp + bj * HALF) = pack8(acc[ai][bj][m][0] * w, acc[ai][bj][m][1] * w); } }
    }
};
template <bool REL> struct GroupedOrder {
    int t0, nM, nN, nwg, G, c; const PG8_LAS int* texp;
    __device__ __forceinline__ void init(int t0_, int t1_, int nN_, int G_, int c_, const PG8_LAS int* texp_) { t0 = t0_; nM = t1_ - t0_; if (nM < 0) nM = 0; nN = nN_; nwg = nM * nN; G = G_; c = c_; texp = texp_; }
    __device__ __forceinline__ bool next(int i, Unit& u) const {
        const long L = (long)i * G + c; if (L >= nwg) return false;
        int wgid = (int)L; { const int q = nwg / NXCD, r = nwg % NXCD, xcd = wgid % NXCD, off = wgid / NXCD; wgid = (xcd < r ? xcd * (q + 1) : r * (q + 1) + (xcd - r) * q) + off; }
        const int nig = WGM * nN, gid = wgid / nig, fm = gid * WGM, gsz = (nM - fm) < WGM ? (nM - fm) : WGM;
        const int pmr = fm + ((wgid % nig) % gsz); u.pn = (wgid % nig) / gsz; u.pm = REL ? pmr : (t0 + pmr); u.pb = texp[t0 + pmr] * nN + u.pn; return true;
    }
    __device__ __forceinline__ void a_ready(const Unit&) const {}
    __device__ __forceinline__ void done(const Unit&) const {}
};
template <class Epi, class Sched, bool ALIGN_EPI = false, bool SP2 = false, bool F8 = false>
__device__ __forceinline__ void gemm_phase(PG8_LAS unsigned char* lds, const Gemm g, const Sched& S, const Epi& E) {
    const int tid = threadIdx.x, wid = __builtin_amdgcn_readfirstlane(tid >> 6), lane = tid & 63, wr = wid >> 2, wc = wid & 3, fr = lane & 15, fq = lane >> 4;
    const int K = g.K, nt = K / BK;
    unsigned voffA[2], voffB[2];
#pragma unroll
    for (int i = 0; i < 2; ++i) { int R, C; stage_rc(tid * 16 + i * 8192, R, C); const int Rb = Epi::PERM ? ((R & ~31) + perm32(R & 31)) : R;
        voffA[i] = (unsigned)(R * K + C) * 2u; voffB[i] = (unsigned)(Rb * K + C) * 2u; }
    const size_t kstep = (size_t)(BK * 2);
    const size_t hstep = (size_t)HALF * K * 2;
    const size_t tstep = 2 * hstep;
    const unsigned ldsw = (unsigned)wid * 1024u;
    const int aoff = lds_byte(wr * 64 + fr, fq * 8), boff = lds_byte(wc * 32 + fr, fq * 8);
#define PG8_SA(b, h) (((b) * 2 + (h)) * HTB)
#define PG8_SB(b, h) ((4 + (b) * 2 + (h)) * HTB)
#define PG8_STAGE(bufoff, gbase, voff) do { _Pragma("unroll") for (int _i = 0; _i < 2; ++_i) \
        __builtin_amdgcn_global_load_lds((const unsigned*)((const char*)(gbase) + (voff)[_i]), (PG8_LAS unsigned*)(lds + (bufoff) + ldsw + _i * 8192), 16, 0, 0); } while (0)
#define PG8_LDA(dst, b, h) do { if constexpr (F8) { _Pragma("unroll") for (int m = 0; m < 4; ++m) dst##8[m] = pg8_cat(*(const PG8_LAS bf16x8*)(lds + PG8_SA(b, h) + aoff + m * 2048), *(const PG8_LAS bf16x8*)(lds + PG8_SA(b, h) + aoff + m * 2048 + 1024)); } else { _Pragma("unroll") for (int m = 0; m < 4; ++m) _Pragma("unroll") for (int k = 0; k < 2; ++k) dst[m][k] = *(const PG8_LAS bf16x8*)(lds + PG8_SA(b, h) + aoff + m * 2048 + k * 1024); } } while (0)
#define PG8_LDB(dst, b, h) do { if constexpr (F8) { _Pragma("unroll") for (int n = 0; n < 2; ++n) dst##8[n] = pg8_cat(*(const PG8_LAS bf16x8*)(lds + PG8_SB(b, h) + boff + n * 2048), *(const PG8_LAS bf16x8*)(lds + PG8_SB(b, h) + boff + n * 2048 + 1024)); } else { _Pragma("unroll") for (int n = 0; n < 2; ++n) _Pragma("unroll") for (int k = 0; k < 2; ++k) dst[n][k] = *(const PG8_LAS bf16x8*)(lds + PG8_SB(b, h) + boff + n * 2048 + k * 1024); } } while (0)
#define PG8_MMA(ai, bj, At, Bt) do { __builtin_amdgcn_s_setprio(1); if constexpr (F8) { _Pragma("unroll") for (int m = 0; m < 4; ++m) _Pragma("unroll") for (int n = 0; n < 2; ++n) asm volatile("v_mfma_f32_16x16x128_f8f6f4 %0, %1, %2, %0" : "+v"(acc[ai][bj][m][n]) : "v"(Bt##8[n]), "v"(At##8[m])); } else { _Pragma("unroll") for (int m = 0; m < 4; ++m) _Pragma("unroll") for (int n = 0; n < 2; ++n) _Pragma("unroll") for (int k = 0; k < 2; ++k) acc[ai][bj][m][n] = __builtin_amdgcn_mfma_f32_16x16x32_bf16(Bt[n][k], At[m][k], acc[ai][bj][m][n], 0, 0, 0); } __builtin_amdgcn_s_setprio(0); } while (0)
#define PG8_WAIT_V(n) asm volatile("s_waitcnt vmcnt(" #n ")" ::: "memory")
#define PG8_WAIT_L(n) asm volatile("s_waitcnt lgkmcnt(" #n ")" ::: "memory")
#define PG8_BAR __builtin_amdgcn_s_barrier()
#define PG8_SCHED __builtin_amdgcn_sched_barrier(0)
    Unit cur, nxt; int ui = 0;
    if (!S.next(0, cur)) return;
    f32x4 acc[2][2][4][2];
#pragma unroll
    for (int a = 0; a < 2; ++a)
#pragma unroll
        for (int b = 0; b < 2; ++b)
#pragma unroll
            for (int m = 0; m < 4; ++m)
#pragma unroll
                for (int n = 0; n < 2; ++n) acc[a][b][m][n] = (f32x4){0.f, 0.f, 0.f, 0.f};
    bf16x8 At[4][2], B0[2][2], B1[2][2];
    v8i_t At8[4], B08[2], B18[2];
    const char* cA = (const char*)g.A + (size_t)cur.pm * tstep; const char* cB = (const char*)g.Bt + (size_t)cur.pb * tstep;
    S.a_ready(cur);
    if constexpr (SP2) {
        PG8_STAGE(PG8_SB(0, 0), cB, voffB); PG8_STAGE(PG8_SB(0, 1), cB + hstep, voffB); PG8_STAGE(PG8_SA(0, 0), cA, voffA); PG8_STAGE(PG8_SA(0, 1), cA + hstep, voffA);
        if (wr == 1) PG8_BAR;
        PG8_WAIT_V(2); PG8_BAR;
        PG8_STAGE(PG8_SB(1, 0), cB + kstep, voffB); PG8_STAGE(PG8_SA(1, 0), cA + kstep, voffA); PG8_STAGE(PG8_SB(1, 1), cB + hstep + kstep, voffB);
        PG8_WAIT_V(6); PG8_BAR;
    } else {
        PG8_STAGE(PG8_SB(0, 0), cB, voffB); PG8_STAGE(PG8_SA(0, 0), cA, voffA); PG8_STAGE(PG8_SB(0, 1), cB + hstep, voffB); PG8_STAGE(PG8_SA(0, 1), cA + hstep, voffA);
        if (wr == 1) PG8_BAR;
        PG8_WAIT_V(4); PG8_BAR;
        PG8_STAGE(PG8_SB(1, 0), cB + kstep, voffB); PG8_STAGE(PG8_SA(1, 0), cA + kstep, voffA); PG8_STAGE(PG8_SB(1, 1), cB + hstep + kstep, voffB);
        PG8_WAIT_V(6); PG8_BAR;
    }
    for (;;) {
        const bool has_next = S.next(ui + 1, nxt);
        const char* nA = has_next ? (const char*)g.A + (size_t)nxt.pm * tstep : cA; const char* nB = has_next ? (const char*)g.Bt + (size_t)nxt.pb * tstep : cB;
        for (int t = 0; t < nt; t += 2) {
            const bool last = (t == nt - 2);
            const char* a1 = cA + (size_t)(t + 1) * kstep;
            const char* a2 = last ? nA : cA + (size_t)(t + 2) * kstep; const char* b2 = last ? nB : cB + (size_t)(t + 2) * kstep;
            const char* a3 = a2 + kstep; const char* b3 = b2 + kstep;
            if (last && has_next) S.a_ready(nxt);
            if constexpr (SP2) {
            PG8_LDB(B0, 0, 0); PG8_LDB(B1, 0, 1); PG8_SCHED; PG8_LDA(At, 0, 0); PG8_STAGE(PG8_SA(1, 1), a1 + hstep, voffA);
            PG8_WAIT_V(8); PG8_WAIT_L(0); PG8_BAR; PG8_MMA(0, 0, At, B0); PG8_MMA(0, 1, At, B1); PG8_BAR; PG8_SCHED;
            PG8_LDA(At, 0, 1); PG8_STAGE(PG8_SB(0, 0), b2, voffB); PG8_STAGE(PG8_SB(0, 1), b2 + hstep, voffB); PG8_STAGE(PG8_SA(0, 0), a2, voffA);
            PG8_WAIT_V(8); PG8_WAIT_L(0); PG8_BAR; PG8_MMA(1, 0, At, B0); PG8_MMA(1, 1, At, B1); PG8_BAR; PG8_SCHED;
            PG8_LDB(B0, 1, 0); PG8_LDB(B1, 1, 1); PG8_SCHED; PG8_LDA(At, 1, 0); PG8_STAGE(PG8_SA(0, 1), a2 + hstep, voffA);
            PG8_WAIT_V(8); PG8_WAIT_L(0); PG8_BAR; PG8_MMA(0, 0, At, B0); PG8_MMA(0, 1, At, B1); PG8_BAR; PG8_SCHED;
            PG8_LDA(At, 1, 1); PG8_STAGE(PG8_SB(1, 0), b3, voffB); PG8_STAGE(PG8_SB(1, 1), b3 + hstep, voffB); PG8_STAGE(PG8_SA(1, 0), a3, voffA);
            PG8_WAIT_V(8); PG8_WAIT_L(0); PG8_BAR; PG8_MMA(1, 0, At, B0); PG8_MMA(1, 1, At, B1); PG8_BAR; PG8_SCHED;
            } else {
            PG8_LDB(B0, 0, 0); PG8_SCHED; PG8_LDA(At, 0, 0); PG8_STAGE(PG8_SA(1, 1), a1 + hstep, voffA);
            PG8_WAIT_L(8); PG8_BAR; PG8_WAIT_L(0); PG8_MMA(0, 0, At, B0); PG8_BAR; PG8_SCHED;
            PG8_LDB(B1, 0, 1); PG8_STAGE(PG8_SB(0, 0), b2, voffB);
            PG8_BAR; PG8_WAIT_L(0); PG8_MMA(0, 1, At, B1); PG8_BAR;
            PG8_LDA(At, 0, 1); PG8_STAGE(PG8_SA(0, 0), a2, voffA);
            PG8_BAR; PG8_WAIT_L(0); PG8_MMA(1, 0, At, B0); PG8_BAR; PG8_SCHED;
            PG8_STAGE(PG8_SB(0, 1), b2 + hstep, voffB);
            PG8_WAIT_V(6); PG8_BAR; PG8_MMA(1, 1, At, B1); PG8_BAR;
            PG8_LDB(B0, 1, 0); PG8_SCHED; PG8_LDA(At, 1, 0); PG8_STAGE(PG8_SA(0, 1), a2 + hstep, voffA);
            PG8_WAIT_L(8); PG8_BAR; PG8_WAIT_L(0); PG8_MMA(0, 0, At, B0); PG8_BAR; PG8_SCHED;
            PG8_LDB(B1, 1, 1); PG8_STAGE(PG8_SB(1, 0), b3, voffB);
            PG8_BAR; PG8_WAIT_L(0); PG8_MMA(0, 1, At, B1); PG8_BAR;
            PG8_LDA(At, 1, 1); PG8_STAGE(PG8_SA(1, 0), a3, voffA);
            PG8_BAR; PG8_WAIT_L(0); PG8_MMA(1, 0, At, B0); PG8_BAR; PG8_SCHED;
            PG8_STAGE(PG8_SB(1, 1), b3 + hstep, voffB);
            PG8_WAIT_V(6); PG8_BAR; PG8_MMA(1, 1, At, B1); PG8_BAR;
            }
        }
        if constexpr (F8) { asm volatile("s_nop 15\n\ts_nop 7" ::: "memory"); }
        if constexpr (ALIGN_EPI) { if (wr == 0) PG8_BAR; }
        if constexpr (!Epi::AFTER_DRAIN) { E(acc, cur, wr, wc, fr, fq); S.done(cur); }
        if (!has_next) break;
#pragma unroll
        for (int a = 0; a < 2; ++a)
#pragma unroll
            for (int b = 0; b < 2; ++b)
#pragma unroll
                for (int m = 0; m < 4; ++m)
#pragma unroll
                    for (int n = 0; n < 2; ++n) acc[a][b][m][n] = (f32x4){0.f, 0.f, 0.f, 0.f};
        cur = nxt; cA = nA; cB = nB; ++ui;
        if constexpr (ALIGN_EPI) { if (wr == 1) PG8_BAR; }
    }
    PG8_WAIT_V(0);
    if constexpr (!ALIGN_EPI) { if (wr == 0) PG8_BAR; }
    PG8_BAR;
    if constexpr (Epi::AFTER_DRAIN) { E.fused(acc, cur, wr, wc, fr, fq, lds, wid, lane); S.done(cur); }
#undef PG8_SA
#undef PG8_SB
#undef PG8_STAGE
#undef PG8_LDA
#undef PG8_LDB
#undef PG8_MMA
#undef PG8_WAIT_V
#undef PG8_WAIT_L
#undef PG8_BAR
#undef PG8_SCHED
}
}

constexpr int NWAVES = 8;
constexpr int BATCH = 2, SEQ = 8192, D = 1024, M = BATCH * SEQ;
constexpr int NPROJ = 3072, NIN = 3080;
constexpr int AH = 8, NB = 32;
constexpr int C_AQ = 0, C_AK = 512, C_AV = 1024, C_MQ = 1536, C_MK = 1792, C_MV = 2048, C_MO = 2560;
constexpr int MH = 4, MLC = 128, NCH = SEQ / MLC;
constexpr int DFF = 2816, NE = 8, DEX = 3584;
constexpr int MAXT = 136;
constexpr int CAP = 136;
constexpr float LN_EPS = 1e-5f, RMS_EPS = 1e-6f;
constexpr float ALPHA = 1.41421356237309515f;
constexpr float SW_UP = 32.f, SW_DN = 128.f;
constexpr float QSCALE = 0.125f * 1.4426950408889634f;

constexpr size_t MiB = 1u << 20;
constexpr size_t WS_CTL = 0, CTL_ZERO_BYTES = 1 * MiB;
constexpr size_t WS_ROPE = 1 * MiB;
constexpr size_t WS_GATES = 2 * MiB;
constexpr size_t WS_ROWMAP = 2 * MiB + 512 * 1024, WS_ROWW = 2 * MiB + 768 * 1024;
constexpr size_t WS_LIST = 3 * MiB, WS_LISTW = 3 * MiB + 512 * 1024;
constexpr size_t WS_WIN = 4 * MiB, WS_WOUT = 16 * MiB, WS_WGU = 20 * MiB, WS_WD = 31 * MiB;
constexpr size_t WS_MGU = 37 * MiB, WS_MD = 93 * MiB;
constexpr size_t WS_MIX2 = 37 * MiB;
constexpr size_t WS_QC = 37 * MiB, WS_KC = 45 * MiB, WS_DC = 53 * MiB, WS_CST = 69 * MiB, WS_DN = 77 * MiB, WS_NST = 77 * MiB + 256 * 1024, WS_SC = 77 * MiB + 512 * 1024, WS_MC = 77 * MiB + 768 * 1024;
constexpr size_t WS_PO = 80 * MiB, WS_PML = 128 * MiB, WS_SEL = 131 * MiB, WS_LISTQ = 132 * MiB;
constexpr size_t WS_CAT2 = 141 * MiB;
constexpr size_t WS_XB = 205 * MiB, WS_X1B = 237 * MiB, WS_XR = 269 * MiB, WS_PROJ = 333 * MiB, WS_CAT = 429 * MiB;
constexpr size_t WS_X1 = 429 * MiB;
constexpr size_t WS_MIX = 333 * MiB;
constexpr size_t WS_HD = 333 * MiB;
constexpr size_t WS_Y = 205 * MiB, WS_HM = 269 * MiB, WS_XS = 393 * MiB, WS_END = 461 * MiB;
static_assert(WS_HM + (size_t)CAP * 256 * DEX <= WS_XS && WS_XS + (size_t)MAXT * 256 * D <= WS_END, "MoE map");
static_assert(WS_HD + (size_t)M * DFF * 2 <= WS_CAT && WS_WD + (size_t)D * DFF * 2 <= WS_MGU && WS_WGU + (size_t)2 * DFF * D * 2 <= WS_WD, "map");
constexpr int CW_TMO = 0, CW_CODE = 1;
constexpr int CW_BAR = 4096;
constexpr int CW_ECNT = 16384;
constexpr int CW_DBG = 2048;
constexpr int CW_BCNT = 32768;
constexpr int CW_KSUM = 65536;

constexpr int LDS_BYTES = 147456;
constexpr int MISC_OFF = LDS_BYTES - 2048;
constexpr int TEXP_OFF = MISC_OFF + 256;
constexpr int XW_OFF = 100 * 1024;

#define GAS __attribute__((address_space(1)))
#define LAS __attribute__((address_space(3)))
typedef unsigned short bf16;
typedef unsigned v4u __attribute__((ext_vector_type(4)));
typedef unsigned v2u __attribute__((ext_vector_type(2)));
typedef float f32x4 __attribute__((ext_vector_type(4)));
typedef GAS unsigned gu32;
#define RLX_AGENT __ATOMIC_RELAXED, __HIP_MEMORY_SCOPE_AGENT
#define LDS_WAIT() asm volatile("s_waitcnt lgkmcnt(0)" ::: "memory")
#define VM_WAIT() asm volatile("s_waitcnt vmcnt(0)" ::: "memory")
__device__ __forceinline__ unsigned f2bf(float f) { unsigned u = __builtin_bit_cast(unsigned, f); return (u + 0x7fffu + ((u >> 16) & 1u)) >> 16; }
__device__ __forceinline__ unsigned pk2(float lo, float hi) { return f2bf(lo) | (f2bf(hi) << 16); }
__device__ __forceinline__ float bf2f(unsigned short h) { return __builtin_bit_cast(float, (unsigned)h << 16); }
__device__ __forceinline__ float bflo(unsigned w) { return __builtin_bit_cast(float, w << 16); }
__device__ __forceinline__ float bfhi(unsigned w) { return __builtin_bit_cast(float, w & 0xffff0000u); }

#ifdef PROBE_SEG
#define PSEG(id) do { if (blockIdx.x == 0 && threadIdx.x == 0) { LAS unsigned long long* sg_ = (LAS unsigned long long*)(F.lds + MISC_OFF + 1536); const unsigned long long n_ = __builtin_amdgcn_s_memrealtime(); sg_[1 + (id)] += n_ - sg_[0]; sg_[0] = n_; } } while (0)
#else
#define PSEG(id)
#endif
#define XB_TMO      128
#define XB_XCNT(j)  (256  + 64 * (j))
#define XB_XSUB(j)  (1280 + 64 * (j))
#define XB_XGEN(j)  (2304 + 64 * (j))
#define XB_TOP      3328
#define XB_TOPGEN   3392
#define XCD_BAR_WORDS 3456
#define XB_SPIN_CAP (1u << 18)

__device__ __forceinline__ unsigned xb_ld(unsigned* p)              { return __hip_atomic_load(p, __ATOMIC_RELAXED, __HIP_MEMORY_SCOPE_AGENT); }
__device__ __forceinline__ unsigned xb_add(unsigned* p, unsigned v) { return __hip_atomic_fetch_add(p, v, __ATOMIC_RELAXED, __HIP_MEMORY_SCOPE_AGENT); }
__device__ __forceinline__ unsigned xb_xcc_id() { return (unsigned)__builtin_amdgcn_s_getreg((3 << 11) | 20) & 0xFu; }
#define XB_SPIN(cond, bar) do { unsigned _sp = 0; while (cond) { __builtin_amdgcn_s_sleep(1); \
    if ((++_sp & 255u) == 0u) { if (xb_ld(&(bar)[XB_TMO])) break; if (_sp > XB_SPIN_CAP) { atomicAdd(&(bar)[XB_TMO], 1u); break; } } } } while (0)

struct XcdBarrier {
    unsigned* bar; unsigned x;
    volatile LAS unsigned* st;
};

__device__ __forceinline__ XcdBarrier xcd_barrier_post(unsigned* bar, volatile LAS unsigned* st) {
    XcdBarrier b; b.bar = bar; b.x = xb_xcc_id(); b.st = st;
    if (threadIdx.x == 0) (void)xb_add(&bar[XB_XCNT(b.x)], 1u);
    return b;
}
__device__ __forceinline__ void xcd_barrier_complete(unsigned* bar, unsigned x, unsigned& nloc, unsigned& nx) {
    const unsigned G = gridDim.x * gridDim.y * gridDim.z;
    unsigned sum, cnt, mine, sp = 0u;
    for (;;) {
        sum = 0u; cnt = 0u; mine = 0u;
#pragma unroll
        for (unsigned j = 0; j < 16; ++j) { const unsigned c = xb_ld(&bar[XB_XCNT(j)]); sum += c; cnt += (c > 0u) ? 1u : 0u; mine = (j == x) ? c : mine; }
        if (sum == G) break;
        __builtin_amdgcn_s_sleep(1);
        if ((++sp & 255u) == 0u) { if (xb_ld(&bar[XB_TMO])) break; if (sp > XB_SPIN_CAP) { atomicAdd(&bar[XB_TMO], 1u); break; } }
    }
    nloc = mine > 0u ? mine : 1u; nx = cnt > 0u ? cnt : 1u;
}

__device__ __forceinline__ void xcd_barrier(const XcdBarrier& b) {
    asm volatile("s_waitcnt vmcnt(0)" ::: "memory");
    __syncthreads();
    if (threadIdx.x == 0) {
        unsigned* bar = b.bar;
        __builtin_amdgcn_s_waitcnt(0);
        unsigned nloc = b.st[0], nx = b.st[1];
        if (nloc == 0u) { xcd_barrier_complete(bar, b.x, nloc, nx); b.st[0] = nloc; b.st[1] = nx; }
        const unsigned old = xb_add(&bar[XB_XSUB(b.x)], 1u);
        const unsigned gen = old / nloc;
        if (old + 1u == (gen + 1u) * nloc) {
            __builtin_amdgcn_fence(__ATOMIC_RELEASE, "agent");
            asm volatile("s_waitcnt vmcnt(0)" ::: "memory");
            const unsigned og = xb_add(&bar[XB_TOP], 1u);
            const unsigned tg = og / nx;
            if (og + 1u == (tg + 1u) * nx) xb_add(&bar[XB_TOPGEN], 1u);
            else XB_SPIN(xb_ld(&bar[XB_TOPGEN]) == tg, bar);
            __builtin_amdgcn_fence(__ATOMIC_ACQUIRE, "agent");
            xb_add(&bar[XB_XGEN(b.x)], 1u);
            asm volatile("s_waitcnt vmcnt(0)" ::: "memory");
        } else {
            XB_SPIN(xb_ld(&bar[XB_XGEN(b.x)]) == gen, bar);
            __builtin_amdgcn_fence(__ATOMIC_ACQUIRE, "agent");
            asm volatile("s_waitcnt vmcnt(0)" ::: "memory");
        }
    }
    __syncthreads();
}

struct Frame {
    LAS unsigned char* lds;
    volatile LAS unsigned* MISC;
    gu32* ctl;
    int tid, lane, wave;
    int vcu, G;
    unsigned char* ws;
};
__device__ __forceinline__ float wave_sum(float v) {
#pragma unroll
    for (int o = 1; o < 64; o <<= 1) v += __shfl_xor(v, o);
    return v;
}
__device__ __forceinline__ float wave_max(float v) {
#pragma unroll
    for (int o = 1; o < 64; o <<= 1) v = fmaxf(v, __shfl_xor(v, o));
    return v;
}
__device__ __forceinline__ void transpose_item(const float* W, int ldw, int k0, int n0, bf16* WT, int K, int drow0, LAS float* scr, int lane) {
    float tv[32];
#pragma unroll
    for (int i = 0; i < 32; ++i) { const int kk = 2 * i + (lane >> 5); tv[i] = W[(size_t)(k0 + kk) * ldw + n0 + (lane & 31)]; }
#pragma unroll
    for (int i = 0; i < 32; ++i) { const int kk = 2 * i + (lane >> 5); scr[kk * 33 + (lane & 31)] = tv[i]; }
    LDS_WAIT(); asm volatile("" ::: "memory");
    const int c = lane & 7;
#pragma unroll
    for (int j = 0; j < 4; ++j) { const int n = (lane >> 3) + 8 * j; const LAS float* s = scr + (8 * c) * 33 + n;
        v4u o; o.x = pk2(s[0 * 33], s[1 * 33]); o.y = pk2(s[2 * 33], s[3 * 33]); o.z = pk2(s[4 * 33], s[5 * 33]); o.w = pk2(s[6 * 33], s[7 * 33]);
        *(GAS v4u*)(WT + (size_t)(drow0 + n) * K + k0 + 8 * c) = o; }
    LDS_WAIT(); asm volatile("" ::: "memory");
}
__device__ __forceinline__ void cvt_plain(const float* W, int ldw, int coff, int K, int N, bf16* WT, LAS float* scr, int it, int lane) {
    const int nblk = N / 32, kb = it / nblk, nb = it % nblk; transpose_item(W, ldw, 64 * kb, coff + 32 * nb, WT, K, 32 * nb, scr, lane);
}
__device__ __forceinline__ void cvt_gu(const float* Wg, const float* Wu, int K, int N, bf16* WT, LAS float* scr, int it, int lane) {
    const int nblk = N / 32, per = (K / 64) * nblk; const int isu = it >= per; if (isu) it -= per; const int kb = it / nblk, nb = it % nblk, n0 = 32 * nb;
    transpose_item(isu ? Wu : Wg, N, 64 * kb, n0, WT, K, (n0 / 128) * 256 + (n0 % 128) + (isu ? 128 : 0), scr, lane);
}

__device__ __forceinline__ void transpose_item8(const float* W, int ldw, int k0, int n0, unsigned char* WT, int K, int drow0, LAS float* scr, int lane, float sc) {
    float tv[32];
#pragma unroll
    for (int i = 0; i < 32; ++i) { const int kk = 2 * i + (lane >> 5); tv[i] = W[(size_t)(k0 + kk) * ldw + n0 + (lane & 31)]; }
#pragma unroll
    for (int i = 0; i < 32; ++i) { const int kk = 2 * i + (lane >> 5); scr[kk * 33 + (lane & 31)] = tv[i] * sc; }
    LDS_WAIT(); asm volatile("" ::: "memory");
    const int c = lane & 7;
#pragma unroll
    for (int j = 0; j < 4; ++j) { const int n = (lane >> 3) + 8 * j; const LAS float* s = scr + (8 * c) * 33 + n;
        v2u o; o.x = pg8::f8x4(s[0 * 33], s[1 * 33], s[2 * 33], s[3 * 33]); o.y = pg8::f8x4(s[4 * 33], s[5 * 33], s[6 * 33], s[7 * 33]);
        *(GAS v2u*)(WT + (size_t)(drow0 + n) * K + k0 + 8 * c) = o; }
    LDS_WAIT(); asm volatile("" ::: "memory");
}

struct CvtItem { const float* W; int ldw, k0, n0; unsigned char* WT; int K, drow0; float sc; };
__device__ __forceinline__ void cvt8_load(const CvtItem& c, int lane, float (&tv)[32]) {
#pragma unroll
    for (int i = 0; i < 32; ++i) { const int kk = 2 * i + (lane >> 5); tv[i] = c.W[(size_t)(c.k0 + kk) * c.ldw + c.n0 + (lane & 31)]; }
}
__device__ __forceinline__ void cvt8_finish(const CvtItem& c, const float (&tv)[32], LAS float* scr, int lane) {
#pragma unroll
    for (int i = 0; i < 32; ++i) { const int kk = 2 * i + (lane >> 5); scr[kk * 33 + (lane & 31)] = tv[i] * c.sc; }
    LDS_WAIT(); asm volatile("" ::: "memory");
    const int cc = lane & 7;
#pragma unroll
    for (int j = 0; j < 4; ++j) { const int n = (lane >> 3) + 8 * j; const LAS float* s = scr + (8 * cc) * 33 + n;
        v2u o; o.x = pg8::f8x4(s[0 * 33], s[1 * 33], s[2 * 33], s[3 * 33]); o.y = pg8::f8x4(s[4 * 33], s[5 * 33], s[6 * 33], s[7 * 33]);
        *(GAS v2u*)(c.WT + (size_t)(c.drow0 + n) * c.K + c.k0 + 8 * cc) = o; }
    LDS_WAIT(); asm volatile("" ::: "memory");
}
__device__ __forceinline__ void cvt_plain8(const float* W, int ldw, int coff, int K, int N, unsigned char* WT, LAS float* scr, int it, int lane, float sc) {
    const int nblk = N / 32, kb = it / nblk, nb = it % nblk; transpose_item8(W, ldw, 64 * kb, coff + 32 * nb, WT, K, 32 * nb, scr, lane, sc);
}
__device__ __forceinline__ void cvt_gu8(const float* Wg, const float* Wu, int K, int N, unsigned char* WT, LAS float* scr, int it, int lane, float sc) {
    const int nblk = N / 32, per = (K / 64) * nblk; const int isu = it >= per; if (isu) it -= per; const int kb = it / nblk, nb = it % nblk, n0 = 32 * nb;
    transpose_item8(isu ? Wu : Wg, N, 64 * kb, n0, WT, K, (n0 / 128) * 256 + (n0 % 128) + (isu ? 128 : 0), scr, lane, sc);
}

__device__ __forceinline__ void store_row_f8(unsigned char* orow, const f32x4 (&y)[4], int lane) {
    GAS unsigned* o4 = (GAS unsigned*)orow + lane;
#pragma unroll
    for (int j = 0; j < 4; ++j) o4[64 * j] = pg8::f8x4(y[j][0], y[j][1], y[j][2], y[j][3]);
}
__device__ __forceinline__ void stage_xw(Frame& F, const float* W, int ldw, int coff) {
    LAS float* xw = (LAS float*)(F.lds + XW_OFF);
    for (int idx = F.tid; idx < 8192; idx += NWAVES * 64) { const int k = idx >> 3, g = idx & 7; xw[g * 1024 + k] = W[(size_t)k * ldw + coff + g]; }
    LDS_WAIT(); __syncthreads();
}
__device__ __forceinline__ void row_dot8(Frame& F, const f32x4 (&v)[4], float (&acc)[8]) {
    const LAS f32x4* xw = (const LAS f32x4*)(F.lds + XW_OFF);
#pragma unroll
    for (int g = 0; g < 8; ++g) { float a = 0.f;
#pragma unroll
        for (int j = 0; j < 4; ++j) { const f32x4 w = xw[g * 256 + j * 64 + F.lane]; a += v[j][0] * w[0] + v[j][1] * w[1] + v[j][2] * w[2] + v[j][3] * w[3]; }
        acc[g] = wave_sum(a); }
}
__device__ __forceinline__ float log_sigmoid(float x) { return fminf(x, 0.f) - log1pf(expf(-fabsf(x))); }
__device__ __forceinline__ void store_row_bf16(bf16* orow, const f32x4 (&y)[4], int lane) {
    GAS unsigned long long* o8 = (GAS unsigned long long*)orow + lane;
#pragma unroll
    for (int j = 0; j < 4; ++j) o8[64 * j] = (unsigned long long)pk2(y[j][0], y[j][1]) | ((unsigned long long)pk2(y[j][2], y[j][3]) << 32);
}
__device__ __forceinline__ void write_gates(Frame& F, const f32x4 (&y)[4], const float* gbias, float* grow) {
    float a[8]; row_dot8(F, y, a);
    if (F.lane < 8) { float r = 0.f;
#pragma unroll
        for (int g = 0; g < 8; ++g) if (F.lane == g) r = a[g];
        r += gbias[F.lane]; if (F.lane >= 4) r = log_sigmoid(r); grow[F.lane] = r; }
}
struct In {
    const float* x; const int* pos; const float *w_in, *gate_bias, *conv_w, *conv_b, *norm_attn, *norm_ml, *w_out, *ln1_g, *ln1_b, *dg, *du, *dd, *router_w, *router_b, *mg, *mu, *md, *ln2_g, *ln2_b;
};
__device__ __forceinline__ void p_prologue(Frame& F, const In& I) {
    unsigned char* ws = F.ws;
    stage_xw(F, I.w_in, NIN, NPROJ);
    LAS float* scr = (LAS float*)(F.lds + F.wave * 8704);
    const int gw = F.vcu * NWAVES + F.wave, NGW = F.G * NWAVES;
    constexpr int I_IN = (D / 64) * (NPROJ / 32), I_OUT = (D / 64) * (D / 32), I_GU = 2 * (D / 64) * (DFF / 32), I_DD = (DFF / 64) * (D / 32);
    constexpr int NITEMS = 2 * I_IN + 2 * I_OUT + I_GU + I_DD;
    for (int it = gw; it < NITEMS; it += NGW) {
        int r = it;
        if (r < 2 * I_IN) { const int l = r / I_IN; r -= l * I_IN; cvt_plain(I.w_in + (size_t)l * D * NIN, NIN, 0, D, NPROJ, (bf16*)(ws + WS_WIN) + (size_t)l * NPROJ * D, scr, r, F.lane); continue; } r -= 2 * I_IN;
        if (r < 2 * I_OUT) { const int l = r / I_OUT; r -= l * I_OUT; cvt_plain(I.w_out + (size_t)l * D * D, D, 0, D, D, (bf16*)(ws + WS_WOUT) + (size_t)l * D * D, scr, r, F.lane); continue; } r -= 2 * I_OUT;
        if (r < I_GU) { cvt_gu8(I.dg, I.du, D, DFF, ws + WS_WGU, scr, r, F.lane, SW_UP); continue; } r -= I_GU;
        cvt_plain8(I.dd, D, 0, DFF, D, ws + WS_WD, scr, r, F.lane, SW_DN);
    }
    for (int e = blockIdx.x * (NWAVES * 64) + F.tid; e < M * 8; e += F.G * NWAVES * 64) { const int row = e >> 3, i = e & 7;
        const float inv = powf(500000.0f, -(float)i / 8.0f); const float ang = (float)I.pos[row] * inv; float s, c; sincosf(ang, &s, &c);
        float* rp = (float*)(ws + WS_ROPE) + (size_t)row * 16; rp[i] = c; rp[8 + i] = s; }
    for (int m = gw; m < M; m += NGW) { const GAS f32x4* xr = (const GAS f32x4*)(I.x + (size_t)m * D) + F.lane; f32x4 v[4];
#pragma unroll
        for (int j = 0; j < 4; ++j) v[j] = xr[64 * j];
        store_row_bf16((bf16*)(ws + WS_XB) + (size_t)m * D, v, F.lane);
        write_gates(F, v, I.gate_bias, (float*)(ws + WS_GATES) + (size_t)m * 8); }
}
__device__ __forceinline__ f32x4 ld_bf16x4(const bf16* p) { const v2u w = *(const GAS v2u*)p; return (f32x4){bflo(w.x), bfhi(w.x), bflo(w.y), bfhi(w.y)}; }
template <bool RESF, bool ADD2, int EXTRA>
__device__ __forceinline__ void ln_phase(Frame& F, const float* resf, const bf16* resb, const bf16* y0, const bf16* y1, const float* g, const float* bt, float* outf, bf16* outb, unsigned char* out8,
                                         const float* xbias, float* gates_out, int* list, float* listw, float oscale) {
    const int gw = F.vcu * NWAVES + F.wave, NGW = F.G * NWAVES;
    LAS int* rcnt = (LAS int*)(F.lds + XW_OFF + 32768); LAS int* rbase = rcnt + 8; LAS int* rent = rcnt + 16; int rloc = 0; const bool ragg = (M + NGW - 1) / NGW <= 8;
    if (EXTRA == 2) { if (F.tid < 8) rcnt[F.tid] = 0; for (int i = F.tid; i < 128; i += NWAVES * 64) rent[i * 4] = -1; LDS_WAIT(); __syncthreads(); }
    f32x4 gv[4], bv[4];
#pragma unroll
    for (int j = 0; j < 4; ++j) { gv[j] = ((const GAS f32x4*)g)[64 * j + F.lane]; bv[j] = ((const GAS f32x4*)bt)[64 * j + F.lane]; }
    for (int m = gw; m < M; m += NGW) {
        f32x4 v[4]; float s = 0.f;
#pragma unroll
        for (int j = 0; j < 4; ++j) { const size_t o = (size_t)m * D + 256 * j + 4 * F.lane;
            const f32x4 r = RESF ? *(const GAS f32x4*)(resf + o) : ld_bf16x4(resb + o); f32x4 a = ld_bf16x4(y0 + o); if (ADD2) a = a + ld_bf16x4(y1 + o);
            v[j] = r * ALPHA + a; }
#pragma unroll
        for (int j = 0; j < 4; ++j) s += (v[j][0] + v[j][1]) + (v[j][2] + v[j][3]);
        const float mean = wave_sum(s) * (1.f / D); float s2 = 0.f;
#pragma unroll
        for (int j = 0; j < 4; ++j) { v[j] = v[j] - mean; s2 += (v[j][0] * v[j][0] + v[j][1] * v[j][1]) + (v[j][2] * v[j][2] + v[j][3] * v[j][3]); }
        const float rstd = 1.f / sqrtf(wave_sum(s2) * (1.f / D) + LN_EPS);
#pragma unroll
        for (int j = 0; j < 4; ++j) v[j] = (v[j] * rstd * gv[j] + bv[j]) * oscale;
        if (outf) { GAS f32x4* of = (GAS f32x4*)(outf + (size_t)m * D) + F.lane;
#pragma unroll
            for (int j = 0; j < 4; ++j) of[64 * j] = v[j]; }
        if (outb) store_row_bf16(outb + (size_t)m * D, v, F.lane);
        if (out8) store_row_f8(out8 + (size_t)m * D, v, F.lane);
        if (EXTRA == 1) write_gates(F, v, xbias, gates_out + (size_t)m * 8);
        if (EXTRA == 2) { float a[8]; row_dot8(F, v, a);
#pragma unroll
            for (int e = 0; e < 8; ++e) a[e] += xbias[e];
            int i0 = 0; float v0 = a[0];
#pragma unroll
            for (int e = 1; e < 8; ++e) if (a[e] > v0) { v0 = a[e]; i0 = e; }
            int i1 = -1; float v1 = -INFINITY;
#pragma unroll
            for (int e = 0; e < 8; ++e) if (e != i0 && a[e] > v1) { v1 = a[e]; i1 = e; }
            const float w1 = 1.f / (1.f + expf(v0 - v1)), w0 = 1.f - w1;
            if (F.lane < 2) { const int e = F.lane ? i1 : i0; const float w = F.lane ? w1 : w0; const int ri = F.wave * 16 + rloc * 2 + F.lane;
                if (ragg) { const int lp = __hip_atomic_fetch_add(rcnt + e, 1, __ATOMIC_RELAXED, __HIP_MEMORY_SCOPE_WORKGROUP);
                    rent[ri * 4] = m * 2 + F.lane; rent[ri * 4 + 1] = __builtin_bit_cast(int, w); rent[ri * 4 + 2] = e; rent[ri * 4 + 3] = lp; }
                else { const unsigned p = __hip_atomic_fetch_add((unsigned*)(F.ctl + CW_ECNT + 64 * e), 1u, RLX_AGENT); list[(size_t)e * M + p] = m * 2 + F.lane; listw[(size_t)e * M + p] = w; } }
            ++rloc; }
    }
    if (EXTRA == 2) {
        LDS_WAIT(); __syncthreads();
        if (F.tid < 8) { const int c = rcnt[F.tid]; rbase[F.tid] = c > 0 ? (int)__hip_atomic_fetch_add((unsigned*)(F.ctl + CW_ECNT + 64 * F.tid), (unsigned)c, RLX_AGENT) : 0; }
        LDS_WAIT(); __syncthreads();
        for (int ri = F.tid; ri < 128; ri += NWAVES * 64) { const int ts = rent[ri * 4]; if (ts >= 0) { const int e = rent[ri * 4 + 2], p = rbase[e] + rent[ri * 4 + 3]; list[(size_t)e * M + p] = ts; listw[(size_t)e * M + p] = __builtin_bit_cast(float, rent[ri * 4 + 1]); } }
        __syncthreads();
    }
}
__device__ __forceinline__ int moe_plan(Frame& F) {
    LAS int* texp = (LAS int*)(F.lds + TEXP_OFF);
    if (F.tid == 0) { int t = 0;
        for (int e = 0; e < NE; ++e) { const int c = (int)__hip_atomic_load((unsigned*)(F.ctl + CW_ECNT + 64 * e), RLX_AGENT); const int nt = (c + 255) >> 8; texp[MAXT + 1 + e] = t * 256;
            for (int k = 0; k < nt && t < MAXT; ++k) texp[t++] = e; }
        texp[MAXT] = t; }
    LDS_WAIT(); __syncthreads();
    return texp[MAXT];
}
__device__ __forceinline__ void moe_gather(Frame& F, int ntiles, const unsigned char* X1B, unsigned char* XS, const int* list, const float* listw, int* rowmap, float* roww) {
    const LAS int* texp = (const LAS int*)(F.lds + TEXP_OFF);
    const int gw = F.vcu * NWAVES + F.wave, NGW = F.G * NWAVES;
    for (int r0 = gw; r0 < ntiles * 256; r0 += 4 * NGW) {
        int ts[4]; float w[4]; v4u a[4];
#pragma unroll
        for (int q = 0; q < 4; ++q) { const int r = r0 + q * NGW; ts[q] = -1; w[q] = 0.f;
            if (r < ntiles * 256) { const int e = texp[r >> 8], i = r - texp[MAXT + 1 + e]; const int c = (int)__hip_atomic_load((unsigned*)(F.ctl + CW_ECNT + 64 * e), RLX_AGENT);
                if (i < c) { ts[q] = list[(size_t)e * M + i]; w[q] = listw[(size_t)e * M + i]; } } }
#pragma unroll
        for (int q = 0; q < 4; ++q) { a[q] = (v4u){0u, 0u, 0u, 0u}; if (ts[q] >= 0) a[q] = ((const GAS v4u*)(X1B + (size_t)(ts[q] >> 1) * D))[F.lane]; }
#pragma unroll
        for (int q = 0; q < 4; ++q) { const int r = r0 + q * NGW;
            if (r < ntiles * 256) { ((GAS v4u*)(XS + (size_t)r * D))[F.lane] = a[q]; if (F.lane == 0) { rowmap[r] = ts[q]; roww[r] = w[q]; } } } }
}
__device__ __forceinline__ CvtItem moe_cvt_item(Frame& F, const In& I, int it) {
    constexpr int I_G = (D / 64) * (DEX / 32), I_GU = 2 * I_G, I_DD = (DEX / 64) * (D / 32), PER = I_GU + I_DD;
    const int e = it / PER; int r = it - e * PER; CvtItem c;
    if (r < I_GU) { const int isu = r >= I_G; if (isu) r -= I_G; const int nblk = DEX / 32, kb = r / nblk, nb = r % nblk, n0 = 32 * nb;
        c.W = (isu ? I.mu : I.mg) + (size_t)e * D * DEX; c.ldw = DEX; c.k0 = 64 * kb; c.n0 = n0; c.WT = F.ws + WS_MGU + (size_t)e * 2 * DEX * D; c.K = D; c.drow0 = (n0 / 128) * 256 + (n0 % 128) + (isu ? 128 : 0); c.sc = SW_UP; }
    else { r -= I_GU; const int nblk = D / 32, kb = r / nblk, nb = r % nblk;
        c.W = I.md + (size_t)e * DEX * D; c.ldw = D; c.k0 = 64 * kb; c.n0 = 32 * nb; c.WT = F.ws + WS_MD + (size_t)e * D * DEX; c.K = DEX; c.drow0 = 32 * nb; c.sc = SW_DN; }
    return c;
}
__device__ __forceinline__ void moe_cvt(Frame& F, const In& I) {
    LAS float* scr = (LAS float*)(F.lds + F.wave * 8704);
    const int gw = F.vcu * NWAVES + F.wave, NGW = F.G * NWAVES;
    constexpr int NIT = NE * (2 * (D / 64) * (DEX / 32) + (DEX / 64) * (D / 32));
    int it = gw; if (it >= NIT) return;
    CvtItem cur = moe_cvt_item(F, I, it); float tv[32]; cvt8_load(cur, F.lane, tv);
    for (;;) { const int nx = it + NGW; const bool more = nx < NIT; CvtItem nxt = cur; float nv[32];
        if (more) { nxt = moe_cvt_item(F, I, nx); cvt8_load(nxt, F.lane, nv); }
        cvt8_finish(cur, tv, scr, F.lane);
        if (!more) break;
#pragma unroll
        for (int i = 0; i < 32; ++i) tv[i] = nv[i];
        cur = nxt; it = nx; }
}

__device__ __forceinline__ float dot64_bf16(const LAS float* qs, const bf16* kr) {
    const GAS v4u* kp = (const GAS v4u*)kr; float a = 0.f;
#pragma unroll
    for (int c = 0; c < 8; ++c) { const v4u w = kp[c]; const LAS f32x4* q4 = (const LAS f32x4*)(qs + 8 * c); const f32x4 qa = q4[0], qb = q4[1];
        a += qa[0] * bflo(w.x) + qa[1] * bfhi(w.x) + qa[2] * bflo(w.y) + qa[3] * bfhi(w.y) + qb[0] * bflo(w.z) + qb[1] * bfhi(w.z) + qb[2] * bflo(w.w) + qb[3] * bfhi(w.w); }
    return a;
}
__device__ __forceinline__ void attn_naive(Frame& F, const bf16* PROJ, const float* ksum, const float* norm_attn, bf16* CAT, int w_lo, int w_n) {
    LAS float* qs = (LAS float*)(F.lds + F.wave * 4608); LAS float* ps = qs + 64;
    const int lane = F.lane; const int gwa = F.vcu * NWAVES + F.wave - w_lo;
    if (gwa < 0) return;
    for (int task = gwa; task < M * AH; task += w_n) {
        const int bh = task >> 13, t = task & 8191, b = bh >> 3, h = bh & 7; const size_t row = (size_t)b * SEQ + t; const int blk = t >> 8;
        qs[lane] = bf2f(PROJ[row * NPROJ + C_AQ + h * 64 + lane]); LDS_WAIT();
        float g = -INFINITY;
        if (lane < blk) { const float* km = ksum + ((size_t)(b * NB + lane) * 512 + h * 64); float a = 0.f;
            for (int d = 0; d < 64; ++d) a += qs[d] * km[d];
            g = a; }
        int sel[3];
#pragma unroll
        for (int k = 0; k < 3; ++k) { float v = g; int idx = lane;
#pragma unroll
            for (int o = 1; o < 64; o <<= 1) { const float ov = __shfl_xor(v, o); const int oi = __shfl_xor(idx, o); if (ov > v || (ov == v && oi < idx)) { v = ov; idx = oi; } }
            idx = __builtin_amdgcn_readfirstlane(idx); const bool ok = __builtin_amdgcn_readfirstlane(v > -INFINITY ? 1 : 0) != 0;
            sel[k] = ok ? idx : -1; if (lane == idx) g = -INFINITY; }
        float sc[4][4]; float mx = -INFINITY;
#pragma unroll
        for (int s = 0; s < 4; ++s) { const int jb = (s < 3) ? sel[s] : blk;
#pragma unroll
            for (int i = 0; i < 4; ++i) { float a = -INFINITY;
                if (jb >= 0) { const int kp = jb * 256 + i * 64 + lane; if (s < 3 || kp <= t) a = dot64_bf16(qs, PROJ + ((size_t)b * SEQ + kp) * NPROJ + C_AK + h * 64); }
                sc[s][i] = a; mx = fmaxf(mx, a); } }
        mx = wave_max(mx); float sum = 0.f;
#pragma unroll
        for (int s = 0; s < 4; ++s)
#pragma unroll
            for (int i = 0; i < 4; ++i) { const float p = __builtin_amdgcn_exp2f(sc[s][i] - mx); sum += p; ps[s * 256 + i * 64 + lane] = p; }
        sum = wave_sum(sum); LDS_WAIT();
        float o = 0.f;
#pragma unroll
        for (int s = 0; s < 4; ++s) { const int jb = (s < 3) ? sel[s] : blk; if (jb < 0) continue; const int kmax = (s < 3) ? 256 : (t - blk * 256 + 1);
            const bf16* vb = PROJ + ((size_t)b * SEQ + jb * 256) * NPROJ + C_AV + h * 64 + lane;
#pragma unroll 8
            for (int k = 0; k < kmax; ++k) o += ps[s * 256 + k] * bf2f(vb[(size_t)k * NPROJ]); }
        o = o / sum; const float ms = wave_sum(o * o) * (1.f / 64.f);
        o = o * (1.f / sqrtf(ms + RMS_EPS)) * norm_attn[h * 64 + lane];
        CAT[row * D + h * 64 + lane] = (bf16)f2bf(o);
        LDS_WAIT();
    }
}
__device__ __forceinline__ void mlstm_naive(Frame& F, int bh, const bf16* PROJ, const float* GATES, const float* conv_w, const float* conv_b, const float* norm_ml, bf16* CAT) {
    const int b = bh >> 2, h = bh & 3, tid = F.tid;
    LAS float* Cst = (LAS float*)(F.lds);
    LAS float* nst = (LAS float*)(F.lds + 33280);
    LAS float* qf = (LAS float*)(F.lds + 33792);
    LAS float* kf = (LAS float*)(F.lds + 67072);
    LAS bf16* vb = (LAS bf16*)(F.lds + 100352);
    LAS float* bs = (LAS float*)(F.lds + 133120);
    LAS float* ig = bs + 128;
    LAS float* mt = bs + 256;
    LAS float* wst = bs + 384;
    LAS float* scal = bs + 512;
    for (int e = tid; e < 128 * 65; e += 512) Cst[e] = 0.f;
    if (tid < 64) nst[tid] = 0.f;
    if (tid == 0) scal[0] = 0.f;
    __syncthreads();
    for (int c = 0; c < NCH; ++c) {
        const size_t row0 = (size_t)b * SEQ + (size_t)c * MLC;
        if (tid < 128) { ig[tid] = GATES[(row0 + tid) * 8 + h]; bs[tid] = GATES[(row0 + tid) * 8 + 4 + h]; }
        for (int e = tid; e < 128 * 128; e += 512) { const int t = e >> 7, cc = e & 127; const int isk = cc >> 6, d = cc & 63; const int ch = isk * 256 + h * 64 + d;
            float a = conv_b[ch];
#pragma unroll
            for (int j = 0; j < 4; ++j) { const int tt = c * MLC + t - 3 + j; if (tt >= 0) a += conv_w[j * 512 + ch] * bf2f(PROJ[((size_t)b * SEQ + tt) * NPROJ + C_MQ + ch]); }
            a = a / (1.f + expf(-a));
            if (isk) kf[t * 65 + d] = a; else qf[t * 65 + d] = a * 0.125f; }
        for (int e = tid; e < 128 * 128; e += 512) { const int t = e >> 7, vv = e & 127; vb[t * 128 + vv] = PROJ[(row0 + t) * NPROJ + C_MV + h * 128 + vv]; }
        __syncthreads();
        if (tid == 0) { const float mc = scal[0]; float run = 0.f, cm = -INFINITY;
            for (int t = 0; t < 128; ++t) { run += bs[t]; bs[t] = run; cm = fmaxf(cm, ig[t] - run); mt[t] = run + fmaxf(mc, cm); }
            const float bl = run; const float mnew = fmaxf(bl + mc, bl + cm); scal[1] = mnew; scal[2] = bl; }
        __syncthreads();
        if (tid < 128) wst[tid] = expf(scal[2] - bs[tid] + ig[tid] - scal[1]);
#pragma unroll 1
        for (int pass = 0; pass < 2; ++pass) {
            const int t = pass * 64 + (tid >> 3), vq = tid & 7; const float mc = scal[0]; const float bt = bs[t], mtt = mt[t];
            float q[64];
#pragma unroll
            for (int d = 0; d < 64; ++d) q[d] = qf[t * 65 + d];
            float num[16]; float den = 0.f;
#pragma unroll
            for (int j = 0; j < 16; ++j) num[j] = 0.f;
            const int tmax = pass * 64 + ((tid >> 6) << 3) + 7;
#pragma unroll 1
            for (int s = 0; s <= tmax; ++s) { if (s <= t) { float dot = 0.f;
#pragma unroll
                    for (int d = 0; d < 64; ++d) dot += q[d] * kf[s * 65 + d];
                    const float sw = dot * expf(bt - bs[s] + ig[s] - mtt); den += sw;
#pragma unroll
                    for (int j = 0; j < 16; ++j) num[j] += sw * bf2f(vb[s * 128 + vq * 16 + j]); } }
            const float wi = expf(bt + mc - mtt); float nq = 0.f;
#pragma unroll
            for (int d = 0; d < 64; ++d) nq += nst[d] * q[d];
            den += wi * nq;
            { float cq[16];
#pragma unroll
              for (int j = 0; j < 16; ++j) cq[j] = 0.f;
#pragma unroll 1
              for (int d = 0; d < 64; ++d) { const float qd = qf[t * 65 + d]; const LAS float* cr = Cst + (vq * 16) * 65 + d;
#pragma unroll
                  for (int j = 0; j < 16; ++j) cq[j] += cr[j * 65] * qd; }
#pragma unroll
              for (int j = 0; j < 16; ++j) num[j] += wi * cq[j]; }
            const float dn = 1.f / fmaxf(fabsf(den), expf(-mtt)); float ss = 0.f;
#pragma unroll
            for (int j = 0; j < 16; ++j) { num[j] *= dn; ss += num[j] * num[j]; }
            ss += __shfl_xor(ss, 1); ss += __shfl_xor(ss, 2); ss += __shfl_xor(ss, 4);
            const float rs = 1.f / sqrtf(ss * (1.f / 128.f) + RMS_EPS);
            const size_t row = row0 + t; const bf16* mo = PROJ + row * NPROJ + C_MO + h * 128 + vq * 16; bf16* out = CAT + row * D + 512 + h * 128 + vq * 16; const float* gn = norm_ml + h * 128 + vq * 16;
#pragma unroll
            for (int j = 0; j < 16; ++j) { const float o = bf2f(mo[j]); out[j] = (bf16)f2bf(num[j] * rs * gn[j] / (1.f + expf(-o))); }
        }
        __syncthreads();
        {
            const float cs = expf(scal[2] + scal[0] - scal[1]);
            for (int e = tid; e < 128 * 64; e += 512) { const int vv = e >> 6, d = e & 63; float a = 0.f;
                for (int s = 0; s < 128; ++s) a += wst[s] * bf2f(vb[s * 128 + vv]) * kf[s * 65 + d];
                Cst[vv * 65 + d] = cs * Cst[vv * 65 + d] + a; }
            if (tid < 64) { float a = 0.f; for (int s = 0; s < 128; ++s) a += wst[s] * kf[s * 65 + tid]; nst[tid] = cs * nst[tid] + a; }
        }
        __syncthreads();
        if (tid == 0) scal[0] = scal[1];
        __syncthreads();
    }
}

typedef short bf16x8_t __attribute__((ext_vector_type(8)));
#define MFMA16(a, b, c) __builtin_amdgcn_mfma_f32_16x16x32_bf16((a), (b), (c), 0, 0, 0)
__device__ __forceinline__ float wave_incl_sum(float v, int lane) {
#pragma unroll
    for (int o = 1; o < 64; o <<= 1) { const float y = __shfl_up(v, o); if (lane >= o) v += y; }
    return v;
}
__device__ __forceinline__ float wave_incl_max(float v, int lane) {
#pragma unroll
    for (int o = 1; o < 64; o <<= 1) { const float y = __shfl_up(v, o); if (lane >= o) v = fmaxf(v, y); }
    return v;
}
__device__ __forceinline__ float fexp(float x) { return __builtin_amdgcn_exp2f(x * 1.4426950408889634f); }
__device__ __forceinline__ float fsigm(float x) { return __builtin_amdgcn_rcpf(1.f + __builtin_amdgcn_exp2f(-1.4426950408889634f * x)); }
struct MlBufs { bf16* QC; bf16* KC; float* DC; bf16* CST; float* DN; float* NST; float* SC; float* MC; };
constexpr int ML_KW = 0, ML_VT = 18432, ML_ARR = 55296;
constexpr int MC_QS = 0, MC_KS = 18432, MC_VT = 36864, MC_CM = 76032, MC_SS = 96768, MC_ARR = 131584;

typedef short v4i16m_t __attribute__((ext_vector_type(4)));
__device__ __forceinline__ bf16x8_t tr8(const LAS bf16* p0, const LAS bf16* p1) {
    const v4i16m_t lo = __builtin_amdgcn_ds_read_tr16_b64_v4i16((LAS v4i16m_t*)p0), hi = __builtin_amdgcn_ds_read_tr16_b64_v4i16((LAS v4i16m_t*)p1);
    return (bf16x8_t){lo[0], lo[1], lo[2], lo[3], hi[0], hi[1], hi[2], hi[3]};
}
template <bool ONES>
__device__ __forceinline__ void ml_stage_v(Frame& F, const bf16* PROJ, size_t row0, int h, LAS bf16* VR) {
#pragma unroll
    for (int e = F.tid; e < 128 * 16; e += NWAVES * 64) { const int t = e >> 4, v0 = (e & 15) * 8;
        *(LAS v4u*)(VR + t * 144 + v0) = *(const GAS v4u*)(PROJ + (row0 + t) * NPROJ + C_MV + h * 128 + v0); }
    if (ONES) { for (int e = F.tid; e < 128 * 2; e += NWAVES * 64) { const int t = e >> 1, hf = e & 1; *(LAS v4u*)(VR + t * 144 + 128 + 8 * hf) = (v4u){hf ? 0u : 0x3f80u, 0u, 0u, 0u}; } }
}
__device__ __forceinline__ void ml_phase_a(Frame& F, int unit, const bf16* PROJ, const float* GATES, const float* conv_w, const float* conv_b, const MlBufs& B) {
    const int bh = unit >> 6, c = unit & 63, b = bh >> 2, h = bh & 3, tid = F.tid, lane = F.lane;
    const size_t row0 = (size_t)b * SEQ + (size_t)c * MLC;
    LAS bf16* KW = (LAS bf16*)(F.lds + ML_KW); LAS bf16* VT = (LAS bf16*)(F.lds + ML_VT);
    LAS float* wst = (LAS float*)(F.lds + ML_ARR);
    PSEG(0);
    if (F.wave == 0) {
        const float i0 = GATES[(row0 + 2 * lane) * 8 + h], i1 = GATES[(row0 + 2 * lane + 1) * 8 + h], f0 = GATES[(row0 + 2 * lane) * 8 + 4 + h], f1 = GATES[(row0 + 2 * lane + 1) * 8 + 4 + h];
        const float tot = wave_incl_sum(f0 + f1, lane); const float b0 = tot - f1, b1 = tot;
        const float a0 = i0 - b0, a1 = i1 - b1; const float amax = wave_max(fmaxf(a0, a1)); const float bl = __shfl(b1, 63);
        wst[2 * lane] = expf(a0 - amax); wst[2 * lane + 1] = expf(a1 - amax);
        if (lane == 0) { B.SC[unit * 2] = bl + amax; B.SC[unit * 2 + 1] = bl; }
    }
    LDS_WAIT(); __syncthreads(); PSEG(1);
    {   const int g8 = tid & 15, isk = g8 >> 3, d0 = (g8 & 7) * 8; const int ch = isk * 256 + h * 64 + d0;
        f32x4 cw[4][2], cb[2];
#pragma unroll
        for (int j = 0; j < 4; ++j) { cw[j][0] = *(const GAS f32x4*)(conv_w + j * 512 + ch); cw[j][1] = *(const GAS f32x4*)(conv_w + j * 512 + ch + 4); }
        cb[0] = *(const GAS f32x4*)(conv_b + ch); cb[1] = *(const GAS f32x4*)(conv_b + ch + 4);
        v4u xin[4][4];
#pragma unroll
        for (int i = 0; i < 4; ++i)
#pragma unroll
            for (int j = 0; j < 4; ++j) { const int t = (tid >> 4) + 32 * i; const int tt = c * MLC + t - 3 + j;
                xin[i][j] = (tt >= 0) ? *(const GAS v4u*)(PROJ + ((size_t)b * SEQ + tt) * NPROJ + C_MQ + ch) : (v4u){0u, 0u, 0u, 0u}; }
#pragma unroll
        for (int i = 0; i < 4; ++i) { const int t = (tid >> 4) + 32 * i;
            float a[8];
#pragma unroll
            for (int e = 0; e < 4; ++e) { a[e] = cb[0][e]; a[4 + e] = cb[1][e]; }
#pragma unroll
            for (int j = 0; j < 4; ++j) { const v4u w = xin[i][j]; const f32x4 w0 = cw[j][0], w1 = cw[j][1];
                a[0] += w0[0] * bflo(w.x); a[1] += w0[1] * bfhi(w.x); a[2] += w0[2] * bflo(w.y); a[3] += w0[3] * bfhi(w.y); a[4] += w1[0] * bflo(w.z); a[5] += w1[1] * bfhi(w.z); a[6] += w1[2] * bflo(w.w); a[7] += w1[3] * bfhi(w.w); }
#pragma unroll
            for (int e = 0; e < 8; ++e) a[e] = a[e] * fsigm(a[e]);
            if (isk) { v4u o; o.x = pk2(a[0], a[1]); o.y = pk2(a[2], a[3]); o.z = pk2(a[4], a[5]); o.w = pk2(a[6], a[7]); *(GAS v4u*)(B.KC + (row0 + t) * 256 + h * 64 + d0) = o;
                const float ws = wst[t];
                v4u kw; kw.x = pk2(a[0] * ws, a[1] * ws); kw.y = pk2(a[2] * ws, a[3] * ws); kw.z = pk2(a[4] * ws, a[5] * ws); kw.w = pk2(a[6] * ws, a[7] * ws);
                *(LAS v4u*)(KW + t * 72 + d0) = kw;
            } else { v4u o; o.x = pk2(a[0] * 0.125f, a[1] * 0.125f); o.y = pk2(a[2] * 0.125f, a[3] * 0.125f); o.z = pk2(a[4] * 0.125f, a[5] * 0.125f); o.w = pk2(a[6] * 0.125f, a[7] * 0.125f);
                *(GAS v4u*)(B.QC + (row0 + t) * 256 + h * 64 + d0) = o; } }
    }
    ml_stage_v<false>(F, PROJ, row0, h, VT);
    LDS_WAIT(); __syncthreads(); PSEG(2);
    {
        const int w = F.wave, r = lane & 15, q4 = lane >> 4; f32x4 acc[4];
#pragma unroll
        for (int nt = 0; nt < 4; ++nt) acc[nt] = (f32x4){0.f, 0.f, 0.f, 0.f};
#pragma unroll
        for (int ks = 0; ks < 4; ++ks) { const int trow = 32 * ks + 8 * q4 + (r >> 2), pc = 4 * (r & 3);
            const bf16x8_t a = tr8(VT + trow * 144 + 16 * w + pc, VT + (trow + 4) * 144 + 16 * w + pc);
#pragma unroll
            for (int nt = 0; nt < 4; ++nt) { const bf16x8_t bb = tr8(KW + trow * 72 + 16 * nt + pc, KW + (trow + 4) * 72 + 16 * nt + pc); acc[nt] = MFMA16(a, bb, acc[nt]); } }
        float* dc = B.DC + (size_t)unit * 8192;
#pragma unroll
        for (int nt = 0; nt < 4; ++nt)
#pragma unroll
            for (int j = 0; j < 4; ++j) dc[(16 * w + 4 * q4 + j) * 64 + 16 * nt + r] = acc[nt][j];
        if (tid < 64) { float s = 0.f; for (int t = 0; t < 128; ++t) s += bf2f(KW[t * 72 + tid]); B.DN[unit * 64 + tid] = s; }
    }
    LDS_WAIT(); __syncthreads(); PSEG(3);
}
__device__ __forceinline__ void ml_phase_b(Frame& F, int u, const MlBufs& B) {
    const int bh = u >> 5, eb = (u & 31) * 256, tid = F.tid;
    LAS float* sC = (LAS float*)(F.lds); LAS float* sD = sC + 64;
    LAS float* scl = sD + 64;
    if (tid < 128) scl[tid] = B.SC[bh * 128 + tid];
    LDS_WAIT(); __syncthreads();
    if (F.wave == 0) {
        const int c = F.lane; const float ac = scl[c * 2], bl = scl[c * 2 + 1]; float A = bl, Bm = ac;
#pragma unroll
        for (int o = 1; o < 64; o <<= 1) { const float Ap = __shfl_up(A, o), Bp = __shfl_up(Bm, o); if (c >= o) { Bm = fmaxf(Bm, A + Bp); A = A + Ap; } }
        const float mn = fmaxf(Bm, A); const float mp = __shfl_up(mn, 1); const float me = (c == 0) ? 0.f : mp;
        sC[c] = fexp(bl + me - mn); sD[c] = fexp(ac - mn); if ((u & 31) == 0) B.MC[bh * 64 + c] = me; }
    LDS_WAIT(); __syncthreads();
    if (tid < 256) { float C = 0.f; const float* dc = B.DC + (size_t)bh * 64 * 8192 + eb + tid; bf16* cs = B.CST + (size_t)bh * 64 * 8192 + eb + tid;
        float dv[64];
#pragma unroll
        for (int c = 0; c < 64; ++c) dv[c] = dc[(size_t)c * 8192];
#pragma unroll
        for (int c = 0; c < 64; ++c) { cs[(size_t)c * 8192] = (bf16)f2bf(C); C = sC[c] * C + sD[c] * dv[c]; } }
    else if (tid < 320 && (u & 31) == 0) { const int d = tid - 256; float n = 0.f;
        for (int c = 0; c < 64; ++c) { B.NST[(bh * 64 + c) * 64 + d] = n; n = sC[c] * n + sD[c] * B.DN[(bh * 64 + c) * 64 + d]; } }
    __syncthreads();
}
__device__ __forceinline__ void ml_phase_c(Frame& F, int unit, const bf16* PROJ, const float* GATES, const float* norm_ml, bf16* CAT, const MlBufs& B) {
    const int bh = unit >> 6, c = unit & 63, b = bh >> 2, h = bh & 3, tid = F.tid, lane = F.lane;
    const size_t row0 = (size_t)b * SEQ + (size_t)c * MLC;
    LAS bf16* QS = (LAS bf16*)(F.lds + MC_QS); LAS bf16* KS = (LAS bf16*)(F.lds + MC_KS); LAS bf16* VT = (LAS bf16*)(F.lds + MC_VT); LAS bf16* CM = (LAS bf16*)(F.lds + MC_CM); LAS bf16* SS = (LAS bf16*)(F.lds + MC_SS);
    LAS float* aa = (LAS float*)(F.lds + MC_ARR); LAS float* rt = aa + 128; LAS float* wint = aa + 256; LAS float* emt = aa + 384;
    if (F.wave == 0) {
        const float mc = B.MC[unit];
        const float i0 = GATES[(row0 + 2 * lane) * 8 + h], i1 = GATES[(row0 + 2 * lane + 1) * 8 + h], f0 = GATES[(row0 + 2 * lane) * 8 + 4 + h], f1 = GATES[(row0 + 2 * lane + 1) * 8 + 4 + h];
        const float tot = wave_incl_sum(f0 + f1, lane); const float b0 = tot - f1, b1 = tot;
        const float a0 = i0 - b0, a1 = i1 - b1; const float cmx = wave_incl_max(fmaxf(a0, a1), lane); const float cmprev = __shfl_up(cmx, 1);
        const float cm0 = (lane == 0) ? a0 : fmaxf(cmprev, a0), cm1 = cmx;
        const float mt0 = b0 + fmaxf(mc, cm0), mt1 = b1 + fmaxf(mc, cm1);
        aa[2 * lane] = a0; aa[2 * lane + 1] = a1; rt[2 * lane] = b0 - mt0; rt[2 * lane + 1] = b1 - mt1;
        wint[2 * lane] = expf(b0 + mc - mt0); wint[2 * lane + 1] = expf(b1 + mc - mt1); emt[2 * lane] = expf(-mt0); emt[2 * lane + 1] = expf(-mt1);
    }
#pragma unroll
    for (int e = tid; e < 128 * 8; e += NWAVES * 64) { const int t = e >> 3, ch = (e & 7) * 8;
        *(LAS v4u*)(QS + t * 72 + ch) = *(const GAS v4u*)(B.QC + (row0 + t) * 256 + h * 64 + ch);
        *(LAS v4u*)(KS + t * 72 + ch) = *(const GAS v4u*)(B.KC + (row0 + t) * 256 + h * 64 + ch);
        *(LAS v4u*)(CM + t * 72 + ch) = *(const GAS v4u*)(B.CST + (size_t)unit * 8192 + t * 64 + ch); }
    ml_stage_v<true>(F, PROJ, row0, h, VT);
    for (int e = tid; e < 16 * 64; e += NWAVES * 64) { const int rr = e >> 6, cc = e & 63; CM[(128 + rr) * 72 + cc] = (rr == 0) ? (bf16)f2bf(B.NST[unit * 64 + cc]) : (bf16)0; }
    LDS_WAIT(); __syncthreads();
    const int w = F.wave, r = lane & 15, q4 = lane >> 4;
    {
        bf16x8_t a[2];
#pragma unroll
        for (int ks = 0; ks < 2; ++ks) a[ks] = *(const LAS bf16x8_t*)(QS + (16 * w + r) * 72 + 32 * ks + 8 * q4);
        float rtj[4];
#pragma unroll
        for (int j = 0; j < 4; ++j) rtj[j] = rt[16 * w + 4 * q4 + j];
        for (int nt = 0; nt <= (w | 1); ++nt) { f32x4 acc = {0.f, 0.f, 0.f, 0.f};
#pragma unroll
            for (int ks = 0; ks < 2; ++ks) { const bf16x8_t bb = *(const LAS bf16x8_t*)(KS + (16 * nt + r) * 72 + 32 * ks + 8 * q4); acc = MFMA16(a[ks], bb, acc); }
            const int s = 16 * nt + r; const float as = aa[s];
#pragma unroll
            for (int j = 0; j < 4; ++j) { const int t = 16 * w + 4 * q4 + j; const float v = (s <= t) ? acc[j] * fexp(rtj[j] + as) : 0.f; SS[t * 136 + s] = (bf16)f2bf(v); } }
    }
    LDS_WAIT();
    f32x4 accS[9], accQ[9];
#pragma unroll
    for (int nt = 0; nt < 9; ++nt) { accS[nt] = (f32x4){0.f, 0.f, 0.f, 0.f}; accQ[nt] = (f32x4){0.f, 0.f, 0.f, 0.f}; }
    for (int ks = 0; ks <= (16 * w + 15) / 32; ++ks) { const bf16x8_t a = *(const LAS bf16x8_t*)(SS + (16 * w + r) * 136 + 32 * ks + 8 * q4);
        const int trow = 32 * ks + 8 * q4 + (r >> 2), pc = 4 * (r & 3);
#pragma unroll
        for (int nt = 0; nt < 9; ++nt) { const bf16x8_t bb = tr8(VT + trow * 144 + 16 * nt + pc, VT + (trow + 4) * 144 + 16 * nt + pc); accS[nt] = MFMA16(a, bb, accS[nt]); } }
#pragma unroll
    for (int ks = 0; ks < 2; ++ks) { const bf16x8_t a = *(const LAS bf16x8_t*)(QS + (16 * w + r) * 72 + 32 * ks + 8 * q4);
#pragma unroll
        for (int nt = 0; nt < 9; ++nt) { const bf16x8_t bb = *(const LAS bf16x8_t*)(CM + (16 * nt + r) * 72 + 32 * ks + 8 * q4); accQ[nt] = MFMA16(a, bb, accQ[nt]); } }
    LDS_WAIT();
    {
        float gn[8];
#pragma unroll
        for (int nt = 0; nt < 8; ++nt) gn[nt] = norm_ml[h * 128 + 16 * nt + r];
#pragma unroll
        for (int j = 0; j < 4; ++j) { const int t = 16 * w + 4 * q4 + j; const float wi = wint[t];
            const float dS = __shfl(accS[8][j], lane & 48), dQ = __shfl(accQ[8][j], lane & 48);
            const float den = dS + wi * dQ; const float dn = 1.f / fmaxf(fabsf(den), emt[t]);
            float hv[8]; float ss = 0.f;
#pragma unroll
            for (int nt = 0; nt < 8; ++nt) { hv[nt] = (accS[nt][j] + wi * accQ[nt][j]) * dn; ss += hv[nt] * hv[nt]; }
            ss += __shfl_xor(ss, 1); ss += __shfl_xor(ss, 2); ss += __shfl_xor(ss, 4); ss += __shfl_xor(ss, 8);
            const float rs = 1.f / sqrtf(ss * (1.f / 128.f) + RMS_EPS);
#pragma unroll
            for (int nt = 0; nt < 8; ++nt) SS[t * 136 + 16 * nt + r] = (bf16)f2bf(hv[nt] * rs * gn[nt]); }
    }
    LDS_WAIT();
    for (int e = lane; e < 16 * 16; e += 64) { const int t = 16 * w + (e >> 4), v0 = (e & 15) * 8;
        const v4u hh = *(const LAS v4u*)(SS + t * 136 + v0); const v4u mo = *(const GAS v4u*)(PROJ + (row0 + t) * NPROJ + C_MO + h * 128 + v0);
        v4u o;
#define SGM(x) fsigm(x)
        o.x = pk2(bflo(hh.x) * SGM(bflo(mo.x)), bfhi(hh.x) * SGM(bfhi(mo.x))); o.y = pk2(bflo(hh.y) * SGM(bflo(mo.y)), bfhi(hh.y) * SGM(bfhi(mo.y)));
        o.z = pk2(bflo(hh.z) * SGM(bflo(mo.z)), bfhi(hh.z) * SGM(bfhi(mo.z))); o.w = pk2(bflo(hh.w) * SGM(bflo(mo.w)), bfhi(hh.w) * SGM(bfhi(mo.w)));
#undef SGM
        *(GAS v4u*)(CAT + (row0 + t) * D + 512 + h * 128 + v0) = o; }
    LDS_WAIT(); __syncthreads();
}

typedef float f32x16_t __attribute__((ext_vector_type(16)));
typedef short s16x4_t __attribute__((ext_vector_type(4)));
typedef short v4i16_t __attribute__((ext_vector_type(4)));
typedef float f32x2_t __attribute__((ext_vector_type(2)));
typedef __bf16 bf16x2_t __attribute__((ext_vector_type(2)));
#define MFMA32(a, b, c) __builtin_amdgcn_mfma_f32_32x32x16_bf16((a), (b), (c), 0, 0, 0)
__device__ __forceinline__ unsigned cvtpk(float lo, float hi) { f32x2_t v = {lo, hi}; bf16x2_t b = __builtin_convertvector(v, bf16x2_t); return __builtin_bit_cast(unsigned, b); }
struct AtBufs { bf16* PO; float* PML; unsigned* SEL; unsigned* LISTQ; unsigned* BCNT; };
constexpr int AT_KS = 0, AT_VS = 36864, AT_END = 86016;
constexpr int AT_PFX = 90112;
constexpr int BKT_PER_BH = 126976;
__device__ __forceinline__ int bucket_off(int bh, int j) { return bh * BKT_PER_BH + 256 * (31 * j - (j * (j - 1)) / 2); }

__device__ __forceinline__ void attn_route(Frame& F, int unit, const bf16* PROJ, const float* ksum, const AtBufs& A) {
    const int bh = unit >> 5, blk = unit & 31, b = bh >> 3, h = bh & 7, tid = F.tid;
    LAS float* km = (LAS float*)(F.lds); LAS int* cnt = (LAS int*)(F.lds + 8192); LAS int* base = cnt + 32;
    PSEG(0);
    LAS float* cv = (LAS float*)(F.lds + 8704); LAS int* ci = (LAS int*)(F.lds + 8704 + 3072);
    for (int e = tid; e < blk * 64; e += NWAVES * 64) km[e] = ksum[(size_t)(b * NB + (e >> 6)) * 512 + h * 64 + (e & 63)];
    if (tid < 32) cnt[tid] = 0;
    LDS_WAIT(); __syncthreads(); PSEG(4);
    const int ql = tid & 255, half = tid >> 8; const int t = blk * 256 + ql; const size_t row = (size_t)b * SEQ + t;
    int i0 = -1, i1 = -1, i2 = -1, l0 = 0, l1 = 0, l2 = 0; float v0 = -INFINITY, v1 = -INFINITY, v2 = -INFINITY;
    {
        float q[64]; const GAS v4u* qp = (const GAS v4u*)(PROJ + row * NPROJ + C_AQ + h * 64);
#pragma unroll
        for (int c = 0; c < 8; ++c) { const v4u w = qp[c]; q[8 * c] = bflo(w.x); q[8 * c + 1] = bfhi(w.x); q[8 * c + 2] = bflo(w.y); q[8 * c + 3] = bfhi(w.y); q[8 * c + 4] = bflo(w.z); q[8 * c + 5] = bfhi(w.z); q[8 * c + 6] = bflo(w.w); q[8 * c + 7] = bfhi(w.w); }
        for (int n = half; n < blk; n += 2) { const LAS f32x4* kr = (const LAS f32x4*)(km + n * 64); float g = 0.f;
#pragma unroll
            for (int c = 0; c < 16; ++c) { const f32x4 kk = kr[c]; g += q[4 * c] * kk[0] + q[4 * c + 1] * kk[1] + q[4 * c + 2] * kk[2] + q[4 * c + 3] * kk[3]; }
            if (g > v0) { v2 = v1; i2 = i1; v1 = v0; i1 = i0; v0 = g; i0 = n; } else if (g > v1) { v2 = v1; i2 = i1; v1 = g; i1 = n; } else if (g > v2) { v2 = g; i2 = n; } }
    }
    PSEG(5);
    if (half) { cv[ql * 3] = v0; cv[ql * 3 + 1] = v1; cv[ql * 3 + 2] = v2; ci[ql * 3] = i0; ci[ql * 3 + 1] = i1; ci[ql * 3 + 2] = i2; }
    LDS_WAIT(); __syncthreads();
    if (!half) {
#pragma unroll
        for (int k = 0; k < 3; ++k) { const float g = cv[ql * 3 + k]; const int n = ci[ql * 3 + k];
            if (n >= 0) { if (g > v0 || (g == v0 && n < i0)) { v2 = v1; i2 = i1; v1 = v0; i1 = i0; v0 = g; i0 = n; } else if (g > v1 || (g == v1 && n < i1)) { v2 = v1; i2 = i1; v1 = g; i1 = n; } else if (g > v2 || (g == v2 && n < i2)) { v2 = g; i2 = n; } } }
        A.SEL[row * 8 + h] = (unsigned)(i0 & 0xff) | ((unsigned)(i1 & 0xff) << 8) | ((unsigned)(i2 & 0xff) << 16);
        if (i0 >= 0) l0 = __hip_atomic_fetch_add(cnt + i0, 1, __ATOMIC_RELAXED, __HIP_MEMORY_SCOPE_WORKGROUP);
        if (i1 >= 0) l1 = __hip_atomic_fetch_add(cnt + i1, 1, __ATOMIC_RELAXED, __HIP_MEMORY_SCOPE_WORKGROUP);
        if (i2 >= 0) l2 = __hip_atomic_fetch_add(cnt + i2, 1, __ATOMIC_RELAXED, __HIP_MEMORY_SCOPE_WORKGROUP);
    }
    LDS_WAIT(); __syncthreads();
    if (tid < blk) { const int c = cnt[tid]; base[tid] = c > 0 ? (int)__hip_atomic_fetch_add(A.BCNT + bh * 32 + tid, (unsigned)c, RLX_AGENT) : 0; }
    LDS_WAIT(); __syncthreads();
    if (!half) {
        if (i0 >= 0) A.LISTQ[bucket_off(bh, i0) + base[i0] + l0] = (unsigned)t;
        if (i1 >= 0) A.LISTQ[bucket_off(bh, i1) + base[i1] + l1] = (unsigned)t | (1u << 13);
        if (i2 >= 0) A.LISTQ[bucket_off(bh, i2) + base[i2] + l2] = (unsigned)t | (2u << 13);
    }
    __syncthreads(); PSEG(6);
}
struct KvRegs { v4u k[4], v[4]; };
__device__ __forceinline__ void attn_kv_load(Frame& F, const bf16* PROJ, size_t krow0, int h, KvRegs& R) {
#pragma unroll
    for (int i = 0; i < 4; ++i) { const int e = F.tid + 512 * i, key = e >> 3, d0 = (e & 7) * 8; const bf16* rp = PROJ + (krow0 + key) * NPROJ + h * 64 + d0;
        R.k[i] = *(const GAS v4u*)(rp + C_AK); R.v[i] = *(const GAS v4u*)(rp + C_AV); }
}
__device__ __forceinline__ void attn_kv_store(Frame& F, const KvRegs& R) {
    LAS bf16* KS = (LAS bf16*)(F.lds + AT_KS); LAS bf16* VS = (LAS bf16*)(F.lds + AT_VS);
#pragma unroll
    for (int i = 0; i < 4; ++i) { const int e = F.tid + 512 * i, key = e >> 3, d0 = (e & 7) * 8; *(LAS v4u*)(KS + key * 72 + d0) = R.k[i]; *(LAS v4u*)(VS + key * 96 + d0) = R.v[i]; }
}
template <bool CAUSAL>
__device__ __forceinline__ void attn_core(Frame& F, const bf16x8_t (&qf)[4], int qloc, float& m, float& l, f32x16_t (&o)[2]) {
    const LAS bf16* KS = (const LAS bf16*)(F.lds + AT_KS); const LAS bf16* VS = (const LAS bf16*)(F.lds + AT_VS);
    const int lane = F.lane, r32 = lane & 31, hh = lane >> 5;
    m = 0.f; l = 0.f;
#pragma unroll
    for (int i = 0; i < 16; ++i) { o[0][i] = 0.f; o[1][i] = 0.f; }
    const int ktmax = CAUSAL ? ((32 * F.wave + 31) >> 6) : 3;
    for (int kt = 0; kt <= ktmax; ++kt) {
        f32x16_t p0, p1; const float nm = -m;
#pragma unroll
        for (int i = 0; i < 16; ++i) { p0[i] = nm; p1[i] = nm; }
#pragma unroll
        for (int d0 = 0; d0 < 4; ++d0) { const bf16x8_t k0 = *(const LAS bf16x8_t*)(KS + (64 * kt + r32) * 72 + 16 * d0 + 8 * hh), k1 = *(const LAS bf16x8_t*)(KS + (64 * kt + 32 + r32) * 72 + 16 * d0 + 8 * hh);
            p0 = MFMA32(k0, qf[d0], p0); p1 = MFMA32(k1, qf[d0], p1); }
        if (CAUSAL) { if (64 * kt + 63 > 32 * F.wave) {
#pragma unroll
                for (int i = 0; i < 16; ++i) { const int kl = 64 * kt + (i & 3) + 8 * (i >> 2) + 4 * hh; if (kl > qloc) p0[i] = -INFINITY; if (kl + 32 > qloc) p1[i] = -INFINITY; } } }
        float rm = fmaxf(p0[0], p1[0]);
#pragma unroll
        for (int i = 1; i < 16; ++i) rm = fmaxf(rm, fmaxf(p0[i], p1[i]));
        rm = fmaxf(rm, __shfl_xor(rm, 32));
        if (kt == 0 || __any(rm > 8.f)) {
            const float dl = (kt == 0) ? rm : fmaxf(rm, 0.f); const float sc = (kt == 0) ? 1.f : __builtin_amdgcn_exp2f(-dl); m += dl; l *= sc;
#pragma unroll
            for (int i = 0; i < 16; ++i) { o[0][i] *= sc; o[1][i] *= sc; p0[i] -= dl; p1[i] -= dl; } }
        float ls = 0.f;
#pragma unroll
        for (int i = 0; i < 16; ++i) { p0[i] = __builtin_amdgcn_exp2f(p0[i]); p1[i] = __builtin_amdgcn_exp2f(p1[i]); ls += p0[i] + p1[i]; }
        l += ls;
        bf16x8_t pf[4];
#pragma unroll
        for (int s = 0; s < 2; ++s) { v4u a, c; a.x = cvtpk(p0[8 * s], p0[8 * s + 1]); a.y = cvtpk(p0[8 * s + 2], p0[8 * s + 3]); a.z = cvtpk(p0[8 * s + 4], p0[8 * s + 5]); a.w = cvtpk(p0[8 * s + 6], p0[8 * s + 7]);
            c.x = cvtpk(p1[8 * s], p1[8 * s + 1]); c.y = cvtpk(p1[8 * s + 2], p1[8 * s + 3]); c.z = cvtpk(p1[8 * s + 4], p1[8 * s + 5]); c.w = cvtpk(p1[8 * s + 6], p1[8 * s + 7]);
            pf[s] = __builtin_bit_cast(bf16x8_t, a); pf[2 + s] = __builtin_bit_cast(bf16x8_t, c); }
#pragma unroll
        for (int dt = 0; dt < 2; ++dt)
#pragma unroll
            for (int s = 0; s < 4; ++s) { const LAS bf16* vp = VS + (64 * kt + 32 * (s >> 1) + 16 * (s & 1) + 4 * hh + ((lane & 15) >> 2)) * 96 + 32 * dt + 16 * ((lane >> 4) & 1) + 4 * (lane & 3);
                const s16x4_t lo = __builtin_bit_cast(s16x4_t, __builtin_amdgcn_ds_read_tr16_b64_v4i16((LAS v4i16_t*)vp)), hi = __builtin_bit_cast(s16x4_t, __builtin_amdgcn_ds_read_tr16_b64_v4i16((LAS v4i16_t*)(vp + 8 * 96)));
                const bf16x8_t vf = {lo[0], lo[1], lo[2], lo[3], hi[0], hi[1], hi[2], hi[3]};
                o[dt] = MFMA32(vf, pf[s], o[dt]); }
    }
}
__device__ __forceinline__ int attn_tile_prefix(Frame& F, const AtBufs& A) {
    LAS int* pfx = (LAS int*)(F.lds + AT_PFX); LAS int* wtot = pfx + 512;
    const int k = F.tid; int nt = 0;
    if (k < 496) { const int bh = k / 31, j = k - bh * 31; nt = ((int)__hip_atomic_load(A.BCNT + bh * 32 + j, RLX_AGENT) + 255) >> 8; }
    int inc = nt;
#pragma unroll
    for (int o = 1; o < 64; o <<= 1) { const int y = __shfl_up(inc, o); if (F.lane >= o) inc += y; }
    if (F.lane == 63) wtot[F.wave] = inc;
    LDS_WAIT(); __syncthreads();
    int wb = 0;
    for (int w = 0; w < F.wave; ++w) wb += wtot[w];
    pfx[k] = wb + inc - nt;
    if (k == 511) pfx[512 + 16] = wb + inc;
    LDS_WAIT(); __syncthreads();
    return pfx[512 + 16];
}
struct SelMeta { int bh, j, n, tile; };
__device__ __forceinline__ SelMeta attn_sel_decode(Frame& F, int u, const AtBufs& A) {
    const LAS int* pfx = (const LAS int*)(F.lds + AT_PFX);
    int lo = 0, hi = 495;
    while (lo < hi) { const int mid = (lo + hi + 1) >> 1; if (pfx[mid] <= u) lo = mid; else hi = mid - 1; }
    SelMeta m; m.bh = lo / 31; m.j = lo - m.bh * 31; m.tile = u - pfx[lo]; m.n = (int)__hip_atomic_load(A.BCNT + m.bh * 32 + m.j, RLX_AGENT); return m;
}
__device__ __forceinline__ void attn_sel_phase(Frame& F, int nu, const bf16* PROJ, const AtBufs& A) {
    const int lane = F.lane, r32 = lane & 31, hh = lane >> 5;
    int u = F.vcu; if (u >= nu) return;
    LAS int* mtab = (LAS int*)(F.lds + AT_PFX + 2560);
    if (F.tid < 32) { const int ui = F.vcu + F.tid * F.G; if (ui < nu) { const SelMeta x = attn_sel_decode(F, ui, A); mtab[4 * F.tid] = x.bh; mtab[4 * F.tid + 1] = x.j; mtab[4 * F.tid + 2] = x.n; mtab[4 * F.tid + 3] = x.tile; } }
    LDS_WAIT(); __syncthreads();
    int ui_ = 0;
#define SEL_META(mt_) { mt_.bh = mtab[4 * ui_]; mt_.j = mtab[4 * ui_ + 1]; mt_.n = mtab[4 * ui_ + 2]; mt_.tile = mtab[4 * ui_ + 3]; ++ui_; }
    KvRegs R; bf16x8_t qn[4]; SelMeta mt; SEL_META(mt) int tq = 0, slotq = 0; bool validq = false;
#define SEL_PREFETCH() { const int b_ = mt.bh >> 3, h_ = mt.bh & 7; attn_kv_load(F, PROJ, (size_t)b_ * SEQ + (size_t)mt.j * 256, h_, R); \
        const int idx_ = mt.tile * 256 + 32 * F.wave + r32; validq = idx_ < mt.n; const unsigned ent_ = A.LISTQ[bucket_off(mt.bh, mt.j) + (validq ? idx_ : mt.n - 1)]; tq = ent_ & 8191; slotq = ent_ >> 13; \
        const bf16* qp_ = PROJ + ((size_t)b_ * SEQ + tq) * NPROJ + C_AQ + h_ * 64 + 8 * hh; \
        _Pragma("unroll") for (int d0 = 0; d0 < 4; ++d0) qn[d0] = *(const GAS bf16x8_t*)(qp_ + 16 * d0); }
    SEL_PREFETCH()
    for (;;) {
        PSEG(0);
        attn_kv_store(F, R);
        bf16x8_t qf[4];
#pragma unroll
        for (int d0 = 0; d0 < 4; ++d0) qf[d0] = qn[d0];
        const int b = mt.bh >> 3, h = mt.bh & 7, t = tq, slot = slotq; const bool valid = validq;
        LDS_WAIT(); __syncthreads(); PSEG(7);
        const int un = u + F.G; const bool more = un < nu;
        if (more) { if (ui_ < 32) { SEL_META(mt) } else mt = attn_sel_decode(F, un, A); SEL_PREFETCH() }
        PSEG(8);
        float m, l; f32x16_t o[2];
        attn_core<false>(F, qf, 0, m, l, o);
        l += __shfl_xor(l, 32); const float inv = 1.f / l; const size_t row = (size_t)b * SEQ + t;
        if (valid) { bf16* po = A.PO + ((row * 8 + h) * 3 + slot) * 64;
#pragma unroll
            for (int dt = 0; dt < 2; ++dt)
#pragma unroll
                for (int g = 0; g < 4; ++g) { v2u w; w.x = cvtpk(o[dt][4 * g] * inv, o[dt][4 * g + 1] * inv); w.y = cvtpk(o[dt][4 * g + 2] * inv, o[dt][4 * g + 3] * inv);
                    *(GAS v2u*)(po + 32 * dt + 8 * g + 4 * hh) = w; }
            if (hh == 0) { float* pm = A.PML + ((row * 8 + h) * 3 + slot) * 2; pm[0] = m; pm[1] = l; } }
        LDS_WAIT(); __syncthreads(); PSEG(9);
        if (!more) break;
        u = un;
    }
#undef SEL_PREFETCH
#undef SEL_META
}
__device__ __forceinline__ void attn_own_phase(Frame& F, const bf16* PROJ, const float* norm_attn, bf16* CAT, const AtBufs& A) {
    const int lane = F.lane, r32 = lane & 31, hh = lane >> 5; const int qloc = 32 * F.wave + r32;
    int u = F.vcu; if (u >= 512) return;
    KvRegs R; bf16x8_t qn[4]; unsigned seln = 0;
#define OWN_PREFETCH(U) { const int bh_ = (U) >> 5, blk_ = (U) & 31, b_ = bh_ >> 3, h_ = bh_ & 7; attn_kv_load(F, PROJ, (size_t)b_ * SEQ + (size_t)blk_ * 256, h_, R); \
        const size_t row_ = (size_t)b_ * SEQ + blk_ * 256 + qloc; const bf16* qp_ = PROJ + row_ * NPROJ + C_AQ + h_ * 64 + 8 * hh; \
        _Pragma("unroll") for (int d0 = 0; d0 < 4; ++d0) qn[d0] = *(const GAS bf16x8_t*)(qp_ + 16 * d0); seln = A.SEL[row_ * 8 + h_]; }
    OWN_PREFETCH(u)
    for (;;) {
        attn_kv_store(F, R);
        bf16x8_t qf[4];
#pragma unroll
        for (int d0 = 0; d0 < 4; ++d0) qf[d0] = qn[d0];
        const unsigned sel = seln; const int bh = u >> 5, blk = u & 31, b = bh >> 3, h = bh & 7; const size_t row = (size_t)b * SEQ + blk * 256 + qloc;
        LDS_WAIT(); __syncthreads();
        const int un = u + F.G; const bool more = un < 512;
        if (more) OWN_PREFETCH(un)
        float m, l; f32x16_t o[2];
        attn_core<true>(F, qf, qloc, m, l, o);
        l += __shfl_xor(l, 32);
        float mk[3], lk[3]; float M2 = m;
#pragma unroll
        for (int k = 0; k < 3; ++k) { const bool ok = ((sel >> (8 * k)) & 0xffu) != 0xffu; mk[k] = -INFINITY; lk[k] = 0.f;
            if (ok) { const float* pm = A.PML + ((row * 8 + h) * 3 + k) * 2; mk[k] = pm[0]; lk[k] = pm[1]; } M2 = fmaxf(M2, mk[k]); }
        const float wo = __builtin_amdgcn_exp2f(m - M2); float L = l * wo;
#pragma unroll
        for (int i = 0; i < 16; ++i) { o[0][i] *= wo; o[1][i] *= wo; }
#pragma unroll
        for (int k = 0; k < 3; ++k) { const float wk = lk[k] * __builtin_amdgcn_exp2f(mk[k] - M2); L += wk;
            if (wk > 0.f) { const bf16* po = A.PO + ((row * 8 + h) * 3 + k) * 64;
#pragma unroll
                for (int dt = 0; dt < 2; ++dt)
#pragma unroll
                    for (int g = 0; g < 4; ++g) { const v2u w = *(const GAS v2u*)(po + 32 * dt + 8 * g + 4 * hh);
                        o[dt][4 * g] += wk * bflo(w.x); o[dt][4 * g + 1] += wk * bfhi(w.x); o[dt][4 * g + 2] += wk * bflo(w.y); o[dt][4 * g + 3] += wk * bfhi(w.y); } } }
        const float inv = 1.f / L; float ss = 0.f;
#pragma unroll
        for (int i = 0; i < 16; ++i) { o[0][i] *= inv; o[1][i] *= inv; ss += o[0][i] * o[0][i] + o[1][i] * o[1][i]; }
        ss += __shfl_xor(ss, 32);
        const float rs = 1.f / sqrtf(ss * (1.f / 64.f) + RMS_EPS);
        bf16* co = CAT + row * D + h * 64;
#pragma unroll
        for (int dt = 0; dt < 2; ++dt)
#pragma unroll
            for (int g = 0; g < 4; ++g) { const int d0 = 32 * dt + 8 * g + 4 * hh; const f32x4 gn = *(const GAS f32x4*)(norm_attn + h * 64 + d0);
                v2u w; w.x = cvtpk(o[dt][4 * g] * rs * gn[0], o[dt][4 * g + 1] * rs * gn[1]); w.y = cvtpk(o[dt][4 * g + 2] * rs * gn[2], o[dt][4 * g + 3] * rs * gn[3]);
                *(GAS v2u*)(co + d0) = w; }
        LDS_WAIT(); __syncthreads();
        if (!more) break;
        u = un;
    }
#undef OWN_PREFETCH
}

constexpr int N_PHASES = 20;
struct Args { In in; float* out; unsigned char* ws; int ph_lo, ph_hi; };
__global__ void __launch_bounds__(NWAVES * 64, 2) hymba_fwd(Args args) {
    extern __shared__ __attribute__((aligned(16))) unsigned char lds[];
    Frame F;
    F.lds = (LAS unsigned char*)lds;
    F.MISC = (volatile LAS unsigned*)(F.lds + MISC_OFF);
    F.tid = threadIdx.x; F.lane = F.tid & 63; F.wave = __builtin_amdgcn_readfirstlane(F.tid >> 6);
    F.G = gridDim.x; { const int bx = blockIdx.x; F.vcu = (F.G % 8 == 0) ? (bx % 8) * (F.G / 8) + bx / 8 : bx; }
    F.ws = args.ws; unsigned char* ws = args.ws;
    F.ctl = (gu32*)(ws + WS_CTL);
    const In& I = args.in;
    for (int u = F.tid; u < (LDS_BYTES - MISC_OFF) / 4; u += NWAVES * 64) ((LAS unsigned*)(F.lds + MISC_OFF))[u] = 0u;
    __syncthreads();
    const int lo = args.ph_lo, hi = args.ph_hi;
    const bool multi = (hi - lo) > 1;
    XcdBarrier bar; bar.bar = (unsigned*)(F.ctl + CW_BAR); bar.x = 0; bar.st = nullptr;
    if (multi) bar = xcd_barrier_post((unsigned*)(F.ctl + CW_BAR), F.MISC + 8);
#define IN(k) (lo <= (k) && (k) < hi)
#ifdef PROBE_MASK
    LAS unsigned long long* pts = (LAS unsigned long long*)(F.lds + MISC_OFF + 1024);
    if (blockIdx.x == 0 && F.tid == 0) pts[0] = __builtin_amdgcn_s_memrealtime();
    LAS unsigned long long* pmid = pts + 32;
#define PMID(k) do { if (blockIdx.x == 0 && F.tid == 0) pmid[k] = __builtin_amdgcn_s_memrealtime(); } while (0)
#define SEAM(k) do { if (IN(k) && IN((k) + 1)) xcd_barrier(bar); if (blockIdx.x == 0 && F.tid == 0) pts[(k) + 1] = __builtin_amdgcn_s_memrealtime(); } while (0)
#else
#define SEAM(k) do { if (IN(k) && IN((k) + 1)) xcd_barrier(bar); } while (0)
#define PMID(k)
#endif
    bf16* XB = (bf16*)(ws + WS_XB); bf16* PROJ = (bf16*)(ws + WS_PROJ); bf16* CAT = (bf16*)(ws + WS_CAT);
    bf16* MIXB = (bf16*)(ws + WS_MIX); bf16* MIX2B = (bf16*)(ws + WS_MIX2); bf16* X1 = (bf16*)(ws + WS_X1); float* GATES = (float*)(ws + WS_GATES);
    const float* ROPE = (const float*)(ws + WS_ROPE);
    int* LIST = (int*)(ws + WS_LIST); float* LISTW = (float*)(ws + WS_LISTW); int* ROWMAP = (int*)(ws + WS_ROWMAP); float* ROWW = (float*)(ws + WS_ROWW);
    bf16* YB = (bf16*)(ws + WS_Y);

    if (IN(0)) { p_prologue(F, I); } SEAM(0);
    MlBufs MLB{(bf16*)(ws + WS_QC), (bf16*)(ws + WS_KC), (float*)(ws + WS_DC), (bf16*)(ws + WS_CST), (float*)(ws + WS_DN), (float*)(ws + WS_NST), (float*)(ws + WS_SC), (float*)(ws + WS_MC)};
    AtBufs ATB{(bf16*)(ws + WS_PO), (float*)(ws + WS_PML), (unsigned*)(ws + WS_SEL), (unsigned*)(ws + WS_LISTQ), nullptr};
#if defined(DBG_ML) || defined(DBG_AT)
    bf16* CAT2 = (bf16*)(ws + WS_CAT2);
#define DBG_CMP(COFF) { float ds = 0.f; for (size_t e = (size_t)blockIdx.x * 512 + F.tid; e < (size_t)M * 512; e += (size_t)F.G * 512) { const size_t idx = (e >> 9) * D + (COFF) + (e & 511); ds += fabsf(bf2f(CAT[idx]) - bf2f(CAT2[idx])); } \
        ds = wave_sum(ds); if (F.lane == 0) __hip_atomic_fetch_add((float*)(F.ctl + CW_DBG), ds, RLX_AGENT); }
#endif
#ifdef DBG_ML
#define DBG_NAIVE(L) if (F.vcu < 8) mlstm_naive(F, F.vcu, PROJ, GATES, I.conv_w + (L) * 2048, I.conv_b + (L) * 512, I.norm_ml + (L) * 512, CAT2);
#define DBG_COMPARE() DBG_CMP(512)
#elif defined(DBG_AT)
#define DBG_NAIVE(L) attn_naive(F, PROJ, (const float*)(F.ctl + CW_KSUM) + (L) * (BATCH * NB * 512), I.norm_attn + (L) * 512, CAT2, 0, F.G * NWAVES);
#define DBG_COMPARE() DBG_CMP(0)
#else
#define DBG_NAIVE(L)
#define DBG_COMPARE()
#endif

#define LAYER_MIXER(L, P)                                                                                                                                   \
    if (IN(P)) {                                                                                                                          \
        pg8::Gemm g{XB, (const bf16*)(ws + WS_WIN) + (size_t)(L) * NPROJ * D, M, NPROJ, D}; pg8::StaticOrder S; S.init(M, NPROJ, F.G, (int)blockIdx.x);     \
        pg8::EpiProj E{PROJ, ROPE, (float*)(F.ctl + CW_KSUM) + (L) * (BATCH * NB * 512), QSCALE};                                                          \
        pg8::gemm_phase<pg8::EpiProj, pg8::StaticOrder, true, true>(F.lds, g, S, E); } SEAM(P);                                                             \
    ATB.BCNT = (unsigned*)(F.ctl + CW_BCNT) + (L) * 512;                                                                                                    \
    if (IN((P) + 1)) {                                                                            \
        for (int u = F.vcu; u < 512; u += F.G) ml_phase_a(F, u, PROJ, GATES, I.conv_w + (L) * 2048, I.conv_b + (L) * 512, MLB); PMID((P) + 1);               \
        for (int u = F.vcu; u < 256; u += F.G) { attn_route(F, u, PROJ, (const float*)(F.ctl + CW_KSUM) + (L) * (BATCH * NB * 512), ATB);                  \
            attn_route(F, 511 - u, PROJ, (const float*)(F.ctl + CW_KSUM) + (L) * (BATCH * NB * 512), ATB); }     \
        DBG_NAIVE(L) } SEAM((P) + 1);                                                                                                                       \
    if (IN((P) + 2)) {                                                      \
        const int nu = attn_tile_prefix(F, ATB);                                                                                                            \
        for (int u = F.vcu; u < 256; u += F.G) ml_phase_b(F, u, MLB); PMID((P) + 2);                                                                        \
        attn_sel_phase(F, nu, PROJ, ATB); } SEAM((P) + 2);                                                              \
    if (IN((P) + 3)) {                                                                             \
        for (int u = F.vcu; u < 512; u += F.G) ml_phase_c(F, u, PROJ, GATES, I.norm_ml + (L) * 512, CAT, MLB); PMID((P) + 3);                               \
        attn_own_phase(F, PROJ, I.norm_attn + (L) * 512, CAT, ATB); } SEAM((P) + 3);                               \
    if (IN((P) + 4)) {                                                                                                                   \
        DBG_COMPARE()                                                                                                                                       \
        pg8::Gemm g{CAT, (const bf16*)(ws + WS_WOUT) + (size_t)(L) * D * D, M, D, D}; pg8::StaticOrder S; S.init(M, D, F.G, (int)blockIdx.x);                \
        pg8::EpiBf16s E{MIXB, D, 1.f};                                                                                                                      \
        pg8::gemm_phase<pg8::EpiBf16s, pg8::StaticOrder, false, true>(F.lds, g, S, E); } SEAM((P) + 4);

    unsigned char* X1F8 = ws + WS_X1B; unsigned char* HD8 = ws + WS_HD; unsigned char* HM8 = ws + WS_HM; unsigned char* XS8 = ws + WS_XS;
    LAYER_MIXER(0, 1)
    if (IN(6)) { ln_phase<true, false, 0>(F, I.x, nullptr, MIXB, nullptr, I.ln1_g, I.ln1_b, nullptr, X1, X1F8, nullptr, nullptr, nullptr, nullptr, 1.f); } SEAM(6);
    if (IN(7)) {
        pg8::Gemm g{(const bf16*)X1F8, (const bf16*)(ws + WS_WGU), M, 2 * DFF, D / 2}; pg8::StaticOrder S; S.init(M, 2 * DFF, F.G, (int)blockIdx.x);
        pg8::EpiSwiglu8 E{HD8, DFF, 0, 1.f / SW_UP};
        pg8::gemm_phase<pg8::EpiSwiglu8, pg8::StaticOrder, true, true, true>(F.lds, g, S, E); } SEAM(7);
    if (IN(8)) {
        pg8::Gemm g{(const bf16*)HD8, (const bf16*)(ws + WS_WD), M, D, DFF / 2}; pg8::StaticOrder S; S.init(M, D, F.G, (int)blockIdx.x);
        pg8::EpiBf16s E{MIX2B, D, 1.f / SW_DN};
        pg8::gemm_phase<pg8::EpiBf16s, pg8::StaticOrder, false, true, true>(F.lds, g, S, E); } SEAM(8);
    if (IN(9)) { stage_xw(F, I.w_in + (size_t)D * NIN, NIN, NPROJ);
        ln_phase<false, false, 1>(F, nullptr, X1, MIX2B, nullptr, I.ln2_g, I.ln2_b, nullptr, XB, nullptr, I.gate_bias + 8, GATES, nullptr, nullptr, 1.f); } SEAM(9);
    LAYER_MIXER(1, 10)
    if (IN(15)) { stage_xw(F, I.router_w, 8, 0);
        ln_phase<false, false, 2>(F, nullptr, XB, MIXB, nullptr, I.ln1_g + D, I.ln1_b + D, nullptr, X1, X1F8, I.router_b, nullptr, LIST, LISTW, 1.f);
        __syncthreads(); PMID(15); moe_cvt(F, I); } SEAM(15);
    int ntiles = 0;
    if (lo <= 18 && hi > 16) ntiles = moe_plan(F);
    if (IN(16)) { moe_gather(F, ntiles, X1F8, XS8, LIST, LISTW, ROWMAP, ROWW); } SEAM(16);
    const PG8_LAS int* texp = (const PG8_LAS int*)(F.lds + TEXP_OFF);
    if (IN(17)) {
        pg8::Gemm g{(const bf16*)XS8, (const bf16*)(ws + WS_MGU), MAXT * 256, 2 * DEX, D / 2}; pg8::GroupedOrder<false> S; S.init(0, ntiles, 2 * DEX / 256, F.G, (int)blockIdx.x, texp);
        pg8::EpiSwiglu8 E{HM8, DEX, 0, 1.f / SW_UP};
        pg8::gemm_phase<pg8::EpiSwiglu8, pg8::GroupedOrder<false>, true, true, true>(F.lds, g, S, E); } SEAM(17);
    if (IN(18)) {
        pg8::Gemm g{(const bf16*)HM8, (const bf16*)(ws + WS_MD), MAXT * 256, D, DEX / 2}; pg8::GroupedOrder<true> S; S.init(0, ntiles, D / 256, F.G, (int)blockIdx.x, texp);
        pg8::EpiScatter E{YB, ROWMAP, ROWW, 0, M, 1.f / SW_DN};
        pg8::gemm_phase<pg8::EpiScatter, pg8::GroupedOrder<true>, true, true, true>(F.lds, g, S, E); } SEAM(18);
    if (IN(19)) { float osc = 1.f;
#if defined(DBG_ML) || defined(DBG_AT)
        osc = 1.f + 10.f * __hip_atomic_load((float*)(F.ctl + CW_DBG), RLX_AGENT) / (2.f * (float)M * 512.f);
#endif
        ln_phase<false, true, 0>(F, nullptr, X1, YB, YB + (size_t)M * D, I.ln2_g + D, I.ln2_b + D, args.out, nullptr, nullptr, nullptr, nullptr, nullptr, nullptr, osc); }
#ifdef PROBE_MASK
    if (blockIdx.x == 0 && F.tid == 0) { pts[N_PHASES] = __builtin_amdgcn_s_memrealtime(); unsigned long long sum = 0;
        for (int p = 0; p < N_PHASES; ++p) if ((PROBE_MASK >> p) & 1) sum += pts[p + 1] - pts[p];
#ifdef PROBE_SUB
        for (int p = 0; p < N_PHASES; ++p) if ((PROBE_SUB >> p) & 1) sum += pmid[p] - pts[p];
#endif
#ifdef PROBE_SEG
        sum += ((LAS unsigned long long*)(F.lds + MISC_OFF + 1536))[1 + PROBE_SEG];
#endif
        const unsigned long long t0 = __builtin_amdgcn_s_memrealtime(); while (__builtin_amdgcn_s_memrealtime() - t0 < 4 * sum) __builtin_amdgcn_s_sleep(8); }
#endif
#undef IN
#undef SEAM
}

extern "C" void kernel_launch(void* const* d_in, const int* in_sizes, int n_in, void* d_out, int out_size, void* d_ws, size_t ws_size, hipStream_t stream) {
    static int grid = 0;
    if (grid == 0) {
        if (n_in != 21 || in_sizes[0] != M * D || out_size != M * D || ws_size < WS_END) { fprintf(stderr, "kernel_launch: unexpected shapes (n_in %d, in0 %d, out %d, ws %zu < %zu); nothing launched\n", n_in, n_in > 0 ? in_sizes[0] : -1, out_size, ws_size, (size_t)WS_END); grid = -1; return; }
        int dev = 0, cus = 0, per_cu = 0;
        if (hipGetDevice(&dev) != hipSuccess || hipDeviceGetAttribute(&cus, hipDeviceAttributeMultiprocessorCount, dev) != hipSuccess) { grid = -1; return; }
        if (hipFuncSetAttribute((const void*)hymba_fwd, hipFuncAttributeMaxDynamicSharedMemorySize, LDS_BYTES) != hipSuccess) { fprintf(stderr, "kernel_launch: hipFuncSetAttribute failed\n"); grid = -1; return; }
        if (hipOccupancyMaxActiveBlocksPerMultiprocessor(&per_cu, (const void*)hymba_fwd, NWAVES * 64, LDS_BYTES) != hipSuccess || per_cu < 1) fprintf(stderr, "kernel_launch: occupancy query reports %d\n", per_cu);
        (void)hipGetLastError();
        grid = cus;
    }
    if (grid < 0) return;
    if (hipMemsetAsync((char*)d_ws + WS_CTL, 0, CTL_ZERO_BYTES, stream) != hipSuccess) return;
    Args a{};
    const void** ip = (const void**)&a.in;
    for (int i = 0; i < 21; ++i) ip[i] = d_in[i];
    a.out = (float*)d_out; a.ws = (unsigned char*)d_ws;
#if defined(MK_MULTI)
    for (int p = 0; p < N_PHASES; ++p) { a.ph_lo = p; a.ph_hi = p + 1;
        hipLaunchKernelGGL(hymba_fwd, dim3(grid), dim3(NWAVES * 64), LDS_BYTES, stream, a); }
#else
    a.ph_lo = 0; a.ph_hi = N_PHASES;
    hipLaunchKernelGGL(hymba_fwd, dim3(grid), dim3(NWAVES * 64), LDS_BYTES, stream, a);
#endif
}
```

```cpp
#include <hip/hip_runtime.h>
#include <cstdio>
#include <cstdint>
#include <cmath>
namespace pg8 {
#define PG8_LAS __attribute__((address_space(3)))
typedef unsigned short bf16_t;
typedef short bf16x8 __attribute__((ext_vector_type(8)));
typedef float f32x4 __attribute__((ext_vector_type(4)));
typedef unsigned u32x4 __attribute__((ext_vector_type(4)));
typedef int v8i_t __attribute__((ext_vector_type(8)));
typedef int v4i_t __attribute__((ext_vector_type(4)));
__device__ __forceinline__ v8i_t pg8_cat(bf16x8 lo, bf16x8 hi) { const v4i_t a = __builtin_bit_cast(v4i_t, lo), b = __builtin_bit_cast(v4i_t, hi); return __builtin_shufflevector(a, b, 0, 1, 2, 3, 4, 5, 6, 7); }
constexpr int BM = 256, BK = 64, HALF = 128, HTB = HALF * BK * 2  , STAGE_BYTES = 8 * HTB, NXCD = 8, WGM = 8;

__host__ __device__ __forceinline__ int lds_byte(int r, int c) { const int st = (r >> 4) * 2 + (c >> 5), rr = r & 15, cc = c & 31, ob = rr * 64 + cc * 2; return st * 1024 + (ob ^ (((ob >> 9) & 1) << 5)); }
__host__ __device__ __forceinline__ void stage_rc(int b, int& R, int& C) { const int st = b / 1024, sb = b % 1024, swz = sb ^ (((sb >> 9) & 1) << 5); R = (st >> 1) * 16 + swz / 64; C = (st & 1) * 32 + (swz % 64) / 2; }
__host__ __device__ __forceinline__ int perm32(int rho) { const int n = rho >> 4, i = rho & 15; return 8 * (i >> 2) + 4 * n + (i & 3); }

struct Unit { int pm, pn, pb; };
struct Gemm { const bf16_t* A; const bf16_t* Bt; int M, N, K; };

struct StaticOrder {
    int nM, nN, nwg, G, c;
    __host__ __device__ void init(int M, int N, int G_, int c_) { nM = M / BM; nN = N / BM; nwg = nM * nN; G = G_; c = c_; }
    __host__ __device__ bool next(int i, Unit& u) const {
        const long L = (long)i * G + c; if (L >= nwg) return false;
        int wgid = (int)L; { const int q = nwg / NXCD, r = nwg % NXCD, xcd = wgid % NXCD, off = wgid / NXCD; wgid = (xcd < r ? xcd * (q + 1) : r * (q + 1) + (xcd - r) * q) + off; }
        const int nig = WGM * nN, gid = wgid / nig, fm = gid * WGM, gsz = (nM - fm) < WGM ? (nM - fm) : WGM;
        u.pm = fm + ((wgid % nig) % gsz); u.pn = (wgid % nig) / gsz; u.pb = u.pn; return true;
    }
    __device__ __forceinline__ void a_ready(const Unit&) const {}
    __device__ __forceinline__ void done(const Unit&) const {}
};


__device__ __forceinline__ unsigned cvt_pk_bf16(float lo, float hi) { unsigned r; asm volatile("v_cvt_pk_bf16_f32 %0, %1, %2" : "=v"(r) : "v"(lo), "v"(hi)); return r; }
__device__ __forceinline__ u32x4 pack8(const f32x4 v0, const f32x4 v1) { u32x4 w; w.x = cvt_pk_bf16(v0[0], v0[1]); w.y = cvt_pk_bf16(v0[2], v0[3]); w.z = cvt_pk_bf16(v1[0], v1[1]); w.w = cvt_pk_bf16(v1[2], v1[3]); return w; }
__device__ __forceinline__ f32x4 shx16(const f32x4 v) { f32x4 r; r[0] = __shfl_xor(v[0], 16); r[1] = __shfl_xor(v[1], 16); r[2] = __shfl_xor(v[2], 16); r[3] = __shfl_xor(v[3], 16); return r; }

struct EpiF32 {
    static constexpr bool PERM = false, AFTER_DRAIN = false;
    float* C; int ldc;
    __device__ __forceinline__ void operator()(const f32x4 (&acc)[2][2][4][2], const Unit& u, int wr, int wc, int fr, int fq) const {
        const int row0 = u.pm * BM + wr * 64 + fr, col0 = u.pn * BM + wc * 32 + 4 * fq;
#pragma unroll
        for (int ai = 0; ai < 2; ++ai)
#pragma unroll
            for (int m = 0; m < 4; ++m) { float* rowp = C + (size_t)(row0 + ai * HALF + m * 16) * ldc + col0;
#pragma unroll
                for (int bj = 0; bj < 2; ++bj)
#pragma unroll
                    for (int n = 0; n < 2; ++n) *(f32x4*)(rowp + bj * HALF + n * 16) = acc[ai][bj][m][n]; }
    }
};


struct EpiBf16s {
    static constexpr bool PERM = true, AFTER_DRAIN = false;
    bf16_t* O; int ldc; float s;
    __device__ __forceinline__ void operator()(const f32x4 (&acc)[2][2][4][2], const Unit& u, int wr, int wc, int fr, int fq) const {
        const int row0 = u.pm * BM + wr * 64 + fr, col0 = u.pn * BM + wc * 32 + 8 * fq;
#pragma unroll
        for (int ai = 0; ai < 2; ++ai)
#pragma unroll
            for (int m = 0; m < 4; ++m) { bf16_t* rowp = O + (size_t)(row0 + ai * HALF + m * 16) * ldc + col0;
#pragma unroll
                for (int bj = 0; bj < 2; ++bj) *(u32x4*)(rowp + bj * HALF) = pack8(acc[ai][bj][m][0] * s, acc[ai][bj][m][1] * s); }
    }
};
struct EpiProj {
    static constexpr bool PERM = true, AFTER_DRAIN = false;
    bf16_t* O; const float* rope; float* ksum; float qscale;
    __device__ __forceinline__ void operator()(const f32x4 (&acc)[2][2][4][2], const Unit& u, int wr, int wc, int fr, int fq) const {
        const int row0 = u.pm * BM + wr * 64 + fr; const int colt = u.pn * BM; const int col0 = colt + wc * 32 + 8 * fq;
        const bool is_qk = u.pn < 4, is_q = u.pn < 2, rot = is_qk && ((wc & 1) == 0);
        float ks[2][8];
#pragma unroll
        for (int bj = 0; bj < 2; ++bj)
#pragma unroll
            for (int i = 0; i < 8; ++i) ks[bj][i] = 0.f;
#pragma unroll
        for (int ai = 0; ai < 2; ++ai)
#pragma unroll
            for (int m = 0; m < 4; ++m) { const int row = row0 + ai * HALF + m * 16; bf16_t* rowp = O + (size_t)row * 3072 + col0;
                f32x4 c0 = {1.f, 1.f, 1.f, 1.f}, c1 = c0, s0 = {0.f, 0.f, 0.f, 0.f}, s1 = s0;
                if (rot && fq < 2) { const f32x4* rp = (const f32x4*)(rope + (size_t)row * 16); c0 = rp[0]; c1 = rp[1]; s0 = rp[2]; s1 = rp[3]; if (fq == 0) { s0 = -s0; s1 = -s1; } }
#pragma unroll
                for (int bj = 0; bj < 2; ++bj) { f32x4 v0 = acc[ai][bj][m][0], v1 = acc[ai][bj][m][1];
                    if (rot) { const f32x4 p0 = shx16(v0), p1 = shx16(v1); v0 = v0 * c0 + p0 * s0; v1 = v1 * c1 + p1 * s1; }
                    if (is_q) { v0 = v0 * qscale; v1 = v1 * qscale; }
                    else if (is_qk) {
#pragma unroll
                        for (int i = 0; i < 4; ++i) { ks[bj][i] += v0[i]; ks[bj][4 + i] += v1[i]; } }
                    *(u32x4*)(rowp + bj * HALF) = pack8(v0, v1); } }
        if (is_qk && !is_q) {
            float* kd = ksum + (size_t)u.pm * 512 + (colt - 512) + wc * 32 + 8 * fq;
#pragma unroll
            for (int bj = 0; bj < 2; ++bj)
#pragma unroll
                for (int i = 0; i < 8; ++i) { float s = ks[bj][i]; s += __shfl_xor(s, 1); s += __shfl_xor(s, 2); s += __shfl_xor(s, 4); s += __shfl_xor(s, 8);
                    if (fr == 0) __hip_atomic_fetch_add(kd + bj * HALF + i, s, __ATOMIC_RELAXED, __HIP_MEMORY_SCOPE_AGENT); }
        }
    }
};

__device__ __forceinline__ float silu_f(float x) { return x * __builtin_amdgcn_rcpf(1.0f + __builtin_amdgcn_exp2f(-1.4426950408889634f * x)); }
struct EpiSwiglu {
    static constexpr bool PERM = true, AFTER_DRAIN = false;
    bf16_t* H; int ldh; int pm_off;
    __device__ __forceinline__ void operator()(const f32x4 (&acc)[2][2][4][2], const Unit& u, int wr, int wc, int fr, int fq) const {
        const int row0 = (u.pm - pm_off) * BM + wr * 64 + fr; const int col0 = u.pn * HALF + wc * 32 + 8 * fq;
#pragma unroll
        for (int ai = 0; ai < 2; ++ai)
#pragma unroll
            for (int m = 0; m < 4; ++m) { bf16_t* rowp = H + (size_t)(row0 + ai * HALF + m * 16) * ldh + col0;
                const f32x4 g0 = acc[ai][0][m][0], g1 = acc[ai][0][m][1], u0 = acc[ai][1][m][0], u1 = acc[ai][1][m][1]; f32x4 h0, h1;
#pragma unroll
                for (int i = 0; i < 4; ++i) { h0[i] = silu_f(g0[i]) * u0[i]; h1[i] = silu_f(g1[i]) * u1[i]; }
                *(u32x4*)rowp = pack8(h0, h1); }
    }
};

typedef unsigned u32x2 __attribute__((ext_vector_type(2)));
__device__ __forceinline__ float clamp448(float x) { return fminf(fmaxf(x, -448.f), 448.f); }
__device__ __forceinline__ unsigned f8x4(float a, float b, float c, float d) { int p = 0; p = __builtin_amdgcn_cvt_pk_fp8_f32(clamp448(a), clamp448(b), p, false); p = __builtin_amdgcn_cvt_pk_fp8_f32(clamp448(c), clamp448(d), p, true); return (unsigned)p; }
struct EpiSwiglu8 {
    static constexpr bool PERM = true, AFTER_DRAIN = false;
    unsigned char* H; int ldh; int pm_off; float sg;
    __device__ __forceinline__ void operator()(const f32x4 (&acc)[2][2][4][2], const Unit& u, int wr, int wc, int fr, int fq) const {
        const int row0 = (u.pm - pm_off) * BM + wr * 64 + fr; const int col0 = u.pn * HALF + wc * 32 + 8 * fq;
#pragma unroll
        for (int ai = 0; ai < 2; ++ai)
#pragma unroll
            for (int m = 0; m < 4; ++m) { unsigned char* rowp = H + (size_t)(row0 + ai * HALF + m * 16) * ldh + col0;
                const f32x4 g0 = acc[ai][0][m][0] * sg, g1 = acc[ai][0][m][1] * sg, u0 = acc[ai][1][m][0] * sg, u1 = acc[ai][1][m][1] * sg; f32x4 h0, h1;
#pragma unroll
                for (int i = 0; i < 4; ++i) { h0[i] = silu_f(g0[i]) * u0[i]; h1[i] = silu_f(g1[i]) * u1[i]; }
                u32x2 w; w.x = f8x4(h0[0], h0[1], h0[2], h0[3]); w.y = f8x4(h1[0], h1[1], h1[2], h1[3]); *(u32x2*)rowp = w; }
    }
};
struct EpiF32s {
    static constexpr bool PERM = false, AFTER_DRAIN = false;
    float* C; int ldc; float s;
    __device__ __forceinline__ void operator()(const f32x4 (&acc)[2][2][4][2], const Unit& u, int wr, int wc, int fr, int fq) const {
        const int row0 = u.pm * BM + wr * 64 + fr, col0 = u.pn * BM + wc * 32 + 4 * fq;
#pragma unroll
        for (int ai = 0; ai < 2; ++ai)
#pragma unroll
            for (int m = 0; m < 4; ++m) { float* rowp = C + (size_t)(row0 + ai * HALF + m * 16) * ldc + col0;
#pragma unroll
                for (int bj = 0; bj < 2; ++bj)
#pragma unroll
                    for (int n = 0; n < 2; ++n) *(f32x4*)(rowp + bj * HALF + n * 16) = acc[ai][bj][m][n] * s; }
    }
};
struct EpiScatter {
    static constexpr bool PERM = true, AFTER_DRAIN = false;
    bf16_t* Y; const int* rowmap; const float* roww; int pm_off; int mtok; float s;
    __device__ __forceinline__ void operator()(const f32x4 (&acc)[2][2][4][2], const Unit& u, int wr, int wc, int fr, int fq) const {
        const int row0 = (u.pm + pm_off) * BM + wr * 64 + fr; const int col0 = u.pn * BM + wc * 32 + 8 * fq;
#pragma unroll
        for (int ai = 0; ai < 2; ++ai)
#pragma unroll
            for (int m = 0; m < 4; ++m) { const int r = row0 + ai * HALF + m * 16; const int ts = rowmap[r];
                if (ts >= 0) { const float w = roww[r] * s; bf16_t* rowp = Y + ((size_t)(ts & 1) * mtok + (ts >> 1)) * 1024 + col0;
#pragma unroll
                    for (int bj = 0; bj < 2; ++bj) *(u32x4*)(rowp + bj * HALF) = pack8(acc[ai][bj][m][0] * w, acc[ai][bj][m][1] * w); } }
    }
};
template <bool REL> struct GroupedOrder {
    int t0, nM, nN, nwg, G, c; const PG8_LAS int* texp;
    __device__ __forceinline__ void init(int t0_, int t1_, int nN_, int G_, int c_, const PG8_LAS int* texp_) { t0 = t0_; nM = t1_ - t0_; if (nM < 0) nM = 0; nN = nN_; nwg = nM * nN; G = G_; c = c_; texp = texp_; }
    __device__ __forceinline__ bool next(int i, Unit& u) const {
        const long L = (long)i * G + c; if (L >= nwg) return false;
        int wgid = (int)L; { const int q = nwg / NXCD, r = nwg % NXCD, xcd = wgid % NXCD, off = wgid / NXCD; wgid = (xcd < r ? xcd * (q + 1) : r * (q + 1) + (xcd - r) * q) + off; }
        const int nig = WGM * nN, gid = wgid / nig, fm = gid * WGM, gsz = (nM - fm) < WGM ? (nM - fm) : WGM;
        const int pmr = fm + ((wgid % nig) % gsz); u.pn = (wgid % nig) / gsz; u.pm = REL ? pmr : (t0 + pmr); u.pb = texp[t0 + pmr] * nN + u.pn; return true;
    }
    __device__ __forceinline__ void a_ready(const Unit&) const {}
    __device__ __forceinline__ void done(const Unit&) const {}
};
template <class Epi, class Sched, bool ALIGN_EPI = false, bool SP2 = false, bool F8 = false>
__device__ __forceinline__ void gemm_phase(PG8_LAS unsigned char* lds, const Gemm g, const Sched& S, const Epi& E) {
    const int tid = threadIdx.x, wid = __builtin_amdgcn_readfirstlane(tid >> 6), lane = tid & 63, wr = wid >> 2, wc = wid & 3, fr = lane & 15, fq = lane >> 4;
    const int K = g.K, nt = K / BK;
    unsigned voffA[2], voffB[2];
#pragma unroll
    for (int i = 0; i < 2; ++i) { int R, C; stage_rc(tid * 16 + i * 8192, R, C); const int Rb = Epi::PERM ? ((R & ~31) + perm32(R & 31)) : R;
        voffA[i] = (unsigned)(R * K + C) * 2u; voffB[i] = (unsigned)(Rb * K + C) * 2u; }
    const size_t kstep = (size_t)(BK * 2);
    const size_t hstep = (size_t)HALF * K * 2;
    const size_t tstep = 2 * hstep;
    const unsigned ldsw = (unsigned)wid * 1024u;
    const int aoff = lds_byte(wr * 64 + fr, fq * 8), boff = lds_byte(wc * 32 + fr, fq * 8);
#define PG8_SA(b, h) (((b) * 2 + (h)) * HTB)
#define PG8_SB(b, h) ((4 + (b) * 2 + (h)) * HTB)
#define PG8_STAGE(bufoff, gbase, voff) do { _Pragma("unroll") for (int _i = 0; _i < 2; ++_i) \
        __builtin_amdgcn_global_load_lds((const unsigned*)((const char*)(gbase) + (voff)[_i]), (PG8_LAS unsigned*)(lds + (bufoff) + ldsw + _i * 8192), 16, 0, 0); } while (0)
#define PG8_LDA(dst, b, h) do { if constexpr (F8) { _Pragma("unroll") for (int m = 0; m < 4; ++m) dst##8[m] = pg8_cat(*(const PG8_LAS bf16x8*)(lds + PG8_SA(b, h) + aoff + m * 2048), *(const PG8_LAS bf16x8*)(lds + PG8_SA(b, h) + aoff + m * 2048 + 1024)); } else { _Pragma("unroll") for (int m = 0; m < 4; ++m) _Pragma("unroll") for (int k = 0; k < 2; ++k) dst[m][k] = *(const PG8_LAS bf16x8*)(lds + PG8_SA(b, h) + aoff + m * 2048 + k * 1024); } } while (0)
#define PG8_LDB(dst, b, h) do { if constexpr (F8) { _Pragma("unroll") for (int n = 0; n < 2; ++n) dst##8[n] = pg8_cat(*(const PG8_LAS bf16x8*)(lds + PG8_SB(b, h) + boff + n * 2048), *(const PG8_LAS bf16x8*)(lds + PG8_SB(b, h) + boff + n * 2048 + 1024)); } else { _Pragma("unroll") for (int n = 0; n < 2; ++n) _Pragma("unroll") for (int k = 0; k < 2; ++k) dst[n][k] = *(const PG8_LAS bf16x8*)(lds + PG8_SB(b, h) + boff + n * 2048 + k * 1024); } } while (0)
#define PG8_MMA(ai, bj, At, Bt) do { __builtin_amdgcn_s_setprio(1); if constexpr (F8) { _Pragma("unroll") for (int m = 0; m < 4; ++m) _Pragma("unroll") for (int n = 0; n < 2; ++n) asm volatile("v_mfma_f32_16x16x128_f8f6f4 %0, %1, %2, %0" : "+v"(acc[ai][bj][m][n]) : "v"(Bt##8[n]), "v"(At##8[m])); } else { _Pragma("unroll") for (int m = 0; m < 4; ++m) _Pragma("unroll") for (int n = 0; n < 2; ++n) _Pragma("unroll") for (int k = 0; k < 2; ++k) acc[ai][bj][m][n] = __builtin_amdgcn_mfma_f32_16x16x32_bf16(Bt[n][k], At[m][k], acc[ai][bj][m][n], 0, 0, 0); } __builtin_amdgcn_s_setprio(0); } while (0)
#define PG8_WAIT_V(n) asm volatile("s_waitcnt vmcnt(" #n ")" ::: "memory")
#define PG8_WAIT_L(n) asm volatile("s_waitcnt lgkmcnt(" #n ")" ::: "memory")
#define PG8_BAR __builtin_amdgcn_s_barrier()
#define PG8_SCHED __builtin_amdgcn_sched_barrier(0)
    Unit cur, nxt; int ui = 0;
    if (!S.next(0, cur)) return;
    f32x4 acc[2][2][4][2];
#pragma unroll
    for (int a = 0; a < 2; ++a)
#pragma unroll
        for (int b = 0; b < 2; ++b)
#pragma unroll
            for (int m = 0; m < 4; ++m)
#pragma unroll
                for (int n = 0; n < 2; ++n) acc[a][b][m][n] = (f32x4){0.f, 0.f, 0.f, 0.f};
    bf16x8 At[4][2], B0[2][2], B1[2][2];
    v8i_t At8[4], B08[2], B18[2];
    const char* cA = (const char*)g.A + (size_t)cur.pm * tstep; const char* cB = (const char*)g.Bt + (size_t)cur.pb * tstep;
    S.a_ready(cur);
    if constexpr (SP2) {
        PG8_STAGE(PG8_SB(0, 0), cB, voffB); PG8_STAGE(PG8_SB(0, 1), cB + hstep, voffB); PG8_STAGE(PG8_SA(0, 0), cA, voffA); PG8_STAGE(PG8_SA(0, 1), cA + hstep, voffA);
        if (wr == 1) PG8_BAR;
        PG8_WAIT_V(2); PG8_BAR;
        PG8_STAGE(PG8_SB(1, 0), cB + kstep, voffB); PG8_STAGE(PG8_SA(1, 0), cA + kstep, voffA); PG8_STAGE(PG8_SB(1, 1), cB + hstep + kstep, voffB);
        PG8_WAIT_V(6); PG8_BAR;
    } else {
        PG8_STAGE(PG8_SB(0, 0), cB, voffB); PG8_STAGE(PG8_SA(0, 0), cA, voffA); PG8_STAGE(PG8_SB(0, 1), cB + hstep, voffB); PG8_STAGE(PG8_SA(0, 1), cA + hstep, voffA);
        if (wr == 1) PG8_BAR;
        PG8_WAIT_V(4); PG8_BAR;
        PG8_STAGE(PG8_SB(1, 0), cB + kstep, voffB); PG8_STAGE(PG8_SA(1, 0), cA + kstep, voffA); PG8_STAGE(PG8_SB(1, 1), cB + hstep + kstep, voffB);
        PG8_WAIT_V(6); PG8_BAR;
    }
    for (;;) {
        const bool has_next = S.next(ui + 1, nxt);
        const char* nA = has_next ? (const char*)g.A + (size_t)nxt.pm * tstep : cA; const char* nB = has_next ? (const char*)g.Bt + (size_t)nxt.pb * tstep : cB;
        for (int t = 0; t < nt; t += 2) {
            const bool last = (t == nt - 2);
            const char* a1 = cA + (size_t)(t + 1) * kstep;
            const char* a2 = last ? nA : cA + (size_t)(t + 2) * kstep; const char* b2 = last ? nB : cB + (size_t)(t + 2) * kstep;
            const char* a3 = a2 + kstep; const char* b3 = b2 + kstep;
            if (last && has_next) S.a_ready(nxt);
            if constexpr (SP2) {
            PG8_LDB(B0, 0, 0); PG8_LDB(B1, 0, 1); PG8_SCHED; PG8_LDA(At, 0, 0); PG8_STAGE(PG8_SA(1, 1), a1 + hstep, voffA);
            PG8_WAIT_V(8); PG8_WAIT_L(0); PG8_BAR; PG8_MMA(0, 0, At, B0); PG8_MMA(0, 1, At, B1); PG8_BAR; PG8_SCHED;
            PG8_LDA(At, 0, 1); PG8_STAGE(PG8_SB(0, 0), b2, voffB); PG8_STAGE(PG8_SB(0, 1), b2 + hstep, voffB); PG8_STAGE(PG8_SA(0, 0), a2, voffA);
            PG8_WAIT_V(8); PG8_WAIT_L(0); PG8_BAR; PG8_MMA(1, 0, At, B0); PG8_MMA(1, 1, At, B1); PG8_BAR; PG8_SCHED;
            PG8_LDB(B0, 1, 0); PG8_LDB(B1, 1, 1); PG8_SCHED; PG8_LDA(At, 1, 0); PG8_STAGE(PG8_SA(0, 1), a2 + hstep, voffA);
            PG8_WAIT_V(8); PG8_WAIT_L(0); PG8_BAR; PG8_MMA(0, 0, At, B0); PG8_MMA(0, 1, At, B1); PG8_BAR; PG8_SCHED;
            PG8_LDA(At, 1, 1); PG8_STAGE(PG8_SB(1, 0), b3, voffB); PG8_STAGE(PG8_SB(1, 1), b3 + hstep, voffB); PG8_STAGE(PG8_SA(1, 0), a3, voffA);
            PG8_WAIT_V(8); PG8_WAIT_L(0); PG8_BAR; PG8_MMA(1, 0, At, B0); PG8_MMA(1, 1, At, B1); PG8_BAR; PG8_SCHED;
            } else {
            PG8_LDB(B0, 0, 0); PG8_SCHED; PG8_LDA(At, 0, 0); PG8_STAGE(PG8_SA(1, 1), a1 + hstep, voffA);
            PG8_WAIT_L(8); PG8_BAR; PG8_WAIT_L(0); PG8_MMA(0, 0, At, B0); PG8_BAR; PG8_SCHED;
            PG8_LDB(B1, 0, 1); PG8_STAGE(PG8_SB(0, 0), b2, voffB);
            PG8_BAR; PG8_WAIT_L(0); PG8_MMA(0, 1, At, B1); PG8_BAR;
            PG8_LDA(At, 0, 1); PG8_STAGE(PG8_SA(0, 0), a2, voffA);
            PG8_BAR; PG8_WAIT_L(0); PG8_MMA(1, 0, At, B0); PG8_BAR; PG8_SCHED;
            PG8_STAGE(PG8_SB(0, 1), b2 + hstep, voffB);
            PG8_WAIT_V(6); PG8_BAR; PG8_MMA(1, 1, At, B1); PG8_BAR;
            PG8_LDB(B0, 1, 0); PG8_SCHED; PG8_LDA(At, 1, 0); PG8_STAGE(PG8_SA(0, 1), a2 + hstep, voffA);
            PG8_WAIT_L(8); PG8_BAR; PG8_WAIT_L(0); PG8_MMA(0, 0, At, B0); PG8_BAR; PG8_SCHED;
            PG8_LDB(B1, 1, 1); PG8_STAGE(PG8_SB(1, 0), b3, voffB);
            PG8_BAR; PG8_WAIT_L(0); PG8_MMA(0, 1, At, B1); PG8_BAR;
            PG8_LDA(At, 1, 1); PG8_STAGE(PG8_SA(1, 0), a3, voffA);
            PG8_BAR; PG8_WAIT_L(0); PG8_MMA(1, 0, At, B0); PG8_BAR; PG8_SCHED;
            PG8_STAGE(PG8_SB(1, 1), b3 + hstep, voffB);
            PG8_WAIT_V(6); PG8_BAR; PG8_MMA(1, 1, At, B1); PG8_BAR;
            }
        }
        if constexpr (F8) { asm volatile("s_nop 15\n\ts_nop 7" ::: "memory"); }
        if constexpr (ALIGN_EPI) { if (wr == 0) PG8_BAR; }
        if constexpr (!Epi::AFTER_DRAIN) { E(acc, cur, wr, wc, fr, fq); S.done(cur); }
        if (!has_next) break;
#pragma unroll
        for (int a = 0; a < 2; ++a)
#pragma unroll
            for (int b = 0; b < 2; ++b)
#pragma unroll
                for (int m = 0; m < 4; ++m)
#pragma unroll
                    for (int n = 0; n < 2; ++n) acc[a][b][m][n] = (f32x4){0.f, 0.f, 0.f, 0.f};
        cur = nxt; cA = nA; cB = nB; ++ui;
        if constexpr (ALIGN_EPI) { if (wr == 1) PG8_BAR; }
    }
    PG8_WAIT_V(0);
    if constexpr (!ALIGN_EPI) { if (wr == 0) PG8_BAR; }
    PG8_BAR;
    if constexpr (Epi::AFTER_DRAIN) { E.fused(acc, cur, wr, wc, fr, fq, lds, wid, lane); S.done(cur); }
#undef PG8_SA
#undef PG8_SB
#undef PG8_STAGE
#undef PG8_LDA
#undef PG8_LDB
#undef PG8_MMA
#undef PG8_WAIT_V
#undef PG8_WAIT_L
#undef PG8_BAR
#undef PG8_SCHED
}
}

constexpr int NWAVES = 8;
constexpr int BATCH = 2, SEQ = 8192, D = 1024, M = BATCH * SEQ;
constexpr int NPROJ = 3072, NIN = 3080;
constexpr int AH = 8, NB = 32;
constexpr int C_AQ = 0, C_AK = 512, C_AV = 1024, C_MQ = 1536, C_MK = 1792, C_MV = 2048, C_MO = 2560;
constexpr int MH = 4, MLC = 128, NCH = SEQ / MLC;
constexpr int DFF = 2816, NE = 8, DEX = 3584;
constexpr int MAXT = 136;
constexpr int CAP = 136;
constexpr float LN_EPS = 1e-5f, RMS_EPS = 1e-6f;
#ifndef CVT_NA_V
#define CVT_NA_V 6000
#endif
#ifndef CVT_ND_V
#define CVT_ND_V 5000
#endif
constexpr int CVT_NA = CVT_NA_V, CVT_ND = CVT_ND_V;
constexpr float ALPHA = 1.41421356237309515f;
constexpr float SW_UP = 32.f, SW_DN = 128.f;
constexpr float QSCALE = 0.125f * 1.4426950408889634f;

constexpr size_t MiB = 1u << 20;
constexpr size_t WS_CTL = 0, CTL_ZERO_BYTES = 1 * MiB;
constexpr size_t WS_ROPE = 1 * MiB;
constexpr size_t WS_GATES = 2 * MiB;
constexpr size_t WS_ROWMAP = 2 * MiB + 512 * 1024, WS_ROWW = 2 * MiB + 768 * 1024;
constexpr size_t WS_LIST = 3 * MiB, WS_LISTW = 3 * MiB + 512 * 1024;
constexpr size_t WS_WIN = 4 * MiB, WS_WOUT = 16 * MiB, WS_WGU = 20 * MiB, WS_WD = 31 * MiB;
constexpr size_t WS_MGU = 253 * MiB, WS_MD = 140 * MiB;
constexpr size_t WS_MIX2 = 377 * MiB;
constexpr size_t WS_QC = 37 * MiB, WS_KC = 45 * MiB, WS_DC = 53 * MiB, WS_CST = 69 * MiB, WS_DN = 77 * MiB, WS_NST = 77 * MiB + 256 * 1024, WS_SC = 77 * MiB + 512 * 1024, WS_MC = 77 * MiB + 768 * 1024;
constexpr size_t WS_PO = 80 * MiB, WS_PML = 128 * MiB, WS_SEL = 131 * MiB, WS_LISTQ = 132 * MiB;
constexpr size_t WS_CAT2 = 169 * MiB;
constexpr size_t WS_XB = 205 * MiB, WS_X1B = 237 * MiB, WS_XR = 269 * MiB, WS_PROJ = 333 * MiB, WS_CAT = 429 * MiB;
constexpr size_t WS_X1 = 429 * MiB;
constexpr size_t WS_MIX = 333 * MiB;
constexpr size_t WS_HD = 333 * MiB;
constexpr size_t WS_Y = 71 * MiB, WS_HM = 309 * MiB, WS_XS = 37 * MiB, WS_END = 461 * MiB;
static_assert(WS_HM + (size_t)CAP * 256 * DEX <= WS_CAT && WS_XS + (size_t)MAXT * 256 * D <= WS_Y && WS_Y + (size_t)2 * M * D * 2 <= WS_MD && WS_MD + (size_t)NE * D * DEX <= WS_CAT2 && WS_MGU + (size_t)NE * 2 * DEX * D <= WS_HM && WS_X1B + (size_t)M * D <= WS_MGU, "MoE map");
static_assert(WS_HD + (size_t)M * DFF <= WS_MIX2 && WS_MIX2 + (size_t)M * D * 2 <= WS_CAT && WS_WD + (size_t)D * DFF <= 37 * MiB && WS_WGU + (size_t)2 * DFF * D <= WS_WD, "map");
constexpr int CW_TMO = 0, CW_CODE = 1;
constexpr int CW_BAR = 4096;
constexpr int CW_ECNT = 16384;
constexpr int CW_DBG = 2048;
constexpr int CW_BCNT = 32768;
constexpr int CW_KSUM = 65536;

constexpr int LDS_BYTES = 147456;
constexpr int MISC_OFF = LDS_BYTES - 2048;
constexpr int TEXP_OFF = MISC_OFF + 256;
constexpr int XW_OFF = 100 * 1024;

#define GAS __attribute__((address_space(1)))
#define LAS __attribute__((address_space(3)))
typedef unsigned short bf16;
typedef unsigned v4u __attribute__((ext_vector_type(4)));
typedef unsigned v2u __attribute__((ext_vector_type(2)));
typedef float f32x4 __attribute__((ext_vector_type(4)));
typedef GAS unsigned gu32;
#define RLX_AGENT __ATOMIC_RELAXED, __HIP_MEMORY_SCOPE_AGENT
#define LDS_WAIT() asm volatile("s_waitcnt lgkmcnt(0)" ::: "memory")
#define VM_WAIT() asm volatile("s_waitcnt vmcnt(0)" ::: "memory")
__device__ __forceinline__ unsigned f2bf(float f) { unsigned u = __builtin_bit_cast(unsigned, f); return (u + 0x7fffu + ((u >> 16) & 1u)) >> 16; }
__device__ __forceinline__ unsigned pk2(float lo, float hi) { return f2bf(lo) | (f2bf(hi) << 16); }
__device__ __forceinline__ float bf2f(unsigned short h) { return __builtin_bit_cast(float, (unsigned)h << 16); }
__device__ __forceinline__ float bflo(unsigned w) { return __builtin_bit_cast(float, w << 16); }
__device__ __forceinline__ float bfhi(unsigned w) { return __builtin_bit_cast(float, w & 0xffff0000u); }

#ifdef PROBE_SEG
#define PSEG(id) do { if (blockIdx.x == 0 && threadIdx.x == 0) { LAS unsigned long long* sg_ = (LAS unsigned long long*)(F.lds + MISC_OFF + 1536); const unsigned long long n_ = __builtin_amdgcn_s_memrealtime(); sg_[1 + (id)] += n_ - sg_[0]; sg_[0] = n_; } } while (0)
#else
#define PSEG(id)
#endif
#define XB_TMO      128
#define XB_XCNT(j)  (256  + 64 * (j))
#define XB_XSUB(j)  (1280 + 64 * (j))
#define XB_XGEN(j)  (2304 + 64 * (j))
#define XB_TOP      3328
#define XB_TOPGEN   3392
#define XCD_BAR_WORDS 3456
#define XB_SPIN_CAP (1u << 18)

__device__ __forceinline__ unsigned xb_ld(unsigned* p)              { return __hip_atomic_load(p, __ATOMIC_RELAXED, __HIP_MEMORY_SCOPE_AGENT); }
__device__ __forceinline__ unsigned xb_add(unsigned* p, unsigned v) { return __hip_atomic_fetch_add(p, v, __ATOMIC_RELAXED, __HIP_MEMORY_SCOPE_AGENT); }
__device__ __forceinline__ unsigned xb_xcc_id() { return (unsigned)__builtin_amdgcn_s_getreg((3 << 11) | 20) & 0xFu; }
#define XB_SPIN(cond, bar) do { unsigned _sp = 0; while (cond) { __builtin_amdgcn_s_sleep(1); \
    if ((++_sp & 255u) == 0u) { if (xb_ld(&(bar)[XB_TMO])) break; if (_sp > XB_SPIN_CAP) { atomicAdd(&(bar)[XB_TMO], 1u); break; } } } } while (0)

struct XcdBarrier {
    unsigned* bar; unsigned x;
    volatile LAS unsigned* st;
};

__device__ __forceinline__ XcdBarrier xcd_barrier_post(unsigned* bar, volatile LAS unsigned* st) {
    XcdBarrier b; b.bar = bar; b.x = xb_xcc_id(); b.st = st;
    if (threadIdx.x == 0) (void)xb_add(&bar[XB_XCNT(b.x)], 1u);
    return b;
}
__device__ __forceinline__ void xcd_barrier_complete(unsigned* bar, unsigned x, unsigned& nloc, unsigned& nx) {
    const unsigned G = gridDim.x * gridDim.y * gridDim.z;
    unsigned sum, cnt, mine, sp = 0u;
    for (;;) {
        sum = 0u; cnt = 0u; mine = 0u;
#pragma unroll
        for (unsigned j = 0; j < 16; ++j) { const unsigned c = xb_ld(&bar[XB_XCNT(j)]); sum += c; cnt += (c > 0u) ? 1u : 0u; mine = (j == x) ? c : mine; }
        if (sum == G) break;
        __builtin_amdgcn_s_sleep(1);
        if ((++sp & 255u) == 0u) { if (xb_ld(&bar[XB_TMO])) break; if (sp > XB_SPIN_CAP) { atomicAdd(&bar[XB_TMO], 1u); break; } }
    }
    nloc = mine > 0u ? mine : 1u; nx = cnt > 0u ? cnt : 1u;
}

__device__ __forceinline__ void xcd_barrier(const XcdBarrier& b) {
    asm volatile("s_waitcnt vmcnt(0)" ::: "memory");
    __syncthreads();
    if (threadIdx.x == 0) {
        unsigned* bar = b.bar;
        __builtin_amdgcn_s_waitcnt(0);
        unsigned nloc = b.st[0], nx = b.st[1];
        if (nloc == 0u) { xcd_barrier_complete(bar, b.x, nloc, nx); b.st[0] = nloc; b.st[1] = nx; }
        const unsigned old = xb_add(&bar[XB_XSUB(b.x)], 1u);
        const unsigned gen = old / nloc;
        if (old + 1u == (gen + 1u) * nloc) {
            __builtin_amdgcn_fence(__ATOMIC_RELEASE, "agent");
            asm volatile("s_waitcnt vmcnt(0)" ::: "memory");
            const unsigned og = xb_add(&bar[XB_TOP], 1u);
            const unsigned tg = og / nx;
            if (og + 1u == (tg + 1u) * nx) xb_add(&bar[XB_TOPGEN], 1u);
            else XB_SPIN(xb_ld(&bar[XB_TOPGEN]) == tg, bar);
            __builtin_amdgcn_fence(__ATOMIC_ACQUIRE, "agent");
            xb_add(&bar[XB_XGEN(b.x)], 1u);
            asm volatile("s_waitcnt vmcnt(0)" ::: "memory");
        } else {
            XB_SPIN(xb_ld(&bar[XB_XGEN(b.x)]) == gen, bar);
            __builtin_amdgcn_fence(__ATOMIC_ACQUIRE, "agent");
            asm volatile("s_waitcnt vmcnt(0)" ::: "memory");
        }
    }
    __syncthreads();
}

struct Frame {
    LAS unsigned char* lds;
    volatile LAS unsigned* MISC;
    gu32* ctl;
    int tid, lane, wave;
    int vcu, G;
    unsigned char* ws;
};
__device__ __forceinline__ float wave_sum(float v) {
#pragma unroll
    for (int o = 1; o < 64; o <<= 1) v += __shfl_xor(v, o);
    return v;
}
__device__ __forceinline__ float wave_max(float v) {
#pragma unroll
    for (int o = 1; o < 64; o <<= 1) v = fmaxf(v, __shfl_xor(v, o));
    return v;
}
__device__ __forceinline__ void transpose_item(const float* W, int ldw, int k0, int n0, bf16* WT, int K, int drow0, LAS float* scr, int lane) {
    float tv[32];
#pragma unroll
    for (int i = 0; i < 32; ++i) { const int kk = 2 * i + (lane >> 5); tv[i] = W[(size_t)(k0 + kk) * ldw + n0 + (lane & 31)]; }
#pragma unroll
    for (int i = 0; i < 32; ++i) { const int kk = 2 * i + (lane >> 5); scr[kk * 33 + (lane & 31)] = tv[i]; }
    LDS_WAIT(); asm volatile("" ::: "memory");
    const int c = lane & 7;
#pragma unroll
    for (int j = 0; j < 4; ++j) { const int n = (lane >> 3) + 8 * j; const LAS float* s = scr + (8 * c) * 33 + n;
        v4u o; o.x = pk2(s[0 * 33], s[1 * 33]); o.y = pk2(s[2 * 33], s[3 * 33]); o.z = pk2(s[4 * 33], s[5 * 33]); o.w = pk2(s[6 * 33], s[7 * 33]);
        *(GAS v4u*)(WT + (size_t)(drow0 + n) * K + k0 + 8 * c) = o; }
    LDS_WAIT(); asm volatile("" ::: "memory");
}
__device__ __forceinline__ void cvt_plain(const float* W, int ldw, int coff, int K, int N, bf16* WT, LAS float* scr, int it, int lane) {
    const int nblk = N / 32, kb = it / nblk, nb = it % nblk; transpose_item(W, ldw, 64 * kb, coff + 32 * nb, WT, K, 32 * nb, scr, lane);
}
__device__ __forceinline__ void cvt_gu(const float* Wg, const float* Wu, int K, int N, bf16* WT, LAS float* scr, int it, int lane) {
    const int nblk = N / 32, per = (K / 64) * nblk; const int isu = it >= per; if (isu) it -= per; const int kb = it / nblk, nb = it % nblk, n0 = 32 * nb;
    transpose_item(isu ? Wu : Wg, N, 64 * kb, n0, WT, K, (n0 / 128) * 256 + (n0 % 128) + (isu ? 128 : 0), scr, lane);
}

__device__ __forceinline__ void transpose_item8(const float* W, int ldw, int k0, int n0, unsigned char* WT, int K, int drow0, LAS float* scr, int lane, float sc) {
    float tv[32];
#pragma unroll
    for (int i = 0; i < 32; ++i) { const int kk = 2 * i + (lane >> 5); tv[i] = W[(size_t)(k0 + kk) * ldw + n0 + (lane & 31)]; }
#pragma unroll
    for (int i = 0; i < 32; ++i) { const int kk = 2 * i + (lane >> 5); scr[kk * 33 + (lane & 31)] = tv[i] * sc; }
    LDS_WAIT(); asm volatile("" ::: "memory");
    const int c = lane & 7;
#pragma unroll
    for (int j = 0; j < 4; ++j) { const int n = (lane >> 3) + 8 * j; const LAS float* s = scr + (8 * c) * 33 + n;
        v2u o; o.x = pg8::f8x4(s[0 * 33], s[1 * 33], s[2 * 33], s[3 * 33]); o.y = pg8::f8x4(s[4 * 33], s[5 * 33], s[6 * 33], s[7 * 33]);
        *(GAS v2u*)(WT + (size_t)(drow0 + n) * K + k0 + 8 * c) = o; }
    LDS_WAIT(); asm volatile("" ::: "memory");
}

struct CvtItem { const float* W; int ldw, k0, n0; unsigned char* WT; int K, drow0; float sc; };
__device__ __forceinline__ void cvt8_load(const CvtItem& c, int lane, float (&tv)[32]) {
#pragma unroll
    for (int i = 0; i < 32; ++i) { const int kk = 2 * i + (lane >> 5); tv[i] = c.W[(size_t)(c.k0 + kk) * c.ldw + c.n0 + (lane & 31)]; }
}
__device__ __forceinline__ void cvt8_finish(const CvtItem& c, const float (&tv)[32], LAS float* scr, int lane) {
#pragma unroll
    for (int i = 0; i < 32; ++i) { const int kk = 2 * i + (lane >> 5); scr[kk * 33 + (lane & 31)] = tv[i] * c.sc; }
    LDS_WAIT(); asm volatile("" ::: "memory");
    const int cc = lane & 7;
#pragma unroll
    for (int j = 0; j < 4; ++j) { const int n = (lane >> 3) + 8 * j; const LAS float* s = scr + (8 * cc) * 33 + n;
        v2u o; o.x = pg8::f8x4(s[0 * 33], s[1 * 33], s[2 * 33], s[3 * 33]); o.y = pg8::f8x4(s[4 * 33], s[5 * 33], s[6 * 33], s[7 * 33]);
        *(GAS v2u*)(c.WT + (size_t)(c.drow0 + n) * c.K + c.k0 + 8 * cc) = o; }
    LDS_WAIT(); asm volatile("" ::: "memory");
}
__device__ __forceinline__ void cvt_plain8(const float* W, int ldw, int coff, int K, int N, unsigned char* WT, LAS float* scr, int it, int lane, float sc) {
    const int nblk = N / 32, kb = it / nblk, nb = it % nblk; transpose_item8(W, ldw, 64 * kb, coff + 32 * nb, WT, K, 32 * nb, scr, lane, sc);
}
__device__ __forceinline__ void cvt_gu8(const float* Wg, const float* Wu, int K, int N, unsigned char* WT, LAS float* scr, int it, int lane, float sc) {
    const int nblk = N / 32, per = (K / 64) * nblk; const int isu = it >= per; if (isu) it -= per; const int kb = it / nblk, nb = it % nblk, n0 = 32 * nb;
    transpose_item8(isu ? Wu : Wg, N, 64 * kb, n0, WT, K, (n0 / 128) * 256 + (n0 % 128) + (isu ? 128 : 0), scr, lane, sc);
}

__device__ __forceinline__ void store_row_f8(unsigned char* orow, const f32x4 (&y)[4], int lane) {
    GAS unsigned* o4 = (GAS unsigned*)orow + lane;
#pragma unroll
    for (int j = 0; j < 4; ++j) o4[64 * j] = pg8::f8x4(y[j][0], y[j][1], y[j][2], y[j][3]);
}
__device__ __forceinline__ void stage_xw(Frame& F, const float* W, int ldw, int coff) {
    LAS float* xw = (LAS float*)(F.lds + XW_OFF);
    for (int idx = F.tid; idx < 8192; idx += NWAVES * 64) { const int k = idx >> 3, g = idx & 7; xw[g * 1024 + k] = W[(size_t)k * ldw + coff + g]; }
    LDS_WAIT(); __syncthreads();
}
__device__ __forceinline__ float wave_sum8(const float (&a)[8], int lane) {
    float b4[4], b2[2];
    const bool h5 = (lane & 32) != 0, h4 = (lane & 16) != 0, h3 = (lane & 8) != 0;
#pragma unroll
    for (int i = 0; i < 4; ++i) { const float send = h5 ? a[i] : a[4 + i]; const float keep = h5 ? a[4 + i] : a[i]; b4[i] = keep + __shfl_xor(send, 32); }
#pragma unroll
    for (int i = 0; i < 2; ++i) { const float send = h4 ? b4[i] : b4[2 + i]; const float keep = h4 ? b4[2 + i] : b4[i]; b2[i] = keep + __shfl_xor(send, 16); }
    float r; { const float send = h3 ? b2[0] : b2[1]; const float keep = h3 ? b2[1] : b2[0]; r = keep + __shfl_xor(send, 8); }
    r += __shfl_xor(r, 4); r += __shfl_xor(r, 2); r += __shfl_xor(r, 1);
    return r;
}
__device__ __forceinline__ void row_dot8(Frame& F, const f32x4 (&v)[4], float (&acc)[8]) {
    const LAS f32x4* xw = (const LAS f32x4*)(F.lds + XW_OFF); float a[8];
#pragma unroll
    for (int g = 0; g < 8; ++g) { float s = 0.f;
#pragma unroll
        for (int j = 0; j < 4; ++j) { const f32x4 w = xw[g * 256 + j * 64 + F.lane]; s += v[j][0] * w[0] + v[j][1] * w[1] + v[j][2] * w[2] + v[j][3] * w[3]; }
        a[g] = s; }
    const float r = wave_sum8(a, F.lane);
#pragma unroll
    for (int g = 0; g < 8; ++g) acc[g] = __builtin_bit_cast(float, __builtin_amdgcn_readlane(__builtin_bit_cast(int, r), 8 * g));
}
__device__ __forceinline__ float log_sigmoid(float x) { return fminf(x, 0.f) - log1pf(expf(-fabsf(x))); }
__device__ __forceinline__ void store_row_bf16(bf16* orow, const f32x4 (&y)[4], int lane) {
    GAS unsigned long long* o8 = (GAS unsigned long long*)orow + lane;
#pragma unroll
    for (int j = 0; j < 4; ++j) o8[64 * j] = (unsigned long long)pk2(y[j][0], y[j][1]) | ((unsigned long long)pk2(y[j][2], y[j][3]) << 32);
}
__device__ __forceinline__ void write_gates(Frame& F, const f32x4 (&y)[4], const float* gbias, float* grow) {
    float a[8]; row_dot8(F, y, a);
    if (F.lane < 8) { float r = 0.f;
#pragma unroll
        for (int g = 0; g < 8; ++g) if (F.lane == g) r = a[g];
        r += gbias[F.lane]; if (F.lane >= 4) r = log_sigmoid(r); grow[F.lane] = r; }
}
struct In {
    const float* x; const int* pos; const float *w_in, *gate_bias, *conv_w, *conv_b, *norm_attn, *norm_ml, *w_out, *ln1_g, *ln1_b, *dg, *du, *dd, *router_w, *router_b, *mg, *mu, *md, *ln2_g, *ln2_b;
};
__device__ __forceinline__ void p_prologue(Frame& F, const In& I) {
    unsigned char* ws = F.ws;
    PSEG(0); stage_xw(F, I.w_in, NIN, NPROJ); PSEG(10);
    LAS float* scr = (LAS float*)(F.lds + F.wave * 8704);
    const int gw = F.vcu * NWAVES + F.wave, NGW = F.G * NWAVES;
    constexpr int I_IN = (D / 64) * (NPROJ / 32), I_OUT = (D / 64) * (D / 32), I_GU = 2 * (D / 64) * (DFF / 32), I_DD = (DFF / 64) * (D / 32);
    constexpr int NITEMS = 2 * I_IN + 2 * I_OUT + I_GU + I_DD;
    for (int it = gw; it < NITEMS; it += NGW) {
        int r = it;
        if (r < 2 * I_IN) { const int l = r / I_IN; r -= l * I_IN; cvt_plain(I.w_in + (size_t)l * D * NIN, NIN, 0, D, NPROJ, (bf16*)(ws + WS_WIN) + (size_t)l * NPROJ * D, scr, r, F.lane); continue; } r -= 2 * I_IN;
        if (r < 2 * I_OUT) { const int l = r / I_OUT; r -= l * I_OUT; cvt_plain(I.w_out + (size_t)l * D * D, D, 0, D, D, (bf16*)(ws + WS_WOUT) + (size_t)l * D * D, scr, r, F.lane); continue; } r -= 2 * I_OUT;
        if (r < I_GU) { cvt_gu8(I.dg, I.du, D, DFF, ws + WS_WGU, scr, r, F.lane, SW_UP); continue; } r -= I_GU;
        cvt_plain8(I.dd, D, 0, DFF, D, ws + WS_WD, scr, r, F.lane, SW_DN);
    }
    PSEG(11);
    for (int e = blockIdx.x * (NWAVES * 64) + F.tid; e < M * 8; e += F.G * NWAVES * 64) { const int row = e >> 3, i = e & 7;
        const float inv = powf(500000.0f, -(float)i / 8.0f); const float ang = (float)I.pos[row] * inv; float s, c; sincosf(ang, &s, &c);
        float* rp = (float*)(ws + WS_ROPE) + (size_t)row * 16; rp[i] = c; rp[8 + i] = s; }
    PSEG(12);
    for (int m = gw; m < M; m += NGW) { const GAS f32x4* xr = (const GAS f32x4*)(I.x + (size_t)m * D) + F.lane; f32x4 v[4];
#pragma unroll
        for (int j = 0; j < 4; ++j) v[j] = xr[64 * j];
        store_row_bf16((bf16*)(ws + WS_XB) + (size_t)m * D, v, F.lane);
        write_gates(F, v, I.gate_bias, (float*)(ws + WS_GATES) + (size_t)m * 8); }
    PSEG(13);
}
__device__ __forceinline__ f32x4 ld_bf16x4(const bf16* p) { const v2u w = *(const GAS v2u*)p; return (f32x4){bflo(w.x), bfhi(w.x), bflo(w.y), bfhi(w.y)}; }
template <bool RESF, bool ADD2, int EXTRA>
__device__ __forceinline__ void ln_phase(Frame& F, const float* resf, const bf16* resb, const bf16* y0, const bf16* y1, const float* g, const float* bt, float* outf, bf16* outb, unsigned char* out8,
                                         const float* xbias, float* gates_out, int* list, float* listw, float oscale) {
    const int gw = F.vcu * NWAVES + F.wave, NGW = F.G * NWAVES;
    LAS int* rcnt = (LAS int*)(F.lds + XW_OFF + 32768); LAS int* rbase = rcnt + 8; LAS int* rent = rcnt + 16; int rloc = 0; const bool ragg = (M + NGW - 1) / NGW <= 8;
    if (EXTRA == 2) { if (F.tid < 8) rcnt[F.tid] = 0; for (int i = F.tid; i < 128; i += NWAVES * 64) rent[i * 4] = -1; LDS_WAIT(); __syncthreads(); }
    f32x4 gv[4], bv[4];
#pragma unroll
    for (int j = 0; j < 4; ++j) { gv[j] = ((const GAS f32x4*)g)[64 * j + F.lane]; bv[j] = ((const GAS f32x4*)bt)[64 * j + F.lane]; }
    for (int m = gw; m < M; m += NGW) {
        f32x4 v[4]; float s = 0.f;
#pragma unroll
        for (int j = 0; j < 4; ++j) { const size_t o = (size_t)m * D + 256 * j + 4 * F.lane;
            const f32x4 r = RESF ? *(const GAS f32x4*)(resf + o) : ld_bf16x4(resb + o); f32x4 a = ld_bf16x4(y0 + o); if (ADD2) a = a + ld_bf16x4(y1 + o);
            v[j] = r * ALPHA + a; }
#pragma unroll
        for (int j = 0; j < 4; ++j) s += (v[j][0] + v[j][1]) + (v[j][2] + v[j][3]);
        const float mean = wave_sum(s) * (1.f / D); float s2 = 0.f;
#pragma unroll
        for (int j = 0; j < 4; ++j) { v[j] = v[j] - mean; s2 += (v[j][0] * v[j][0] + v[j][1] * v[j][1]) + (v[j][2] * v[j][2] + v[j][3] * v[j][3]); }
        const float rstd = 1.f / sqrtf(wave_sum(s2) * (1.f / D) + LN_EPS);
#pragma unroll
        for (int j = 0; j < 4; ++j) v[j] = (v[j] * rstd * gv[j] + bv[j]) * oscale;
        if (outf) { GAS f32x4* of = (GAS f32x4*)(outf + (size_t)m * D) + F.lane;
#pragma unroll
            for (int j = 0; j < 4; ++j) of[64 * j] = v[j]; }
        if (outb) store_row_bf16(outb + (size_t)m * D, v, F.lane);
        if (out8) store_row_f8(out8 + (size_t)m * D, v, F.lane);
        if (EXTRA == 1) write_gates(F, v, xbias, gates_out + (size_t)m * 8);
        if (EXTRA == 2) { float a[8]; row_dot8(F, v, a);
#pragma unroll
            for (int e = 0; e < 8; ++e) a[e] += xbias[e];
            int i0 = 0; float v0 = a[0];
#pragma unroll
            for (int e = 1; e < 8; ++e) if (a[e] > v0) { v0 = a[e]; i0 = e; }
            int i1 = -1; float v1 = -INFINITY;
#pragma unroll
            for (int e = 0; e < 8; ++e) if (e != i0 && a[e] > v1) { v1 = a[e]; i1 = e; }
            const float w1 = 1.f / (1.f + expf(v0 - v1)), w0 = 1.f - w1;
            if (F.lane < 2) { const int e = F.lane ? i1 : i0; const float w = F.lane ? w1 : w0; const int ri = F.wave * 16 + rloc * 2 + F.lane;
                if (ragg) { const int lp = __hip_atomic_fetch_add(rcnt + e, 1, __ATOMIC_RELAXED, __HIP_MEMORY_SCOPE_WORKGROUP);
                    rent[ri * 4] = m * 2 + F.lane; rent[ri * 4 + 1] = __builtin_bit_cast(int, w); rent[ri * 4 + 2] = e; rent[ri * 4 + 3] = lp; }
                else { const unsigned p = __hip_atomic_fetch_add((unsigned*)(F.ctl + CW_ECNT + 64 * e), 1u, RLX_AGENT); list[(size_t)e * M + p] = m * 2 + F.lane; listw[(size_t)e * M + p] = w; } }
            ++rloc; }
    }
    if (EXTRA == 2) {
        LDS_WAIT(); __syncthreads();
        if (F.tid < 8) { const int c = rcnt[F.tid]; rbase[F.tid] = c > 0 ? (int)__hip_atomic_fetch_add((unsigned*)(F.ctl + CW_ECNT + 64 * F.tid), (unsigned)c, RLX_AGENT) : 0; }
        LDS_WAIT(); __syncthreads();
        for (int ri = F.tid; ri < 128; ri += NWAVES * 64) { const int ts = rent[ri * 4]; if (ts >= 0) { const int e = rent[ri * 4 + 2], p = rbase[e] + rent[ri * 4 + 3]; list[(size_t)e * M + p] = ts; listw[(size_t)e * M + p] = __builtin_bit_cast(float, rent[ri * 4 + 1]); } }
        __syncthreads();
    }
}
__device__ __forceinline__ int moe_plan(Frame& F) {
    LAS int* texp = (LAS int*)(F.lds + TEXP_OFF);
    if (F.tid == 0) { int t = 0;
        for (int e = 0; e < NE; ++e) { const int c = (int)__hip_atomic_load((unsigned*)(F.ctl + CW_ECNT + 64 * e), RLX_AGENT); const int nt = (c + 255) >> 8; texp[MAXT + 1 + e] = t * 256;
            for (int k = 0; k < nt && t < MAXT; ++k) texp[t++] = e; }
        texp[MAXT] = t; }
    LDS_WAIT(); __syncthreads();
    return texp[MAXT];
}
__device__ __forceinline__ void moe_gather(Frame& F, int ntiles, const unsigned char* X1B, unsigned char* XS, const int* list, const float* listw, int* rowmap, float* roww) {
    const LAS int* texp = (const LAS int*)(F.lds + TEXP_OFF);
    const int gw = F.vcu * NWAVES + F.wave, NGW = F.G * NWAVES;
    for (int r0 = gw; r0 < ntiles * 256; r0 += 4 * NGW) {
        int ts[4]; float w[4]; v4u a[4];
#pragma unroll
        for (int q = 0; q < 4; ++q) { const int r = r0 + q * NGW; ts[q] = -1; w[q] = 0.f;
            if (r < ntiles * 256) { const int e = texp[r >> 8], i = r - texp[MAXT + 1 + e]; const int c = (int)__hip_atomic_load((unsigned*)(F.ctl + CW_ECNT + 64 * e), RLX_AGENT);
                if (i < c) { ts[q] = list[(size_t)e * M + i]; w[q] = listw[(size_t)e * M + i]; } } }
#pragma unroll
        for (int q = 0; q < 4; ++q) { a[q] = (v4u){0u, 0u, 0u, 0u}; if (ts[q] >= 0) a[q] = ((const GAS v4u*)(X1B + (size_t)(ts[q] >> 1) * D))[F.lane]; }
#pragma unroll
        for (int q = 0; q < 4; ++q) { const int r = r0 + q * NGW;
            if (r < ntiles * 256) { ((GAS v4u*)(XS + (size_t)r * D))[F.lane] = a[q]; if (F.lane == 0) { rowmap[r] = ts[q]; roww[r] = w[q]; } } } }
}
constexpr int CV_IG = (D / 64) * (DEX / 32), CV_IGU = 2 * CV_IG, CV_IDD = (DEX / 64) * (D / 32), NUPI = NE * CV_IGU, NDNI = NE * CV_IDD;
__device__ __forceinline__ CvtItem moe_cvt_item(Frame& F, const In& I, int it) {
    CvtItem c;
    if (it < NUPI) { const int e = it / CV_IGU; int r = it - e * CV_IGU; const int isu = r >= CV_IG; if (isu) r -= CV_IG; const int nblk = DEX / 32, kb = r / nblk, nb = r % nblk, n0 = 32 * nb;
        c.W = (isu ? I.mu : I.mg) + (size_t)e * D * DEX; c.ldw = DEX; c.k0 = 64 * kb; c.n0 = n0; c.WT = F.ws + WS_MGU + (size_t)e * 2 * DEX * D; c.K = D; c.drow0 = (n0 / 128) * 256 + (n0 % 128) + (isu ? 128 : 0); c.sc = SW_UP; }
    else { it -= NUPI; const int e = it / CV_IDD; const int r = it - e * CV_IDD; const int nblk = D / 32, kb = r / nblk, nb = r % nblk;
        c.W = I.md + (size_t)e * DEX * D; c.ldw = D; c.k0 = 64 * kb; c.n0 = 32 * nb; c.WT = F.ws + WS_MD + (size_t)e * D * DEX; c.K = DEX; c.drow0 = 32 * nb; c.sc = SW_DN; }
    return c;
}
__device__ __forceinline__ void moe_cvt_range(Frame& F, const In& I, int lo, int hi, int w, int nw) {
    LAS float* scr = (LAS float*)(F.lds + F.wave * 8704);
    int nxt = lo + w;
    CvtItem c0, c1, c2, c3; float t0[32], t1[32], t2[32], t3[32]; bool v0, v1, v2, v3;
#define CV_LD(s) { v##s = nxt < hi; if (v##s) { c##s = moe_cvt_item(F, I, nxt); cvt8_load(c##s, F.lane, t##s); nxt += nw; } }
    CV_LD(0) CV_LD(1) CV_LD(2) CV_LD(3)
    for (;;) {
        if (!v0) break; cvt8_finish(c0, t0, scr, F.lane); CV_LD(0)
        if (!v1) break; cvt8_finish(c1, t1, scr, F.lane); CV_LD(1)
        if (!v2) break; cvt8_finish(c2, t2, scr, F.lane); CV_LD(2)
        if (!v3) break; cvt8_finish(c3, t3, scr, F.lane); CV_LD(3)
    }
#undef CV_LD
}

__device__ __forceinline__ float dot64_bf16(const LAS float* qs, const bf16* kr) {
    const GAS v4u* kp = (const GAS v4u*)kr; float a = 0.f;
#pragma unroll
    for (int c = 0; c < 8; ++c) { const v4u w = kp[c]; const LAS f32x4* q4 = (const LAS f32x4*)(qs + 8 * c); const f32x4 qa = q4[0], qb = q4[1];
        a += qa[0] * bflo(w.x) + qa[1] * bfhi(w.x) + qa[2] * bflo(w.y) + qa[3] * bfhi(w.y) + qb[0] * bflo(w.z) + qb[1] * bfhi(w.z) + qb[2] * bflo(w.w) + qb[3] * bfhi(w.w); }
    return a;
}
__device__ __forceinline__ void attn_naive(Frame& F, const bf16* PROJ, const float* ksum, const float* norm_attn, bf16* CAT, int w_lo, int w_n) {
    LAS float* qs = (LAS float*)(F.lds + F.wave * 4608); LAS float* ps = qs + 64;
    const int lane = F.lane; const int gwa = F.vcu * NWAVES + F.wave - w_lo;
    if (gwa < 0) return;
    for (int task = gwa; task < M * AH; task += w_n) {
        const int bh = task >> 13, t = task & 8191, b = bh >> 3, h = bh & 7; const size_t row = (size_t)b * SEQ + t; const int blk = t >> 8;
        qs[lane] = bf2f(PROJ[row * NPROJ + C_AQ + h * 64 + lane]); LDS_WAIT();
        float g = -INFINITY;
        if (lane < blk) { const float* km = ksum + ((size_t)(b * NB + lane) * 512 + h * 64); float a = 0.f;
            for (int d = 0; d < 64; ++d) a += qs[d] * km[d];
            g = a; }
        int sel[3];
#pragma unroll
        for (int k = 0; k < 3; ++k) { float v = g; int idx = lane;
#pragma unroll
            for (int o = 1; o < 64; o <<= 1) { const float ov = __shfl_xor(v, o); const int oi = __shfl_xor(idx, o); if (ov > v || (ov == v && oi < idx)) { v = ov; idx = oi; } }
            idx = __builtin_amdgcn_readfirstlane(idx); const bool ok = __builtin_amdgcn_readfirstlane(v > -INFINITY ? 1 : 0) != 0;
            sel[k] = ok ? idx : -1; if (lane == idx) g = -INFINITY; }
        float sc[4][4]; float mx = -INFINITY;
#pragma unroll
        for (int s = 0; s < 4; ++s) { const int jb = (s < 3) ? sel[s] : blk;
#pragma unroll
            for (int i = 0; i < 4; ++i) { float a = -INFINITY;
                if (jb >= 0) { const int kp = jb * 256 + i * 64 + lane; if (s < 3 || kp <= t) a = dot64_bf16(qs, PROJ + ((size_t)b * SEQ + kp) * NPROJ + C_AK + h * 64); }
                sc[s][i] = a; mx = fmaxf(mx, a); } }
        mx = wave_max(mx); float sum = 0.f;
#pragma unroll
        for (int s = 0; s < 4; ++s)
#pragma unroll
            for (int i = 0; i < 4; ++i) { const float p = __builtin_amdgcn_exp2f(sc[s][i] - mx); sum += p; ps[s * 256 + i * 64 + lane] = p; }
        sum = wave_sum(sum); LDS_WAIT();
        float o = 0.f;
#pragma unroll
        for (int s = 0; s < 4; ++s) { const int jb = (s < 3) ? sel[s] : blk; if (jb < 0) continue; const int kmax = (s < 3) ? 256 : (t - blk * 256 + 1);
            const bf16* vb = PROJ + ((size_t)b * SEQ + jb * 256) * NPROJ + C_AV + h * 64 + lane;
#pragma unroll 8
            for (int k = 0; k < kmax; ++k) o += ps[s * 256 + k] * bf2f(vb[(size_t)k * NPROJ]); }
        o = o / sum; const float ms = wave_sum(o * o) * (1.f / 64.f);
        o = o * (1.f / sqrtf(ms + RMS_EPS)) * norm_attn[h * 64 + lane];
        CAT[row * D + h * 64 + lane] = (bf16)f2bf(o);
        LDS_WAIT();
    }
}
__device__ __forceinline__ void mlstm_naive(Frame& F, int bh, const bf16* PROJ, const float* GATES, const float* conv_w, const float* conv_b, const float* norm_ml, bf16* CAT) {
    const int b = bh >> 2, h = bh & 3, tid = F.tid;
    LAS float* Cst = (LAS float*)(F.lds);
    LAS float* nst = (LAS float*)(F.lds + 33280);
    LAS float* qf = (LAS float*)(F.lds + 33792);
    LAS float* kf = (LAS float*)(F.lds + 67072);
    LAS bf16* vb = (LAS bf16*)(F.lds + 100352);
    LAS float* bs = (LAS float*)(F.lds + 133120);
    LAS float* ig = bs + 128;
    LAS float* mt = bs + 256;
    LAS float* wst = bs + 384;
    LAS float* scal = bs + 512;
    for (int e = tid; e < 128 * 65; e += 512) Cst[e] = 0.f;
    if (tid < 64) nst[tid] = 0.f;
    if (tid == 0) scal[0] = 0.f;
    __syncthreads();
    for (int c = 0; c < NCH; ++c) {
        const size_t row0 = (size_t)b * SEQ + (size_t)c * MLC;
        if (tid < 128) { ig[tid] = GATES[(row0 + tid) * 8 + h]; bs[tid] = GATES[(row0 + tid) * 8 + 4 + h]; }
        for (int e = tid; e < 128 * 128; e += 512) { const int t = e >> 7, cc = e & 127; const int isk = cc >> 6, d = cc & 63; const int ch = isk * 256 + h * 64 + d;
            float a = conv_b[ch];
#pragma unroll
            for (int j = 0; j < 4; ++j) { const int tt = c * MLC + t - 3 + j; if (tt >= 0) a += conv_w[j * 512 + ch] * bf2f(PROJ[((size_t)b * SEQ + tt) * NPROJ + C_MQ + ch]); }
            a = a / (1.f + expf(-a));
            if (isk) kf[t * 65 + d] = a; else qf[t * 65 + d] = a * 0.125f; }
        for (int e = tid; e < 128 * 128; e += 512) { const int t = e >> 7, vv = e & 127; vb[t * 128 + vv] = PROJ[(row0 + t) * NPROJ + C_MV + h * 128 + vv]; }
        __syncthreads();
        if (tid == 0) { const float mc = scal[0]; float run = 0.f, cm = -INFINITY;
            for (int t = 0; t < 128; ++t) { run += bs[t]; bs[t] = run; cm = fmaxf(cm, ig[t] - run); mt[t] = run + fmaxf(mc, cm); }
            const float bl = run; const float mnew = fmaxf(bl + mc, bl + cm); scal[1] = mnew; scal[2] = bl; }
        __syncthreads();
        if (tid < 128) wst[tid] = expf(scal[2] - bs[tid] + ig[tid] - scal[1]);
#pragma unroll 1
        for (int pass = 0; pass < 2; ++pass) {
            const int t = pass * 64 + (tid >> 3), vq = tid & 7; const float mc = scal[0]; const float bt = bs[t], mtt = mt[t];
            float q[64];
#pragma unroll
            for (int d = 0; d < 64; ++d) q[d] = qf[t * 65 + d];
            float num[16]; float den = 0.f;
#pragma unroll
            for (int j = 0; j < 16; ++j) num[j] = 0.f;
            const int tmax = pass * 64 + ((tid >> 6) << 3) + 7;
#pragma unroll 1
            for (int s = 0; s <= tmax; ++s) { if (s <= t) { float dot = 0.f;
#pragma unroll
                    for (int d = 0; d < 64; ++d) dot += q[d] * kf[s * 65 + d];
                    const float sw = dot * expf(bt - bs[s] + ig[s] - mtt); den += sw;
#pragma unroll
                    for (int j = 0; j < 16; ++j) num[j] += sw * bf2f(vb[s * 128 + vq * 16 + j]); } }
            const float wi = expf(bt + mc - mtt); float nq = 0.f;
#pragma unroll
            for (int d = 0; d < 64; ++d) nq += nst[d] * q[d];
            den += wi * nq;
            { float cq[16];
#pragma unroll
              for (int j = 0; j < 16; ++j) cq[j] = 0.f;
#pragma unroll 1
              for (int d = 0; d < 64; ++d) { const float qd = qf[t * 65 + d]; const LAS float* cr = Cst + (vq * 16) * 65 + d;
#pragma unroll
                  for (int j = 0; j < 16; ++j) cq[j] += cr[j * 65] * qd; }
#pragma unroll
              for (int j = 0; j < 16; ++j) num[j] += wi * cq[j]; }
            const float dn = 1.f / fmaxf(fabsf(den), expf(-mtt)); float ss = 0.f;
#pragma unroll
            for (int j = 0; j < 16; ++j) { num[j] *= dn; ss += num[j] * num[j]; }
            ss += __shfl_xor(ss, 1); ss += __shfl_xor(ss, 2); ss += __shfl_xor(ss, 4);
            const float rs = 1.f / sqrtf(ss * (1.f / 128.f) + RMS_EPS);
            const size_t row = row0 + t; const bf16* mo = PROJ + row * NPROJ + C_MO + h * 128 + vq * 16; bf16* out = CAT + row * D + 512 + h * 128 + vq * 16; const float* gn = norm_ml + h * 128 + vq * 16;
#pragma unroll
            for (int j = 0; j < 16; ++j) { const float o = bf2f(mo[j]); out[j] = (bf16)f2bf(num[j] * rs * gn[j] / (1.f + expf(-o))); }
        }
        __syncthreads();
        {
            const float cs = expf(scal[2] + scal[0] - scal[1]);
            for (int e = tid; e < 128 * 64; e += 512) { const int vv = e >> 6, d = e & 63; float a = 0.f;
                for (int s = 0; s < 128; ++s) a += wst[s] * bf2f(vb[s * 128 + vv]) * kf[s * 65 + d];
                Cst[vv * 65 + d] = cs * Cst[vv * 65 + d] + a; }
            if (tid < 64) { float a = 0.f; for (int s = 0; s < 128; ++s) a += wst[s] * kf[s * 65 + tid]; nst[tid] = cs * nst[tid] + a; }
        }
        __syncthreads();
        if (tid == 0) scal[0] = scal[1];
        __syncthreads();
    }
}

typedef short bf16x8_t __attribute__((ext_vector_type(8)));
#define MFMA16(a, b, c) __builtin_amdgcn_mfma_f32_16x16x32_bf16((a), (b), (c), 0, 0, 0)
__device__ __forceinline__ float wave_incl_sum(float v, int lane) {
#pragma unroll
    for (int o = 1; o < 64; o <<= 1) { const float y = __shfl_up(v, o); if (lane >= o) v += y; }
    return v;
}
__device__ __forceinline__ float wave_incl_max(float v, int lane) {
#pragma unroll
    for (int o = 1; o < 64; o <<= 1) { const float y = __shfl_up(v, o); if (lane >= o) v = fmaxf(v, y); }
    return v;
}
__device__ __forceinline__ float fexp(float x) { return __builtin_amdgcn_exp2f(x * 1.4426950408889634f); }
__device__ __forceinline__ float fsigm(float x) { return __builtin_amdgcn_rcpf(1.f + __builtin_amdgcn_exp2f(-1.4426950408889634f * x)); }
struct MlBufs { bf16* QC; bf16* KC; float* DC; bf16* CST; float* DN; float* NST; float* SC; float* MC; };
constexpr int ML_KW = 0, ML_VT = 18432, ML_ARR = 55296;
constexpr int MC_QS = 0, MC_KS = 18432, MC_VT = 36864, MC_CM = 76032, MC_SS = 96768, MC_ARR = 131584;

typedef short v4i16m_t __attribute__((ext_vector_type(4)));
__device__ __forceinline__ bf16x8_t tr8(const LAS bf16* p0, const LAS bf16* p1) {
    const v4i16m_t lo = __builtin_amdgcn_ds_read_tr16_b64_v4i16((LAS v4i16m_t*)p0), hi = __builtin_amdgcn_ds_read_tr16_b64_v4i16((LAS v4i16m_t*)p1);
    return (bf16x8_t){lo[0], lo[1], lo[2], lo[3], hi[0], hi[1], hi[2], hi[3]};
}
template <bool ONES>
__device__ __forceinline__ void ml_stage_v(Frame& F, const bf16* PROJ, size_t row0, int h, LAS bf16* VR) {
#pragma unroll
    for (int e = F.tid; e < 128 * 16; e += NWAVES * 64) { const int t = e >> 4, v0 = (e & 15) * 8;
        *(LAS v4u*)(VR + t * 144 + v0) = *(const GAS v4u*)(PROJ + (row0 + t) * NPROJ + C_MV + h * 128 + v0); }
    if (ONES) { for (int e = F.tid; e < 128 * 2; e += NWAVES * 64) { const int t = e >> 1, hf = e & 1; *(LAS v4u*)(VR + t * 144 + 128 + 8 * hf) = (v4u){hf ? 0u : 0x3f80u, 0u, 0u, 0u}; } }
}
__device__ __forceinline__ void ml_phase_a(Frame& F, int unit, const bf16* PROJ, const float* GATES, const float* conv_w, const float* conv_b, const MlBufs& B) {
    const int bh = unit >> 6, c = unit & 63, b = bh >> 2, h = bh & 3, tid = F.tid, lane = F.lane;
    const size_t row0 = (size_t)b * SEQ + (size_t)c * MLC;
    LAS bf16* KW = (LAS bf16*)(F.lds + ML_KW); LAS bf16* VT = (LAS bf16*)(F.lds + ML_VT);
    LAS float* wst = (LAS float*)(F.lds + ML_ARR);
    PSEG(0);
    if (F.wave == 0) {
        const float i0 = GATES[(row0 + 2 * lane) * 8 + h], i1 = GATES[(row0 + 2 * lane + 1) * 8 + h], f0 = GATES[(row0 + 2 * lane) * 8 + 4 + h], f1 = GATES[(row0 + 2 * lane + 1) * 8 + 4 + h];
        const float tot = wave_incl_sum(f0 + f1, lane); const float b0 = tot - f1, b1 = tot;
        const float a0 = i0 - b0, a1 = i1 - b1; const float amax = wave_max(fmaxf(a0, a1)); const float bl = __shfl(b1, 63);
        wst[2 * lane] = expf(a0 - amax); wst[2 * lane + 1] = expf(a1 - amax);
        if (lane == 0) { B.SC[unit * 2] = bl + amax; B.SC[unit * 2 + 1] = bl; }
    }
    LDS_WAIT(); __syncthreads(); PSEG(1);
    {   const int g8 = tid & 15, isk = g8 >> 3, d0 = (g8 & 7) * 8; const int ch = isk * 256 + h * 64 + d0;
        f32x4 cw[4][2], cb[2];
#pragma unroll
        for (int j = 0; j < 4; ++j) { cw[j][0] = *(const GAS f32x4*)(conv_w + j * 512 + ch); cw[j][1] = *(const GAS f32x4*)(conv_w + j * 512 + ch + 4); }
        cb[0] = *(const GAS f32x4*)(conv_b + ch); cb[1] = *(const GAS f32x4*)(conv_b + ch + 4);
        v4u xin[4][4];
#pragma unroll
        for (int i = 0; i < 4; ++i)
#pragma unroll
            for (int j = 0; j < 4; ++j) { const int t = (tid >> 4) + 32 * i; const int tt = c * MLC + t - 3 + j;
                xin[i][j] = (tt >= 0) ? *(const GAS v4u*)(PROJ + ((size_t)b * SEQ + tt) * NPROJ + C_MQ + ch) : (v4u){0u, 0u, 0u, 0u}; }
#pragma unroll
        for (int i = 0; i < 4; ++i) { const int t = (tid >> 4) + 32 * i;
            float a[8];
#pragma unroll
            for (int e = 0; e < 4; ++e) { a[e] = cb[0][e]; a[4 + e] = cb[1][e]; }
#pragma unroll
            for (int j = 0; j < 4; ++j) { const v4u w = xin[i][j]; const f32x4 w0 = cw[j][0], w1 = cw[j][1];
                a[0] += w0[0] * bflo(w.x); a[1] += w0[1] * bfhi(w.x); a[2] += w0[2] * bflo(w.y); a[3] += w0[3] * bfhi(w.y); a[4] += w1[0] * bflo(w.z); a[5] += w1[1] * bfhi(w.z); a[6] += w1[2] * bflo(w.w); a[7] += w1[3] * bfhi(w.w); }
#pragma unroll
            for (int e = 0; e < 8; ++e) a[e] = a[e] * fsigm(a[e]);
            if (isk) { v4u o; o.x = pk2(a[0], a[1]); o.y = pk2(a[2], a[3]); o.z = pk2(a[4], a[5]); o.w = pk2(a[6], a[7]); *(GAS v4u*)(B.KC + (row0 + t) * 256 + h * 64 + d0) = o;
                const float ws = wst[t];
                v4u kw; kw.x = pk2(a[0] * ws, a[1] * ws); kw.y = pk2(a[2] * ws, a[3] * ws); kw.z = pk2(a[4] * ws, a[5] * ws); kw.w = pk2(a[6] * ws, a[7] * ws);
                *(LAS v4u*)(KW + t * 72 + d0) = kw;
            } else { v4u o; o.x = pk2(a[0] * 0.125f, a[1] * 0.125f); o.y = pk2(a[2] * 0.125f, a[3] * 0.125f); o.z = pk2(a[4] * 0.125f, a[5] * 0.125f); o.w = pk2(a[6] * 0.125f, a[7] * 0.125f);
                *(GAS v4u*)(B.QC + (row0 + t) * 256 + h * 64 + d0) = o; } }
    }
    ml_stage_v<false>(F, PROJ, row0, h, VT);
    LDS_WAIT(); __syncthreads(); PSEG(2);
    {
        const int w = F.wave, r = lane & 15, q4 = lane >> 4; f32x4 acc[4];
#pragma unroll
        for (int nt = 0; nt < 4; ++nt) acc[nt] = (f32x4){0.f, 0.f, 0.f, 0.f};
#pragma unroll
        for (int ks = 0; ks < 4; ++ks) { const int trow = 32 * ks + 8 * q4 + (r >> 2), pc = 4 * (r & 3);
            const bf16x8_t a = tr8(VT + trow * 144 + 16 * w + pc, VT + (trow + 4) * 144 + 16 * w + pc);
#pragma unroll
            for (int nt = 0; nt < 4; ++nt) { const bf16x8_t bb = tr8(KW + trow * 72 + 16 * nt + pc, KW + (trow + 4) * 72 + 16 * nt + pc); acc[nt] = MFMA16(a, bb, acc[nt]); } }
        float* dc = B.DC + (size_t)unit * 8192;
#pragma unroll
        for (int nt = 0; nt < 4; ++nt)
#pragma unroll
            for (int j = 0; j < 4; ++j) dc[(16 * w + 4 * q4 + j) * 64 + 16 * nt + r] = acc[nt][j];
        if (tid < 64) { float s = 0.f; for (int t = 0; t < 128; ++t) s += bf2f(KW[t * 72 + tid]); B.DN[unit * 64 + tid] = s; }
    }
    LDS_WAIT(); __syncthreads(); PSEG(3);
}
__device__ __forceinline__ void ml_phase_b(Frame& F, int u, const MlBufs& B) {
    const int bh = u >> 5, eb = (u & 31) * 256, tid = F.tid;
    LAS float* sC = (LAS float*)(F.lds); LAS float* sD = sC + 64;
    LAS float* scl = sD + 64;
    if (tid < 128) scl[tid] = B.SC[bh * 128 + tid];
    LDS_WAIT(); __syncthreads();
    if (F.wave == 0) {
        const int c = F.lane; const float ac = scl[c * 2], bl = scl[c * 2 + 1]; float A = bl, Bm = ac;
#pragma unroll
        for (int o = 1; o < 64; o <<= 1) { const float Ap = __shfl_up(A, o), Bp = __shfl_up(Bm, o); if (c >= o) { Bm = fmaxf(Bm, A + Bp); A = A + Ap; } }
        const float mn = fmaxf(Bm, A); const float mp = __shfl_up(mn, 1); const float me = (c == 0) ? 0.f : mp;
        sC[c] = fexp(bl + me - mn); sD[c] = fexp(ac - mn); if ((u & 31) == 0) B.MC[bh * 64 + c] = me; }
    LDS_WAIT(); __syncthreads();
    if (tid < 256) { float C = 0.f; const float* dc = B.DC + (size_t)bh * 64 * 8192 + eb + tid; bf16* cs = B.CST + (size_t)bh * 64 * 8192 + eb + tid;
        float dv[64];
#pragma unroll
        for (int c = 0; c < 64; ++c) dv[c] = dc[(size_t)c * 8192];
#pragma unroll
        for (int c = 0; c < 64; ++c) { cs[(size_t)c * 8192] = (bf16)f2bf(C); C = sC[c] * C + sD[c] * dv[c]; } }
    else if (tid < 320 && (u & 31) == 0) { const int d = tid - 256; float n = 0.f;
        for (int c = 0; c < 64; ++c) { B.NST[(bh * 64 + c) * 64 + d] = n; n = sC[c] * n + sD[c] * B.DN[(bh * 64 + c) * 64 + d]; } }
    __syncthreads();
}
__device__ __forceinline__ void ml_phase_c(Frame& F, int unit, const bf16* PROJ, const float* GATES, const float* norm_ml, bf16* CAT, const MlBufs& B) {
    const int bh = unit >> 6, c = unit & 63, b = bh >> 2, h = bh & 3, tid = F.tid, lane = F.lane;
    const size_t row0 = (size_t)b * SEQ + (size_t)c * MLC;
    LAS bf16* QS = (LAS bf16*)(F.lds + MC_QS); LAS bf16* KS = (LAS bf16*)(F.lds + MC_KS); LAS bf16* VT = (LAS bf16*)(F.lds + MC_VT); LAS bf16* CM = (LAS bf16*)(F.lds + MC_CM); LAS bf16* SS = (LAS bf16*)(F.lds + MC_SS);
    LAS float* aa = (LAS float*)(F.lds + MC_ARR); LAS float* rt = aa + 128; LAS float* wint = aa + 256; LAS float* emt = aa + 384;
    if (F.wave == 0) {
        const float mc = B.MC[unit];
        const float i0 = GATES[(row0 + 2 * lane) * 8 + h], i1 = GATES[(row0 + 2 * lane + 1) * 8 + h], f0 = GATES[(row0 + 2 * lane) * 8 + 4 + h], f1 = GATES[(row0 + 2 * lane + 1) * 8 + 4 + h];
        const float tot = wave_incl_sum(f0 + f1, lane); const float b0 = tot - f1, b1 = tot;
        const float a0 = i0 - b0, a1 = i1 - b1; const float cmx = wave_incl_max(fmaxf(a0, a1), lane); const float cmprev = __shfl_up(cmx, 1);
        const float cm0 = (lane == 0) ? a0 : fmaxf(cmprev, a0), cm1 = cmx;
        const float mt0 = b0 + fmaxf(mc, cm0), mt1 = b1 + fmaxf(mc, cm1);
        aa[2 * lane] = a0; aa[2 * lane + 1] = a1; rt[2 * lane] = b0 - mt0; rt[2 * lane + 1] = b1 - mt1;
        wint[2 * lane] = expf(b0 + mc - mt0); wint[2 * lane + 1] = expf(b1 + mc - mt1); emt[2 * lane] = expf(-mt0); emt[2 * lane + 1] = expf(-mt1);
    }
#pragma unroll
    for (int e = tid; e < 128 * 8; e += NWAVES * 64) { const int t = e >> 3, ch = (e & 7) * 8;
        *(LAS v4u*)(QS + t * 72 + ch) = *(const GAS v4u*)(B.QC + (row0 + t) * 256 + h * 64 + ch);
        *(LAS v4u*)(KS + t * 72 + ch) = *(const GAS v4u*)(B.KC + (row0 + t) * 256 + h * 64 + ch);
        *(LAS v4u*)(CM + t * 72 + ch) = *(const GAS v4u*)(B.CST + (size_t)unit * 8192 + t * 64 + ch); }
    ml_stage_v<true>(F, PROJ, row0, h, VT);
    for (int e = tid; e < 16 * 64; e += NWAVES * 64) { const int rr = e >> 6, cc = e & 63; CM[(128 + rr) * 72 + cc] = (rr == 0) ? (bf16)f2bf(B.NST[unit * 64 + cc]) : (bf16)0; }
    LDS_WAIT(); __syncthreads();
    const int w = F.wave, r = lane & 15, q4 = lane >> 4;
    {
        bf16x8_t a[2];
#pragma unroll
        for (int ks = 0; ks < 2; ++ks) a[ks] = *(const LAS bf16x8_t*)(QS + (16 * w + r) * 72 + 32 * ks + 8 * q4);
        float rtj[4];
#pragma unroll
        for (int j = 0; j < 4; ++j) rtj[j] = rt[16 * w + 4 * q4 + j];
        for (int nt = 0; nt <= (w | 1); ++nt) { f32x4 acc = {0.f, 0.f, 0.f, 0.f};
#pragma unroll
            for (int ks = 0; ks < 2; ++ks) { const bf16x8_t bb = *(const LAS bf16x8_t*)(KS + (16 * nt + r) * 72 + 32 * ks + 8 * q4); acc = MFMA16(a[ks], bb, acc); }
            const int s = 16 * nt + r; const float as = aa[s];
#pragma unroll
            for (int j = 0; j < 4; ++j) { const int t = 16 * w + 4 * q4 + j; const float v = (s <= t) ? acc[j] * fexp(rtj[j] + as) : 0.f; SS[t * 136 + s] = (bf16)f2bf(v); } }
    }
    LDS_WAIT();
    f32x4 accS[9], accQ[9];
#pragma unroll
    for (int nt = 0; nt < 9; ++nt) { accS[nt] = (f32x4){0.f, 0.f, 0.f, 0.f}; accQ[nt] = (f32x4){0.f, 0.f, 0.f, 0.f}; }
    for (int ks = 0; ks <= (16 * w + 15) / 32; ++ks) { const bf16x8_t a = *(const LAS bf16x8_t*)(SS + (16 * w + r) * 136 + 32 * ks + 8 * q4);
        const int trow = 32 * ks + 8 * q4 + (r >> 2), pc = 4 * (r & 3);
#pragma unroll
        for (int nt = 0; nt < 9; ++nt) { const bf16x8_t bb = tr8(VT + trow * 144 + 16 * nt + pc, VT + (trow + 4) * 144 + 16 * nt + pc); accS[nt] = MFMA16(a, bb, accS[nt]); } }
#pragma unroll
    for (int ks = 0; ks < 2; ++ks) { const bf16x8_t a = *(const LAS bf16x8_t*)(QS + (16 * w + r) * 72 + 32 * ks + 8 * q4);
#pragma unroll
        for (int nt = 0; nt < 9; ++nt) { const bf16x8_t bb = *(const LAS bf16x8_t*)(CM + (16 * nt + r) * 72 + 32 * ks + 8 * q4); accQ[nt] = MFMA16(a, bb, accQ[nt]); } }
    LDS_WAIT();
    {
        float gn[8];
#pragma unroll
        for (int nt = 0; nt < 8; ++nt) gn[nt] = norm_ml[h * 128 + 16 * nt + r];
#pragma unroll
        for (int j = 0; j < 4; ++j) { const int t = 16 * w + 4 * q4 + j; const float wi = wint[t];
            const float dS = __shfl(accS[8][j], lane & 48), dQ = __shfl(accQ[8][j], lane & 48);
            const float den = dS + wi * dQ; const float dn = 1.f / fmaxf(fabsf(den), emt[t]);
            float hv[8]; float ss = 0.f;
#pragma unroll
            for (int nt = 0; nt < 8; ++nt) { hv[nt] = (accS[nt][j] + wi * accQ[nt][j]) * dn; ss += hv[nt] * hv[nt]; }
            ss += __shfl_xor(ss, 1); ss += __shfl_xor(ss, 2); ss += __shfl_xor(ss, 4); ss += __shfl_xor(ss, 8);
            const float rs = 1.f / sqrtf(ss * (1.f / 128.f) + RMS_EPS);
#pragma unroll
            for (int nt = 0; nt < 8; ++nt) SS[t * 136 + 16 * nt + r] = (bf16)f2bf(hv[nt] * rs * gn[nt]); }
    }
    LDS_WAIT();
    for (int e = lane; e < 16 * 16; e += 64) { const int t = 16 * w + (e >> 4), v0 = (e & 15) * 8;
        const v4u hh = *(const LAS v4u*)(SS + t * 136 + v0); const v4u mo = *(const GAS v4u*)(PROJ + (row0 + t) * NPROJ + C_MO + h * 128 + v0);
        v4u o;
#define SGM(x) fsigm(x)
        o.x = pk2(bflo(hh.x) * SGM(bflo(mo.x)), bfhi(hh.x) * SGM(bfhi(mo.x))); o.y = pk2(bflo(hh.y) * SGM(bflo(mo.y)), bfhi(hh.y) * SGM(bfhi(mo.y)));
        o.z = pk2(bflo(hh.z) * SGM(bflo(mo.z)), bfhi(hh.z) * SGM(bfhi(mo.z))); o.w = pk2(bflo(hh.w) * SGM(bflo(mo.w)), bfhi(hh.w) * SGM(bfhi(mo.w)));
#undef SGM
        *(GAS v4u*)(CAT + (row0 + t) * D + 512 + h * 128 + v0) = o; }
    LDS_WAIT(); __syncthreads();
}

typedef float f32x16_t __attribute__((ext_vector_type(16)));
typedef short s16x4_t __attribute__((ext_vector_type(4)));
typedef short v4i16_t __attribute__((ext_vector_type(4)));
typedef float f32x2_t __attribute__((ext_vector_type(2)));
typedef __bf16 bf16x2_t __attribute__((ext_vector_type(2)));
#define MFMA32(a, b, c) __builtin_amdgcn_mfma_f32_32x32x16_bf16((a), (b), (c), 0, 0, 0)
__device__ __forceinline__ unsigned cvtpk(float lo, float hi) { f32x2_t v = {lo, hi}; bf16x2_t b = __builtin_convertvector(v, bf16x2_t); return __builtin_bit_cast(unsigned, b); }
struct AtBufs { bf16* PO; float* PML; unsigned* SEL; unsigned* LISTQ; unsigned* BCNT; };
constexpr int AT_KS = 0, AT_VS = 36864, AT_END = 86016;
constexpr int AT_PFX = 90112;
constexpr int BKT_PER_BH = 126976;
__device__ __forceinline__ int bucket_off(int bh, int j) { return bh * BKT_PER_BH + 256 * (31 * j - (j * (j - 1)) / 2); }

__device__ __forceinline__ void attn_route(Frame& F, int unit, const bf16* PROJ, const float* ksum, const AtBufs& A) {
    const int bh = unit >> 5, blk = unit & 31, b = bh >> 3, h = bh & 7, tid = F.tid;
    LAS float* km = (LAS float*)(F.lds); LAS int* cnt = (LAS int*)(F.lds + 8192); LAS int* base = cnt + 32;
    PSEG(0);
    LAS float* cv = (LAS float*)(F.lds + 8704); LAS int* ci = (LAS int*)(F.lds + 8704 + 3072);
    for (int e = tid; e < blk * 64; e += NWAVES * 64) km[e] = ksum[(size_t)(b * NB + (e >> 6)) * 512 + h * 64 + (e & 63)];
    if (tid < 32) cnt[tid] = 0;
    LDS_WAIT(); __syncthreads(); PSEG(4);
    const int ql = tid & 255, half = tid >> 8; const int t = blk * 256 + ql; const size_t row = (size_t)b * SEQ + t;
    int i0 = -1, i1 = -1, i2 = -1, l0 = 0, l1 = 0, l2 = 0; float v0 = -INFINITY, v1 = -INFINITY, v2 = -INFINITY;
    {
        float q[64]; const GAS v4u* qp = (const GAS v4u*)(PROJ + row * NPROJ + C_AQ + h * 64);
#pragma unroll
        for (int c = 0; c < 8; ++c) { const v4u w = qp[c]; q[8 * c] = bflo(w.x); q[8 * c + 1] = bfhi(w.x); q[8 * c + 2] = bflo(w.y); q[8 * c + 3] = bfhi(w.y); q[8 * c + 4] = bflo(w.z); q[8 * c + 5] = bfhi(w.z); q[8 * c + 6] = bflo(w.w); q[8 * c + 7] = bfhi(w.w); }
        for (int n = half; n < blk; n += 2) { const LAS f32x4* kr = (const LAS f32x4*)(km + n * 64); float g = 0.f;
#pragma unroll
            for (int c = 0; c < 16; ++c) { const f32x4 kk = kr[c]; g += q[4 * c] * kk[0] + q[4 * c + 1] * kk[1] + q[4 * c + 2] * kk[2] + q[4 * c + 3] * kk[3]; }
            if (g > v0) { v2 = v1; i2 = i1; v1 = v0; i1 = i0; v0 = g; i0 = n; } else if (g > v1) { v2 = v1; i2 = i1; v1 = g; i1 = n; } else if (g > v2) { v2 = g; i2 = n; } }
    }
    PSEG(5);
    if (half) { cv[ql * 3] = v0; cv[ql * 3 + 1] = v1; cv[ql * 3 + 2] = v2; ci[ql * 3] = i0; ci[ql * 3 + 1] = i1; ci[ql * 3 + 2] = i2; }
    LDS_WAIT(); __syncthreads();
    if (!half) {
#pragma unroll
        for (int k = 0; k < 3; ++k) { const float g = cv[ql * 3 + k]; const int n = ci[ql * 3 + k];
            if (n >= 0) { if (g > v0 || (g == v0 && n < i0)) { v2 = v1; i2 = i1; v1 = v0; i1 = i0; v0 = g; i0 = n; } else if (g > v1 || (g == v1 && n < i1)) { v2 = v1; i2 = i1; v1 = g; i1 = n; } else if (g > v2 || (g == v2 && n < i2)) { v2 = g; i2 = n; } } }
        A.SEL[row * 8 + h] = (unsigned)(i0 & 0xff) | ((unsigned)(i1 & 0xff) << 8) | ((unsigned)(i2 & 0xff) << 16);
        if (i0 >= 0) l0 = __hip_atomic_fetch_add(cnt + i0, 1, __ATOMIC_RELAXED, __HIP_MEMORY_SCOPE_WORKGROUP);
        if (i1 >= 0) l1 = __hip_atomic_fetch_add(cnt + i1, 1, __ATOMIC_RELAXED, __HIP_MEMORY_SCOPE_WORKGROUP);
        if (i2 >= 0) l2 = __hip_atomic_fetch_add(cnt + i2, 1, __ATOMIC_RELAXED, __HIP_MEMORY_SCOPE_WORKGROUP);
    }
    LDS_WAIT(); __syncthreads();
    if (tid < blk) { const int c = cnt[tid]; base[tid] = c > 0 ? (int)__hip_atomic_fetch_add(A.BCNT + bh * 32 + tid, (unsigned)c, RLX_AGENT) : 0; }
    LDS_WAIT(); __syncthreads();
    if (!half) {
        if (i0 >= 0) A.LISTQ[bucket_off(bh, i0) + base[i0] + l0] = (unsigned)t;
        if (i1 >= 0) A.LISTQ[bucket_off(bh, i1) + base[i1] + l1] = (unsigned)t | (1u << 13);
        if (i2 >= 0) A.LISTQ[bucket_off(bh, i2) + base[i2] + l2] = (unsigned)t | (2u << 13);
    }
    __syncthreads(); PSEG(6);
}
struct KvRegs { v4u k[4], v[4]; };
__device__ __forceinline__ void attn_kv_load(Frame& F, const bf16* PROJ, size_t krow0, int h, KvRegs& R) {
#pragma unroll
    for (int i = 0; i < 4; ++i) { const int e = F.tid + 512 * i, key = e >> 3, d0 = (e & 7) * 8; const bf16* rp = PROJ + (krow0 + key) * NPROJ + h * 64 + d0;
        R.k[i] = *(const GAS v4u*)(rp + C_AK); R.v[i] = *(const GAS v4u*)(rp + C_AV); }
}
__device__ __forceinline__ void attn_kv_store(Frame& F, const KvRegs& R) {
    LAS bf16* KS = (LAS bf16*)(F.lds + AT_KS); LAS bf16* VS = (LAS bf16*)(F.lds + AT_VS);
#pragma unroll
    for (int i = 0; i < 4; ++i) { const int e = F.tid + 512 * i, key = e >> 3, d0 = (e & 7) * 8; *(LAS v4u*)(KS + key * 72 + d0) = R.k[i]; *(LAS v4u*)(VS + key * 96 + d0) = R.v[i]; }
}
template <bool CAUSAL>
__device__ __forceinline__ void attn_core(Frame& F, const bf16x8_t (&qf)[4], int qloc, float& m, float& l, f32x16_t (&o)[2]) {
    const LAS bf16* KS = (const LAS bf16*)(F.lds + AT_KS); const LAS bf16* VS = (const LAS bf16*)(F.lds + AT_VS);
    const int lane = F.lane, r32 = lane & 31, hh = lane >> 5;
    m = 0.f; l = 0.f;
#pragma unroll
    for (int i = 0; i < 16; ++i) { o[0][i] = 0.f; o[1][i] = 0.f; }
    const int ktmax = CAUSAL ? ((32 * F.wave + 31) >> 6) : 3;
    for (int kt = 0; kt <= ktmax; ++kt) {
        f32x16_t p0, p1; const float nm = -m;
#pragma unroll
        for (int i = 0; i < 16; ++i) { p0[i] = nm; p1[i] = nm; }
#pragma unroll
        for (int d0 = 0; d0 < 4; ++d0) { const bf16x8_t k0 = *(const LAS bf16x8_t*)(KS + (64 * kt + r32) * 72 + 16 * d0 + 8 * hh), k1 = *(const LAS bf16x8_t*)(KS + (64 * kt + 32 + r32) * 72 + 16 * d0 + 8 * hh);
            p0 = MFMA32(k0, qf[d0], p0); p1 = MFMA32(k1, qf[d0], p1); }
        if (CAUSAL) { if (64 * kt + 63 > 32 * F.wave) {
#pragma unroll
                for (int i = 0; i < 16; ++i) { const int kl = 64 * kt + (i & 3) + 8 * (i >> 2) + 4 * hh; if (kl > qloc) p0[i] = -INFINITY; if (kl + 32 > qloc) p1[i] = -INFINITY; } } }
        float rm = fmaxf(p0[0], p1[0]);
#pragma unroll
        for (int i = 1; i < 16; ++i) rm = fmaxf(rm, fmaxf(p0[i], p1[i]));
        rm = fmaxf(rm, __shfl_xor(rm, 32));
        if (kt == 0 || __any(rm > 8.f)) {
            const float dl = (kt == 0) ? rm : fmaxf(rm, 0.f); const float sc = (kt == 0) ? 1.f : __builtin_amdgcn_exp2f(-dl); m += dl; l *= sc;
#pragma unroll
            for (int i = 0; i < 16; ++i) { o[0][i] *= sc; o[1][i] *= sc; p0[i] -= dl; p1[i] -= dl; } }
        float ls = 0.f;
#pragma unroll
        for (int i = 0; i < 16; ++i) { p0[i] = __builtin_amdgcn_exp2f(p0[i]); p1[i] = __builtin_amdgcn_exp2f(p1[i]); ls += p0[i] + p1[i]; }
        l += ls;
        bf16x8_t pf[4];
#pragma unroll
        for (int s = 0; s < 2; ++s) { v4u a, c; a.x = cvtpk(p0[8 * s], p0[8 * s + 1]); a.y = cvtpk(p0[8 * s + 2], p0[8 * s + 3]); a.z = cvtpk(p0[8 * s + 4], p0[8 * s + 5]); a.w = cvtpk(p0[8 * s + 6], p0[8 * s + 7]);
            c.x = cvtpk(p1[8 * s], p1[8 * s + 1]); c.y = cvtpk(p1[8 * s + 2], p1[8 * s + 3]); c.z = cvtpk(p1[8 * s + 4], p1[8 * s + 5]); c.w = cvtpk(p1[8 * s + 6], p1[8 * s + 7]);
            pf[s] = __builtin_bit_cast(bf16x8_t, a); pf[2 + s] = __builtin_bit_cast(bf16x8_t, c); }
#pragma unroll
        for (int dt = 0; dt < 2; ++dt)
#pragma unroll
            for (int s = 0; s < 4; ++s) { const LAS bf16* vp = VS + (64 * kt + 32 * (s >> 1) + 16 * (s & 1) + 4 * hh + ((lane & 15) >> 2)) * 96 + 32 * dt + 16 * ((lane >> 4) & 1) + 4 * (lane & 3);
                const s16x4_t lo = __builtin_bit_cast(s16x4_t, __builtin_amdgcn_ds_read_tr16_b64_v4i16((LAS v4i16_t*)vp)), hi = __builtin_bit_cast(s16x4_t, __builtin_amdgcn_ds_read_tr16_b64_v4i16((LAS v4i16_t*)(vp + 8 * 96)));
                const bf16x8_t vf = {lo[0], lo[1], lo[2], lo[3], hi[0], hi[1], hi[2], hi[3]};
                o[dt] = MFMA32(vf, pf[s], o[dt]); }
    }
}
__device__ __forceinline__ int attn_tile_prefix(Frame& F, const AtBufs& A) {
    LAS int* pfx = (LAS int*)(F.lds + AT_PFX); LAS int* wtot = pfx + 512;
    const int k = F.tid; int nt = 0;
    if (k < 496) { const int bh = k / 31, j = k - bh * 31; nt = ((int)__hip_atomic_load(A.BCNT + bh * 32 + j, RLX_AGENT) + 255) >> 8; }
    int inc = nt;
#pragma unroll
    for (int o = 1; o < 64; o <<= 1) { const int y = __shfl_up(inc, o); if (F.lane >= o) inc += y; }
    if (F.lane == 63) wtot[F.wave] = inc;
    LDS_WAIT(); __syncthreads();
    int wb = 0;
    for (int w = 0; w < F.wave; ++w) wb += wtot[w];
    pfx[k] = wb + inc - nt;
    if (k == 511) pfx[512 + 16] = wb + inc;
    LDS_WAIT(); __syncthreads();
    return pfx[512 + 16];
}
struct SelMeta { int bh, j, n, tile; };
__device__ __forceinline__ SelMeta attn_sel_decode(Frame& F, int u, const AtBufs& A) {
    const LAS int* pfx = (const LAS int*)(F.lds + AT_PFX);
    int lo = 0, hi = 495;
    while (lo < hi) { const int mid = (lo + hi + 1) >> 1; if (pfx[mid] <= u) lo = mid; else hi = mid - 1; }
    SelMeta m; m.bh = lo / 31; m.j = lo - m.bh * 31; m.tile = u - pfx[lo]; m.n = (int)__hip_atomic_load(A.BCNT + m.bh * 32 + m.j, RLX_AGENT); return m;
}
__device__ __forceinline__ void attn_sel_phase(Frame& F, int nu, const bf16* PROJ, const AtBufs& A) {
    const int lane = F.lane, r32 = lane & 31, hh = lane >> 5;
    const int u0 = (int)(((long)F.vcu * nu) / F.G), u1 = (int)(((long)(F.vcu + 1) * nu) / F.G); if (u0 >= u1) return;
    LAS int* mtab = (LAS int*)(F.lds + AT_PFX + 2560);
    if (F.tid < 64) { const int ui = u0 + F.tid; if (ui < u1) { const SelMeta x = attn_sel_decode(F, ui, A); mtab[4 * F.tid] = x.bh; mtab[4 * F.tid + 1] = x.j; mtab[4 * F.tid + 2] = x.n; mtab[4 * F.tid + 3] = x.tile; } }
    LDS_WAIT(); __syncthreads();
#define SEL_META(mt_, u_) { const int i_ = (u_) - u0; if (i_ < 64) { mt_.bh = mtab[4 * i_]; mt_.j = mtab[4 * i_ + 1]; mt_.n = mtab[4 * i_ + 2]; mt_.tile = mtab[4 * i_ + 3]; } else mt_ = attn_sel_decode(F, (u_), A); }
    KvRegs R; bf16x8_t qn[4]; int tq = 0, slotq = 0; bool validq = false;
#define SEL_PREFETCH(mt_, kv_) { const int b_ = mt_.bh >> 3, h_ = mt_.bh & 7; if (kv_) attn_kv_load(F, PROJ, (size_t)b_ * SEQ + (size_t)mt_.j * 256, h_, R); \
        const int idx_ = mt_.tile * 256 + 32 * F.wave + r32; validq = idx_ < mt_.n; const unsigned ent_ = A.LISTQ[bucket_off(mt_.bh, mt_.j) + (validq ? idx_ : mt_.n - 1)]; tq = ent_ & 8191; slotq = ent_ >> 13; \
        const bf16* qp_ = PROJ + ((size_t)b_ * SEQ + tq) * NPROJ + C_AQ + h_ * 64 + 8 * hh; \
        _Pragma("unroll") for (int d0 = 0; d0 < 4; ++d0) qn[d0] = *(const GAS bf16x8_t*)(qp_ + 16 * d0); }
    int u = u0; SelMeta mt; SEL_META(mt, u) bool newkv = true;
    SEL_PREFETCH(mt, true)
    for (;;) {
        if (newkv) { __syncthreads(); attn_kv_store(F, R); LDS_WAIT(); __syncthreads(); }
        bf16x8_t qf[4];
#pragma unroll
        for (int d0 = 0; d0 < 4; ++d0) qf[d0] = qn[d0];
        const int b = mt.bh >> 3, h = mt.bh & 7, t = tq, slot = slotq; const bool valid = validq;
        const int un = u + 1; const bool more = un < u1; SelMeta mn = mt; bool nkv = false;
        if (more) { SEL_META(mn, un) nkv = (mn.bh != mt.bh) || (mn.j != mt.j); SEL_PREFETCH(mn, nkv) }
        float m, l; f32x16_t o[2];
        attn_core<false>(F, qf, 0, m, l, o);
        l += __shfl_xor(l, 32); const float inv = 1.f / l; const size_t row = (size_t)b * SEQ + t;
        if (valid) { bf16* po = A.PO + ((row * 8 + h) * 3 + slot) * 64;
#pragma unroll
            for (int dt = 0; dt < 2; ++dt)
#pragma unroll
                for (int g = 0; g < 4; ++g) { v2u w; w.x = cvtpk(o[dt][4 * g] * inv, o[dt][4 * g + 1] * inv); w.y = cvtpk(o[dt][4 * g + 2] * inv, o[dt][4 * g + 3] * inv);
                    *(GAS v2u*)(po + 32 * dt + 8 * g + 4 * hh) = w; }
            if (hh == 0) { float* pm = A.PML + ((row * 8 + h) * 3 + slot) * 2; pm[0] = m; pm[1] = l; } }
        if (!more) break;
        u = un; mt = mn; newkv = nkv;
    }
    LDS_WAIT(); __syncthreads();
#undef SEL_PREFETCH
#undef SEL_META
}
__device__ __forceinline__ void attn_own_phase(Frame& F, const bf16* PROJ, const float* norm_attn, bf16* CAT, const AtBufs& A) {
    const int lane = F.lane, r32 = lane & 31, hh = lane >> 5; const int qloc = 32 * F.wave + r32;
    int u = F.vcu; if (u >= 512) return;
    KvRegs R; bf16x8_t qn[4]; unsigned seln = 0;
#define OWN_PREFETCH(U) { const int bh_ = (U) >> 5, blk_ = (U) & 31, b_ = bh_ >> 3, h_ = bh_ & 7; attn_kv_load(F, PROJ, (size_t)b_ * SEQ + (size_t)blk_ * 256, h_, R); \
        const size_t row_ = (size_t)b_ * SEQ + blk_ * 256 + qloc; const bf16* qp_ = PROJ + row_ * NPROJ + C_AQ + h_ * 64 + 8 * hh; \
        _Pragma("unroll") for (int d0 = 0; d0 < 4; ++d0) qn[d0] = *(const GAS bf16x8_t*)(qp_ + 16 * d0); seln = A.SEL[row_ * 8 + h_]; }
    OWN_PREFETCH(u)
    for (;;) {
        attn_kv_store(F, R);
        bf16x8_t qf[4];
#pragma unroll
        for (int d0 = 0; d0 < 4; ++d0) qf[d0] = qn[d0];
        const unsigned sel = seln; const int bh = u >> 5, blk = u & 31, b = bh >> 3, h = bh & 7; const size_t row = (size_t)b * SEQ + blk * 256 + qloc;
        LDS_WAIT(); __syncthreads();
        const int un = u + F.G; const bool more = un < 512;
        if (more) OWN_PREFETCH(un)
        float m, l; f32x16_t o[2];
        attn_core<true>(F, qf, qloc, m, l, o);
        l += __shfl_xor(l, 32);
        float mk[3], lk[3]; float M2 = m;
#pragma unroll
        for (int k = 0; k < 3; ++k) { const bool ok = ((sel >> (8 * k)) & 0xffu) != 0xffu; mk[k] = -INFINITY; lk[k] = 0.f;
            if (ok) { const float* pm = A.PML + ((row * 8 + h) * 3 + k) * 2; mk[k] = pm[0]; lk[k] = pm[1]; } M2 = fmaxf(M2, mk[k]); }
        const float wo = __builtin_amdgcn_exp2f(m - M2); float L = l * wo;
#pragma unroll
        for (int i = 0; i < 16; ++i) { o[0][i] *= wo; o[1][i] *= wo; }
#pragma unroll
        for (int k = 0; k < 3; ++k) { const float wk = lk[k] * __builtin_amdgcn_exp2f(mk[k] - M2); L += wk;
            if (wk > 0.f) { const bf16* po = A.PO + ((row * 8 + h) * 3 + k) * 64;
#pragma unroll
                for (int dt = 0; dt < 2; ++dt)
#pragma unroll
                    for (int g = 0; g < 4; ++g) { const v2u w = *(const GAS v2u*)(po + 32 * dt + 8 * g + 4 * hh);
                        o[dt][4 * g] += wk * bflo(w.x); o[dt][4 * g + 1] += wk * bfhi(w.x); o[dt][4 * g + 2] += wk * bflo(w.y); o[dt][4 * g + 3] += wk * bfhi(w.y); } } }
        const float inv = 1.f / L; float ss = 0.f;
#pragma unroll
        for (int i = 0; i < 16; ++i) { o[0][i] *= inv; o[1][i] *= inv; ss += o[0][i] * o[0][i] + o[1][i] * o[1][i]; }
        ss += __shfl_xor(ss, 32);
        const float rs = 1.f / sqrtf(ss * (1.f / 64.f) + RMS_EPS);
        bf16* co = CAT + row * D + h * 64;
#pragma unroll
        for (int dt = 0; dt < 2; ++dt)
#pragma unroll
            for (int g = 0; g < 4; ++g) { const int d0 = 32 * dt + 8 * g + 4 * hh; const f32x4 gn = *(const GAS f32x4*)(norm_attn + h * 64 + d0);
                v2u w; w.x = cvtpk(o[dt][4 * g] * rs * gn[0], o[dt][4 * g + 1] * rs * gn[1]); w.y = cvtpk(o[dt][4 * g + 2] * rs * gn[2], o[dt][4 * g + 3] * rs * gn[3]);
                *(GAS v2u*)(co + d0) = w; }
        LDS_WAIT(); __syncthreads();
        if (!more) break;
        u = un;
    }
#undef OWN_PREFETCH
}

constexpr int N_PHASES = 20;
struct Args { In in; float* out; unsigned char* ws; int ph_lo, ph_hi; };
__global__ void __launch_bounds__(NWAVES * 64, 2) hymba_fwd(Args args) {
    extern __shared__ __attribute__((aligned(16))) unsigned char lds[];
    Frame F;
    F.lds = (LAS unsigned char*)lds;
    F.MISC = (volatile LAS unsigned*)(F.lds + MISC_OFF);
    F.tid = threadIdx.x; F.lane = F.tid & 63; F.wave = __builtin_amdgcn_readfirstlane(F.tid >> 6);
    F.G = gridDim.x; { const int bx = blockIdx.x; F.vcu = (F.G % 8 == 0) ? (bx % 8) * (F.G / 8) + bx / 8 : bx; }
    F.ws = args.ws; unsigned char* ws = args.ws;
    F.ctl = (gu32*)(ws + WS_CTL);
    const In& I = args.in;
    for (int u = F.tid; u < (LDS_BYTES - MISC_OFF) / 4; u += NWAVES * 64) ((LAS unsigned*)(F.lds + MISC_OFF))[u] = 0u;
    __syncthreads();
    const int lo = args.ph_lo, hi = args.ph_hi;
    const bool multi = (hi - lo) > 1;
    XcdBarrier bar; bar.bar = (unsigned*)(F.ctl + CW_BAR); bar.x = 0; bar.st = nullptr;
    if (multi) bar = xcd_barrier_post((unsigned*)(F.ctl + CW_BAR), F.MISC + 8);
#define IN(k) (lo <= (k) && (k) < hi)
#ifdef PROBE_MASK
    LAS unsigned long long* pts = (LAS unsigned long long*)(F.lds + MISC_OFF + 1024);
    if (blockIdx.x == 0 && F.tid == 0) pts[0] = __builtin_amdgcn_s_memrealtime();
    LAS unsigned long long* pmid = pts + 32;
#define PMID(k) do { if (blockIdx.x == 0 && F.tid == 0) pmid[k] = __builtin_amdgcn_s_memrealtime(); } while (0)
#define SEAM(k) do { if (IN(k) && IN((k) + 1)) xcd_barrier(bar); if (blockIdx.x == 0 && F.tid == 0) pts[(k) + 1] = __builtin_amdgcn_s_memrealtime(); } while (0)
#else
#define SEAM(k) do { if (IN(k) && IN((k) + 1)) xcd_barrier(bar); } while (0)
#define PMID(k)
#endif
    bf16* XB = (bf16*)(ws + WS_XB); bf16* PROJ = (bf16*)(ws + WS_PROJ); bf16* CAT = (bf16*)(ws + WS_CAT);
    bf16* MIXB = (bf16*)(ws + WS_MIX); bf16* MIX2B = (bf16*)(ws + WS_MIX2); bf16* X1 = (bf16*)(ws + WS_X1); float* GATES = (float*)(ws + WS_GATES);
    const float* ROPE = (const float*)(ws + WS_ROPE);
    int* LIST = (int*)(ws + WS_LIST); float* LISTW = (float*)(ws + WS_LISTW); int* ROWMAP = (int*)(ws + WS_ROWMAP); float* ROWW = (float*)(ws + WS_ROWW);
    bf16* YB = (bf16*)(ws + WS_Y);

    if (IN(0)) { p_prologue(F, I); } SEAM(0);
    MlBufs MLB{(bf16*)(ws + WS_QC), (bf16*)(ws + WS_KC), (float*)(ws + WS_DC), (bf16*)(ws + WS_CST), (float*)(ws + WS_DN), (float*)(ws + WS_NST), (float*)(ws + WS_SC), (float*)(ws + WS_MC)};
    AtBufs ATB{(bf16*)(ws + WS_PO), (float*)(ws + WS_PML), (unsigned*)(ws + WS_SEL), (unsigned*)(ws + WS_LISTQ), nullptr};
#if defined(DBG_ML) || defined(DBG_AT)
    bf16* CAT2 = (bf16*)(ws + WS_CAT2);
#define DBG_CMP(COFF) { float ds = 0.f; for (size_t e = (size_t)blockIdx.x * 512 + F.tid; e < (size_t)M * 512; e += (size_t)F.G * 512) { const size_t idx = (e >> 9) * D + (COFF) + (e & 511); ds += fabsf(bf2f(CAT[idx]) - bf2f(CAT2[idx])); } \
        ds = wave_sum(ds); if (F.lane == 0) __hip_atomic_fetch_add((float*)(F.ctl + CW_DBG), ds, RLX_AGENT); }
#endif
#ifdef DBG_ML
#define DBG_NAIVE(L) if (F.vcu < 8) mlstm_naive(F, F.vcu, PROJ, GATES, I.conv_w + (L) * 2048, I.conv_b + (L) * 512, I.norm_ml + (L) * 512, CAT2);
#define DBG_COMPARE() DBG_CMP(512)
#elif defined(DBG_AT)
#define DBG_NAIVE(L) attn_naive(F, PROJ, (const float*)(F.ctl + CW_KSUM) + (L) * (BATCH * NB * 512), I.norm_attn + (L) * 512, CAT2, 0, F.G * NWAVES);
#define DBG_COMPARE() DBG_CMP(0)
#else
#define DBG_NAIVE(L)
#define DBG_COMPARE()
#endif

#define LAYER_MIXER(L, P)                                                                                                                                   \
    if (IN(P)) {                                                                                                                          \
        pg8::Gemm g{XB, (const bf16*)(ws + WS_WIN) + (size_t)(L) * NPROJ * D, M, NPROJ, D}; pg8::StaticOrder S; S.init(M, NPROJ, F.G, (int)blockIdx.x);     \
        pg8::EpiProj E{PROJ, ROPE, (float*)(F.ctl + CW_KSUM) + (L) * (BATCH * NB * 512), QSCALE};                                                          \
        pg8::gemm_phase<pg8::EpiProj, pg8::StaticOrder, true, true>(F.lds, g, S, E); } SEAM(P);                                                             \
    ATB.BCNT = (unsigned*)(F.ctl + CW_BCNT) + (L) * 512;                                                                                                    \
    if (IN((P) + 1)) {                                                                            \
        for (int u = F.vcu; u < 512; u += F.G) ml_phase_a(F, u, PROJ, GATES, I.conv_w + (L) * 2048, I.conv_b + (L) * 512, MLB); PMID((P) + 1);               \
        for (int u = F.vcu; u < 256; u += F.G) { attn_route(F, u, PROJ, (const float*)(F.ctl + CW_KSUM) + (L) * (BATCH * NB * 512), ATB);                  \
            attn_route(F, 511 - u, PROJ, (const float*)(F.ctl + CW_KSUM) + (L) * (BATCH * NB * 512), ATB); }     \
        DBG_NAIVE(L) } SEAM((P) + 1);                                                                                                                       \
    if (IN((P) + 2)) {                                                      \
        const int nu = attn_tile_prefix(F, ATB);                                                                                                            \
        for (int u = F.vcu; u < 256; u += F.G) ml_phase_b(F, u, MLB); PMID((P) + 2);                                                                        \
        attn_sel_phase(F, nu, PROJ, ATB); } SEAM((P) + 2);                                                              \
    if (IN((P) + 3)) {                                                                             \
        for (int u = F.vcu; u < 512; u += F.G) ml_phase_c(F, u, PROJ, GATES, I.norm_ml + (L) * 512, CAT, MLB); PMID((P) + 3);                               \
        attn_own_phase(F, PROJ, I.norm_attn + (L) * 512, CAT, ATB); } SEAM((P) + 3);                               \
    if (IN((P) + 4)) {                                                                                                                   \
        DBG_COMPARE()                                                                                                                                       \
        pg8::Gemm g{CAT, (const bf16*)(ws + WS_WOUT) + (size_t)(L) * D * D, M, D, D}; pg8::StaticOrder S; S.init(M, D, F.G, (int)blockIdx.x);                \
        pg8::EpiBf16s E{MIXB, D, 1.f};                                                                                                                      \
        pg8::gemm_phase<pg8::EpiBf16s, pg8::StaticOrder, false, true>(F.lds, g, S, E); } SEAM((P) + 4);

    unsigned char* X1F8 = ws + WS_X1B; unsigned char* HD8 = ws + WS_HD; unsigned char* HM8 = ws + WS_HM; unsigned char* XS8 = ws + WS_XS;
    LAYER_MIXER(0, 1)
    if (IN(6)) { ln_phase<true, false, 0>(F, I.x, nullptr, MIXB, nullptr, I.ln1_g, I.ln1_b, nullptr, X1, X1F8, nullptr, nullptr, nullptr, nullptr, 1.f); } SEAM(6);
    if (IN(7)) {
        const int U = (M / 256) * (2 * DFF / 256), R = (U + F.G - 1) / F.G, Gp = (U + R - 1) / R;
        if ((int)blockIdx.x < Gp) {
            pg8::Gemm g{(const bf16*)X1F8, (const bf16*)(ws + WS_WGU), M, 2 * DFF, D / 2}; pg8::StaticOrder S; S.init(M, 2 * DFF, Gp, (int)blockIdx.x);
            pg8::EpiSwiglu8 E{HD8, DFF, 0, 1.f / SW_UP};
            pg8::gemm_phase<pg8::EpiSwiglu8, pg8::StaticOrder, true, true, true>(F.lds, g, S, E); }
        else moe_cvt_range(F, I, 0, CVT_NA, ((int)blockIdx.x - Gp) * NWAVES + F.wave, (F.G - Gp) * NWAVES);
        if (Gp == F.G) moe_cvt_range(F, I, 0, CVT_NA, F.vcu * NWAVES + F.wave, F.G * NWAVES);     } SEAM(7);
    if (IN(8)) {
        pg8::Gemm g{(const bf16*)HD8, (const bf16*)(ws + WS_WD), M, D, DFF / 2}; pg8::StaticOrder S; S.init(M, D, F.G, (int)blockIdx.x);
        pg8::EpiBf16s E{MIX2B, D, 1.f / SW_DN};
        pg8::gemm_phase<pg8::EpiBf16s, pg8::StaticOrder, false, true, true>(F.lds, g, S, E); } SEAM(8);
    if (IN(9)) { stage_xw(F, I.w_in + (size_t)D * NIN, NIN, NPROJ);
        ln_phase<false, false, 1>(F, nullptr, X1, MIX2B, nullptr, I.ln2_g, I.ln2_b, nullptr, XB, nullptr, I.gate_bias + 8, GATES, nullptr, nullptr, 1.f); } SEAM(9);
    LAYER_MIXER(1, 10)
    if (IN(15)) { stage_xw(F, I.router_w, 8, 0);
        ln_phase<false, false, 2>(F, nullptr, XB, MIXB, nullptr, I.ln1_g + D, I.ln1_b + D, nullptr, X1, X1F8, I.router_b, nullptr, LIST, LISTW, 1.f);
        __syncthreads(); PMID(15); { const int w_ = F.vcu * NWAVES + F.wave, nw_ = F.G * NWAVES; moe_cvt_range(F, I, CVT_NA, NUPI, w_, nw_); moe_cvt_range(F, I, NUPI + CVT_ND, NUPI + NDNI, w_, nw_); } } SEAM(15);
    int ntiles = 0;
    if (lo <= 18 && hi > 16) ntiles = moe_plan(F);
    if (IN(16)) { moe_gather(F, ntiles, X1F8, XS8, LIST, LISTW, ROWMAP, ROWW); } SEAM(16);
    const PG8_LAS int* texp = (const PG8_LAS int*)(F.lds + TEXP_OFF);
    if (IN(17)) {
        const int U = ntiles * (2 * DEX / 256), R = (U + F.G - 1) / F.G; const int Gp = R > 0 ? (U + R - 1) / R : F.G;
        if ((int)blockIdx.x < Gp) {
            pg8::Gemm g{(const bf16*)XS8, (const bf16*)(ws + WS_MGU), MAXT * 256, 2 * DEX, D / 2}; pg8::GroupedOrder<false> S; S.init(0, ntiles, 2 * DEX / 256, Gp, (int)blockIdx.x, texp);
            pg8::EpiSwiglu8 E{HM8, DEX, 0, 1.f / SW_UP};
            pg8::gemm_phase<pg8::EpiSwiglu8, pg8::GroupedOrder<false>, true, true, true>(F.lds, g, S, E); }
        else moe_cvt_range(F, I, NUPI, NUPI + CVT_ND, ((int)blockIdx.x - Gp) * NWAVES + F.wave, (F.G - Gp) * NWAVES);
        if (Gp == F.G) moe_cvt_range(F, I, NUPI, NUPI + CVT_ND, F.vcu * NWAVES + F.wave, F.G * NWAVES); } SEAM(17);
    if (IN(18)) {
        pg8::Gemm g{(const bf16*)HM8, (const bf16*)(ws + WS_MD), MAXT * 256, D, DEX / 2}; pg8::GroupedOrder<true> S; S.init(0, ntiles, D / 256, F.G, (int)blockIdx.x, texp);
        pg8::EpiScatter E{YB, ROWMAP, ROWW, 0, M, 1.f / SW_DN};
        pg8::gemm_phase<pg8::EpiScatter, pg8::GroupedOrder<true>, true, true, true>(F.lds, g, S, E); } SEAM(18);
    if (IN(19)) { float osc = 1.f;
#if defined(DBG_ML) || defined(DBG_AT)
        osc = 1.f + 10.f * __hip_atomic_load((float*)(F.ctl + CW_DBG), RLX_AGENT) / (2.f * (float)M * 512.f);
#endif
        ln_phase<false, true, 0>(F, nullptr, X1, YB, YB + (size_t)M * D, I.ln2_g + D, I.ln2_b + D, args.out, nullptr, nullptr, nullptr, nullptr, nullptr, nullptr, osc); }
#ifdef PROBE_MASK
    if (blockIdx.x == 0 && F.tid == 0) { pts[N_PHASES] = __builtin_amdgcn_s_memrealtime(); unsigned long long sum = 0;
        for (int p = 0; p < N_PHASES; ++p) if ((PROBE_MASK >> p) & 1) sum += pts[p + 1] - pts[p];
#ifdef PROBE_SUB
        for (int p = 0; p < N_PHASES; ++p) if ((PROBE_SUB >> p) & 1) sum += pmid[p] - pts[p];
#endif
#ifdef PROBE_SEG
        sum += ((LAS unsigned long long*)(F.lds + MISC_OFF + 1536))[1 + PROBE_SEG];
#endif
        const unsigned long long t0 = __builtin_amdgcn_s_memrealtime(); while (__builtin_amdgcn_s_memrealtime() - t0 < 4 * sum) __builtin_amdgcn_s_sleep(8); }
#endif
#undef IN
#undef SEAM
}

extern "C" void kernel_launch(void* const* d_in, const int* in_sizes, int n_in, void* d_out, int out_size, void* d_ws, size_t ws_size, hipStream_t stream) {
    static int grid = 0;
    if (grid == 0) {
        if (n_in != 21 || in_sizes[0] != M * D || out_size != M * D || ws_size < WS_END) { fprintf(stderr, "kernel_launch: unexpected shapes (n_in %d, in0 %d, out %d, ws %zu < %zu); nothing launched\n", n_in, n_in > 0 ? in_sizes[0] : -1, out_size, ws_size, (size_t)WS_END); grid = -1; return; }
        int dev = 0, cus = 0, per_cu = 0;
        if (hipGetDevice(&dev) != hipSuccess || hipDeviceGetAttribute(&cus, hipDeviceAttributeMultiprocessorCount, dev) != hipSuccess) { grid = -1; return; }
        if (hipFuncSetAttribute((const void*)hymba_fwd, hipFuncAttributeMaxDynamicSharedMemorySize, LDS_BYTES) != hipSuccess) { fprintf(stderr, "kernel_launch: hipFuncSetAttribute failed\n"); grid = -1; return; }
        if (hipOccupancyMaxActiveBlocksPerMultiprocessor(&per_cu, (const void*)hymba_fwd, NWAVES * 64, LDS_BYTES) != hipSuccess || per_cu < 1) fprintf(stderr, "kernel_launch: occupancy query reports %d\n", per_cu);
        (void)hipGetLastError();
        grid = cus;
    }
    if (grid < 0) return;
    if (hipMemsetAsync((char*)d_ws + WS_CTL, 0, CTL_ZERO_BYTES, stream) != hipSuccess) return;
    Args a{};
    const void** ip = (const void**)&a.in;
    for (int i = 0; i < 21; ++i) ip[i] = d_in[i];
    a.out = (float*)d_out; a.ws = (unsigned char*)d_ws;
#if defined(MK_MULTI)
    for (int p = 0; p < N_PHASES; ++p) { a.ph_lo = p; a.ph_hi = p + 1;
        hipLaunchKernelGGL(hymba_fwd, dim3(grid), dim3(NWAVES * 64), LDS_BYTES, stream, a); }
#else
    a.ph_lo = 0; a.ph_hi = N_PHASES;
    hipLaunchKernelGGL(hymba_fwd, dim3(grid), dim3(NWAVES * 64), LDS_BYTES, stream, a);
#endif
}
```
